# Optimizing an MI355X kernel written in HIP

```python
import math
import jax, jax.numpy as jnp
from jax import lax
import numpy as np

D_MODEL = 1024
BATCH = 4
SEQ = 8192
DEPTH = 4

CTX_LEN = 256
GRID_W = 64
HEAD_DIM = 64
RW_W = 3 * D_MODEL // 8
RW_HEADS = RW_W // HEAD_DIM
RW_DECAY_LORA = 64
RW_ICLR_LORA = 64
RW_GATE_LORA = 128
GD_W = 3 * D_MODEL // 8
GD_HEADS = GD_W // HEAD_DIM
GD_CONV = 3
GD_CHUNK = 64
S5_W = D_MODEL - RW_W - GD_W
S5_CH = 16
S5_GROUPS = S5_W // S5_CH
S5_STATE = 64
S5_DT_MIN = 1e-3
S5_DT_MAX = 1e-1
FFN_HIDDEN = 256 * math.ceil(8 * D_MODEL / (3 * 256))
IN_RW = 3 * RW_W + RW_DECAY_LORA + RW_ICLR_LORA + RW_GATE_LORA
IN_GD = 3 * GD_W + 4 * GD_HEADS + GD_W
IN_TOTAL = IN_RW + IN_GD + S5_W
NORM_EPS = 1e-6
LNX_EPS = 64e-5
F32 = jnp.float32

kernel_name = 'hybrid_rwkv7_gdn_s5_adaln_prefix'


def rms_norm(x, g):
    xf = x.astype(F32)
    y = xf * lax.rsqrt(jnp.mean(xf * xf, axis=-1, keepdims=True) + NORM_EPS)
    return (y * g).astype(x.dtype)


def l2_normalize(t):
    t = t.astype(F32)
    return t * lax.rsqrt(jnp.sum(t * t, axis=-1, keepdims=True) + NORM_EPS)


def centred_shift(p):
    prev = jnp.pad(p[:, :-1], ((0, 0), (1, 0), (0, 0)))
    nxt = jnp.pad(p[:, 1:], ((0, 0), (0, 1), (0, 0)))
    return 0.5 * (prev + nxt)


def depthwise_conv_centred(x, w):
    pad = w.shape[0] // 2
    return lax.conv_general_dilated(x, w[:, None, :].astype(x.dtype), window_strides=(1,),
                                    padding=[(pad, pad)], dimension_numbers=('NWC', 'WIO', 'NWC'),
                                    feature_group_count=x.shape[-1])


def raster_to_column_major(t):
    bsz, n, ch = t.shape
    rows = n // GRID_W
    return t.reshape(bsz, rows, GRID_W, ch).transpose(0, 2, 1, 3).reshape(bsz, n, ch)


def column_major_to_raster(t):
    bsz, n, ch = t.shape
    rows = n // GRID_W
    return t.reshape(bsz, GRID_W, rows, ch).transpose(0, 2, 1, 3).reshape(bsz, n, ch)


def head_group_norm(y, gain, bias):
    mu = jnp.mean(y, axis=-1, keepdims=True)
    var = jnp.mean(jnp.square(y - mu), axis=-1, keepdims=True)
    yn = (y - mu) * lax.rsqrt(var + LNX_EPS)
    bsz, n, h, d = y.shape
    return yn.reshape(bsz, n, h * d) * gain + bias


def rwkv7_scan(r, w, k, v, a, b, s0, reverse):
    def step(S, inp):
        r_t, w_t, k_t, v_t, a_t, b_t = inp
        sa = jnp.einsum('bhvk,bhk->bhv', S, a_t)
        S = S * w_t[:, :, None, :] + sa[..., None] * b_t[:, :, None, :] + v_t[..., None] * k_t[:, :, None, :]
        return S, jnp.einsum('bhvk,bhk->bhv', S, r_t)
    xs = tuple(jnp.moveaxis(t.astype(F32), 1, 0) for t in (r, w, k, v, a, b))
    s_final, ys = lax.scan(step, s0, xs, reverse=reverse)
    return jnp.moveaxis(ys, 0, 1), s_final


def rwkv7_mixer(z, P, s0):
    bsz, n, _ = z.shape
    z = z + (centred_shift(z) - z) * P['rw_mu']
    r, k, v, wd, ad, gd = jnp.split(z, [RW_W, 2 * RW_W, 3 * RW_W, 3 * RW_W + RW_DECAY_LORA,
                                        3 * RW_W + RW_DECAY_LORA + RW_ICLR_LORA], axis=-1)
    heads = lambda t: t.reshape(bsz, n, RW_HEADS, HEAD_DIM)
    gate = jax.nn.sigmoid(gd) @ P['rw_gup']
    rh = heads(r).astype(F32)
    vh = heads(v).astype(F32)
    kk = l2_normalize(heads(k * P['rw_kk']))
    wd_t = jnp.tanh(wd.astype(F32))
    ys = []
    finals = []
    bonus = jnp.zeros_like(vh)
    for d in range(2):
        w_log = -jax.nn.softplus(-(P['rw_w0'][d] + wd_t @ P['rw_wup'][d])) - 0.5
        decay = jnp.exp(-jnp.exp(w_log))
        a = jax.nn.sigmoid(P['rw_a0'][d] + ad.astype(F32) @ P['rw_aup'][d])
        kd = heads(k.astype(F32) * (1.0 + (a - 1.0) * P['rw_ka']))
        y, s_fin = rwkv7_scan(rh, heads(decay), kd, vh, -kk, kk * heads(a), s0[d], d == 1)
        ys.append(y)
        finals.append(s_fin)
        bonus = bonus + jnp.sum(rh * kd * P['rw_rk'], axis=-1, keepdims=True) * vh
    y = head_group_norm(ys[0] + ys[1], P['rw_lnx_g'], P['rw_lnx_b']) + bonus.reshape(bsz, n, RW_W)
    return (y * gate).astype(z.dtype), jnp.stack(finals)


def gated_delta_chunked(q, k, v, beta, g, s0):
    bsz, n, h, d = q.shape
    nc = n // GD_CHUNK

    def to_chunks(t):
        return jnp.swapaxes(t.reshape((bsz, nc, GD_CHUNK) + t.shape[2:]), 2, 3)

    q, k, v, beta, g = (to_chunks(t) for t in (q, k, v, beta, g))
    G = jnp.cumsum(g, axis=-1)
    idx = jnp.arange(GD_CHUNK)
    incl = idx[:, None] >= idx[None, :]
    strict = idx[:, None] > idx[None, :]
    decay = jnp.exp(jnp.where(incl, G[..., :, None] - G[..., None, :], -jnp.inf))
    kk = jnp.einsum('bnhik,bnhjk->bnhij', k, k)
    m = jnp.where(strict, beta[..., :, None] * kk * decay, 0.0)
    eye = jnp.eye(GD_CHUNK, dtype=F32)
    rhs = jnp.concatenate([v * beta[..., None], k * (beta * jnp.exp(G))[..., None]], axis=-1)
    sol = lax.linalg.triangular_solve(eye + m, rhs, left_side=True, lower=True, unit_diagonal=True)
    w_v, w_k = jnp.split(sol, 2, axis=-1)
    a_qk = jnp.einsum('bnhik,bnhjk->bnhij', q, k) * decay
    q_g = q * jnp.exp(G)[..., None]
    k_d = k * jnp.exp(G[..., -1:] - G)[..., None]
    g_c = jnp.exp(G[..., -1])

    def step(S, inp):
        w_v_c, w_k_c, a_c, q_c, k_c, gc = inp
        U = w_v_c - jnp.einsum('bhck,bhkv->bhcv', w_k_c, S)
        O = jnp.einsum('bhck,bhkv->bhcv', q_c, S) + jnp.einsum('bhij,bhjv->bhiv', a_c, U)
        S = gc[..., None, None] * S + jnp.einsum('bhck,bhcv->bhkv', k_c, U)
        return S, O

    xs = tuple(jnp.moveaxis(t, 1, 0) for t in (w_v, w_k, a_qk, q_g, k_d, g_c))
    s_final, O = lax.scan(step, s0, xs)
    O = jnp.swapaxes(jnp.moveaxis(O, 0, 1), 2, 3).reshape(bsz, n, h, d)
    return O, s_final


def gdn_mixer(z, P, s0):
    bsz, n, _ = z.shape
    qkv, beta_in, a_in, gate = jnp.split(z, [3 * GD_W, 3 * GD_W + 2 * GD_HEADS, 3 * GD_W + 4 * GD_HEADS], axis=-1)
    qkv = jax.nn.silu(depthwise_conv_centred(qkv, P['gd_conv']))
    q, k, v = jnp.split(qkv, 3, axis=-1)
    heads = lambda t: t.reshape(bsz, n, GD_HEADS, HEAD_DIM)
    q = l2_normalize(heads(q)) * (HEAD_DIM ** -0.5)
    k = l2_normalize(heads(k))
    v = heads(v).astype(F32)
    beta = jax.nn.sigmoid(beta_in.astype(F32)).reshape(bsz, n, 2, GD_HEADS)
    g = -jnp.exp(P['gd_a_log'].astype(F32)) * jax.nn.softplus(
        a_in.astype(F32).reshape(bsz, n, 2, GD_HEADS) + P['gd_dt_bias'])
    flip = lambda t: jnp.flip(t, 1)
    o_f, s_f = gated_delta_chunked(q, k, v, beta[:, :, 0], g[:, :, 0], s0[0])
    o_b, s_b = gated_delta_chunked(flip(q), flip(k), flip(v), flip(beta[:, :, 1]), flip(g[:, :, 1]), s0[1])
    o = o_f + flip(o_b)
    o = o * lax.rsqrt(jnp.mean(o * o, axis=-1, keepdims=True) + NORM_EPS) * P['gd_norm_g']
    o = o * jax.nn.silu(heads(gate).astype(F32))
    return o.reshape(bsz, n, GD_W).astype(z.dtype), jnp.stack([s_f, s_b])


def complex_affine_combine(e1, e2):
    a1r, a1i, b1r, b1i = e1
    a2r, a2i, b2r, b2i = e2
    return (a1r * a2r - a1i * a2i, a1r * a2i + a1i * a2r,
            a2r * b1r - a2i * b1i + b2r, a2r * b1i + a2i * b1r + b2i)


def s5_scan(u, lam_re, lam_im, log_dt, b_re, b_im, c_re, c_im, h0):
    lam_re, lam_im, b_re, b_im, c_re, c_im = (t.astype(F32) for t in (lam_re, lam_im, b_re, b_im, c_re, c_im))
    dt = jnp.exp(log_dt.astype(F32))[:, None]
    mag = jnp.exp(lam_re * dt)
    ab_re = mag * jnp.cos(lam_im * dt)
    ab_im = mag * jnp.sin(lam_im * dt)
    den = lam_re * lam_re + lam_im * lam_im
    f_re = ((ab_re - 1.0) * lam_re + ab_im * lam_im) / den
    f_im = (ab_im * lam_re - (ab_re - 1.0) * lam_im) / den
    bb_re = f_re[..., None] * b_re - f_im[..., None] * b_im
    bb_im = f_re[..., None] * b_im + f_im[..., None] * b_re
    bu_re = jnp.einsum('btgh,gph->btgp', u, bb_re)
    bu_im = jnp.einsum('btgh,gph->btgp', u, bb_im)
    h0_re, h0_im = h0[0], h0[1]
    bu_re = bu_re.at[:, 0].add(ab_re * h0_re - ab_im * h0_im)
    bu_im = bu_im.at[:, 0].add(ab_re * h0_im + ab_im * h0_re)
    n = u.shape[1]
    a_re = jnp.broadcast_to(ab_re, (1, n) + ab_re.shape)
    a_im = jnp.broadcast_to(ab_im, (1, n) + ab_im.shape)
    _, _, h_re, h_im = lax.associative_scan(complex_affine_combine, (a_re, a_im, bu_re, bu_im), axis=1)
    y = jnp.einsum('btgp,ghp->btgh', h_re, c_re) - jnp.einsum('btgp,ghp->btgh', h_im, c_im)
    return y, jnp.stack([h_re[:, -1], h_im[:, -1]])


def s5_mixer(u, P, s0, column_major):
    bsz, n, _ = u.shape
    uf = u.astype(F32)
    us = raster_to_column_major(uf) if column_major else uf
    ug = us.reshape(bsz, n, S5_GROUPS, S5_CH)
    ys = []
    finals = []
    for d in range(2):
        seq = ug if d == 0 else jnp.flip(ug, 1)
        y, h_fin = s5_scan(seq, P['s5_lam_re'][d], P['s5_lam_im'][d], P['s5_log_dt'][d],
                           P['s5_b_re'][d], P['s5_b_im'][d], P['s5_c_re'][d], P['s5_c_im'][d], s0[d])
        ys.append(y if d == 0 else jnp.flip(y, 1))
        finals.append(h_fin)
    y = (ys[0] + ys[1]).reshape(bsz, n, S5_W)
    if column_major:
        y = column_major_to_raster(y)
    y = jax.nn.gelu(y + P['s5_d'] * uf)
    y = y * jax.nn.sigmoid(y @ P['s5_glu_w'] + P['s5_glu_b'])
    return y.astype(u.dtype), jnp.stack(finals)


def token_mixers(h, P, states0, column_major):
    z = h @ P['w_in']
    z_rw, z_gd, z_s5 = jnp.split(z, [IN_RW, IN_RW + IN_GD], axis=-1)
    y_rw, s_rw = rwkv7_mixer(z_rw, P, states0[0])
    y_gd, s_gd = gdn_mixer(z_gd, P, states0[1])
    y_s5, s_s5 = s5_mixer(z_s5, P, states0[2], column_major)
    return jnp.concatenate([y_rw, y_gd, y_s5], axis=-1), (s_rw, s_gd, s_s5)


def ada_modulation(cond, w, b):
    return jnp.split(jax.nn.silu(cond) @ w + b, 6, axis=-1)


def swiglu(h, w_gate, w_up, w_down):
    return (jax.nn.silu(h @ w_gate) * (h @ w_up)) @ w_down


def setup_inputs(seed: int = 0) -> dict:
    key = jax.random.key(seed)
    ks = iter(jax.random.split(key, 64))

    def nrm(shape, scale):
        return jax.random.normal(next(ks), shape, F32) * scale

    def unif(shape, lo, hi):
        return jax.random.uniform(next(ks), shape, F32, lo, hi)

    L, D, F = DEPTH, D_MODEL, FFN_HIDDEN
    G, P, H = S5_GROUPS, S5_STATE, S5_CH
    gd_dt = jnp.exp(unif((L, 2, GD_HEADS), math.log(1e-3), math.log(1e-1)))
    return {
        'x': nrm((BATCH, SEQ, D), 1.0),
        'c': nrm((BATCH, D), 1.0),
        'ctx': nrm((BATCH, CTX_LEN, D), 1.0),
        'c_ctx': nrm((D,), 1.0),
        'norm1_g': 1.0 + nrm((L, D), 0.02),
        'norm2_g': 1.0 + nrm((L, D), 0.02),
        'final_g': 1.0 + nrm((D,), 0.02),
        'ada_w': nrm((L, D, 6 * D), D ** -0.5),
        'ada_b': nrm((L, 6 * D), 0.01),
        'w_in': nrm((L, D, IN_TOTAL), D ** -0.5),
        'w_out': nrm((L, D, D), D ** -0.5),
        'rw_mu': unif((L, IN_RW), 0.0, 1.0),
        'rw_w0': nrm((L, 2, RW_W), 0.5),
        'rw_wup': nrm((L, 2, RW_DECAY_LORA, RW_W), 0.1),
        'rw_a0': nrm((L, 2, RW_W), 0.5),
        'rw_aup': nrm((L, 2, RW_ICLR_LORA, RW_W), RW_ICLR_LORA ** -0.5),
        'rw_gup': nrm((L, RW_GATE_LORA, RW_W), RW_GATE_LORA ** -0.5),
        'rw_kk': 0.85 + nrm((L, RW_W), 0.05),
        'rw_ka': 1.0 + nrm((L, RW_W), 0.05),
        'rw_rk': nrm((L, RW_HEADS, HEAD_DIM), 0.1),
        'rw_lnx_g': 1.0 + nrm((L, RW_W), 0.02),
        'rw_lnx_b': nrm((L, RW_W), 0.01),
        'gd_conv': nrm((L, GD_CONV, 3 * GD_W), GD_CONV ** -0.5),
        'gd_a_log': jnp.log(unif((L, 2, GD_HEADS), 1.0, 16.0)),
        'gd_dt_bias': gd_dt + jnp.log(-jnp.expm1(-gd_dt)),
        'gd_norm_g': 1.0 + nrm((L, HEAD_DIM), 0.02),
        's5_lam_re': -0.5 + nrm((L, 2, G, P), 0.01),
        's5_lam_im': jnp.pi * jnp.arange(P, dtype=F32) + nrm((L, 2, G, P), 0.01),
        's5_log_dt': unif((L, 2, G), math.log(S5_DT_MIN), math.log(S5_DT_MAX)),
        's5_b_re': nrm((L, 2, G, P, H), (2 * H) ** -0.5),
        's5_b_im': nrm((L, 2, G, P, H), (2 * H) ** -0.5),
        's5_c_re': nrm((L, 2, G, H, P), P ** -0.5),
        's5_c_im': nrm((L, 2, G, H, P), P ** -0.5),
        's5_d': nrm((L, S5_W), 1.0),
        's5_glu_w': nrm((L, S5_W, S5_W), S5_W ** -0.5),
        's5_glu_b': nrm((L, S5_W), 0.01),
        'ffn_w_gate': nrm((L, D, F), D ** -0.5),
        'ffn_w_up': nrm((L, D, F), D ** -0.5),
        'ffn_w_down': nrm((L, F, D), F ** -0.5),
    }


def reference(x, c, ctx, c_ctx, norm1_g, norm2_g, final_g, ada_w, ada_b, w_in, w_out,
              rw_mu, rw_w0, rw_wup, rw_a0, rw_aup, rw_gup, rw_kk, rw_ka, rw_rk, rw_lnx_g, rw_lnx_b,
              gd_conv, gd_a_log, gd_dt_bias, gd_norm_g,
              s5_lam_re, s5_lam_im, s5_log_dt, s5_b_re, s5_b_im, s5_c_re, s5_c_im, s5_d, s5_glu_w, s5_glu_b,
              ffn_w_gate, ffn_w_up, ffn_w_down):
    bsz = x.shape[0]
    zero_states = (jnp.zeros((2, bsz, RW_HEADS, HEAD_DIM, HEAD_DIM), F32),
                   jnp.zeros((2, bsz, GD_HEADS, HEAD_DIM, HEAD_DIM), F32),
                   jnp.zeros((2, 2, bsz, S5_GROUPS, S5_STATE), F32))
    for l in range(DEPTH):
        P = {
            'w_in': w_in[l], 'rw_mu': rw_mu[l], 'rw_w0': rw_w0[l], 'rw_wup': rw_wup[l], 'rw_a0': rw_a0[l],
            'rw_aup': rw_aup[l], 'rw_gup': rw_gup[l], 'rw_kk': rw_kk[l], 'rw_ka': rw_ka[l], 'rw_rk': rw_rk[l],
            'rw_lnx_g': rw_lnx_g[l], 'rw_lnx_b': rw_lnx_b[l], 'gd_conv': gd_conv[l], 'gd_a_log': gd_a_log[l],
            'gd_dt_bias': gd_dt_bias[l], 'gd_norm_g': gd_norm_g[l], 's5_lam_re': s5_lam_re[l],
            's5_lam_im': s5_lam_im[l], 's5_log_dt': s5_log_dt[l], 's5_b_re': s5_b_re[l], 's5_b_im': s5_b_im[l],
            's5_c_re': s5_c_re[l], 's5_c_im': s5_c_im[l], 's5_d': s5_d[l], 's5_glu_w': s5_glu_w[l],
            's5_glu_b': s5_glu_b[l],
        }
        sh1c, sc1c, g1c, sh2c, sc2c, g2c = ada_modulation(c_ctx[None, None, :], ada_w[l], ada_b[l])
        hc = rms_norm(ctx, norm1_g[l]) * (1.0 + sc1c) + sh1c
        mix_c, ctx_states = token_mixers(hc, P, zero_states, False)
        sh1x, sc1x, g1x, sh2x, sc2x, g2x = ada_modulation(c[:, None, :], ada_w[l], ada_b[l])
        hx = rms_norm(x, norm1_g[l]) * (1.0 + sc1x) + sh1x
        mix_x, _ = token_mixers(hx, P, ctx_states, True)
        x = x + g1x * (mix_x @ w_out[l])
        hx2 = rms_norm(x, norm2_g[l]) * (1.0 + sc2x) + sh2x
        x = x + g2x * swiglu(hx2, ffn_w_gate[l], ffn_w_up[l], ffn_w_down[l])
        if l < DEPTH - 1:
            ctx = ctx + g1c * (mix_c @ w_out[l])
            hc2 = rms_norm(ctx, norm2_g[l]) * (1.0 + sc2c) + sh2c
            ctx = ctx + g2c * swiglu(hc2, ffn_w_gate[l], ffn_w_up[l], ffn_w_down[l])
    return rms_norm(x, final_g)
```

```cpp
#include <hip/hip_runtime.h>
#include <hip/hip_cooperative_groups.h>
#include <cstdio>
namespace cg = cooperative_groups;

#define LAS __attribute__((address_space(3)))
typedef unsigned short bf16_t;
typedef unsigned char uchar;
typedef short bf16x8 __attribute__((ext_vector_type(8)));
typedef float f32x4 __attribute__((ext_vector_type(4)));
typedef float f32x2 __attribute__((ext_vector_type(2)));
typedef unsigned u32x4 __attribute__((ext_vector_type(4)));
typedef unsigned u32x2 __attribute__((ext_vector_type(2)));

constexpr int DM = 1024, NB = 4, SEQ = 8192, CTX = 256, TT = 8448, MROWS = 33792, DEPTH = 4;
constexpr int FFN = 2816, ZLD = 2968, NCH = 264  , GROWS = 1056  ;
constexpr int LDSB = 131072;
constexpr int LDS_TOTAL = 163840, TAB_OFF = 162816;

enum { I_X = 0, I_C, I_CTX, I_CCTX, I_N1G, I_N2G, I_FG, I_ADAW, I_ADAB, I_WIN, I_WOUT, I_MU, I_W0, I_WUP, I_A0, I_AUP, I_GUP, I_KK, I_KA, I_RK,
       I_LNG, I_LNB, I_CONV, I_ALOG, I_DTB, I_GNG, I_LRE, I_LIM, I_LDT, I_BRE, I_BIM, I_CRE, I_CIM, I_S5D, I_GLUW, I_GLUB, I_FG8, I_FU, I_FD, N_IN };

constexpr size_t OFF_WIN = 0;
constexpr size_t OFF_WOUT = OFF_WIN + 6815744;
constexpr size_t OFF_WGU = OFF_WOUT + 2097152;
constexpr size_t OFF_WDN = OFF_WGU + 11534336;
constexpr size_t OFF_WUP = OFF_WDN + 5767168;
constexpr size_t OFF_AUP = OFF_WUP + 98304;
constexpr size_t OFF_GUP = OFF_AUP + 98304;
constexpr size_t OFF_GLU = OFF_GUP + 98304;
constexpr size_t OFF_TF = OFF_GLU + 131072;
constexpr size_t OFF_E2 = OFF_TF + 20971520;
constexpr size_t OFF_DP = OFF_E2 + 4194304;
constexpr size_t OFF_MOD = OFF_DP + 16384;
constexpr size_t OFF_CTXR = OFF_MOD + 491520;
constexpr size_t OFF_BC = OFF_CTXR + 4194304;
constexpr size_t OFF_H = OFF_BC + 1622016;
constexpr size_t OFF_Z = OFF_H + 69206016;
constexpr size_t OFF_YO = OFF_Z + 200589312;
constexpr size_t OFF_A2 = OFF_YO + 103809024;
constexpr size_t OFF_Y5 = OFF_A2 + 43581440;
constexpr size_t OFF_HL = OFF_Y5 + 34603008;
constexpr size_t OFF_BAR = OFF_HL + 17301504;
constexpr size_t WS_NEED = OFF_BAR + 16384;

struct P { const float* in[N_IN]; float* out; char* ws; };
__device__ __forceinline__ char* ldp(int i) {
    extern __shared__ __attribute__((aligned(16))) unsigned char shm_[];
    const unsigned long long v = ((const unsigned long long*)(shm_ + TAB_OFF))[i];
    const unsigned lo = __builtin_amdgcn_readfirstlane((unsigned)v), hi = __builtin_amdgcn_readfirstlane((unsigned)(v >> 32));
    return (char*)(__attribute__((address_space(1))) char*)(((unsigned long long)hi << 32) | lo);
}
struct PIn { __device__ __forceinline__ const float* operator[](int i) const { return (const float*)ldp(i); } };
struct PP { PIn in; float* out; char* ws; int wv; };
__device__ __forceinline__ PP mkp(int wv) { PP q; q.out = (float*)ldp(N_IN); q.ws = ldp(N_IN + 1); q.wv = wv; return q; }

__device__ __forceinline__ int lane_id() { return (int)__builtin_amdgcn_mbcnt_hi(~0u, __builtin_amdgcn_mbcnt_lo(~0u, 0u)); }
__device__ __forceinline__ int tid_of(int wv) { int t = wv * 64 + lane_id(); asm volatile("" : "+v"(t)); return t; }
__device__ __forceinline__ int bidx() { int t = blockIdx.x; asm volatile("" : "+s"(t)); return t; }
__device__ __forceinline__ bf16_t f2bf(float f) { unsigned u = __float_as_uint(f); u += 0x7FFFu + ((u >> 16) & 1u); return (bf16_t)(u >> 16); }
typedef __bf16 bf16v2_t __attribute__((ext_vector_type(2)));
__device__ __forceinline__ unsigned pk2(float lo, float hi) { f32x2 f; f.x = lo; f.y = hi; return __builtin_bit_cast(unsigned, __builtin_convertvector(f, bf16v2_t)); }
__device__ __forceinline__ float bflo(unsigned u) { return __uint_as_float(u << 16); }
__device__ __forceinline__ float bfhi(unsigned u) { return __uint_as_float(u & 0xFFFF0000u); }
__device__ __forceinline__ float bf2f(bf16_t b) { return __uint_as_float(((unsigned)b) << 16); }
__device__ __forceinline__ f32x4 unpk4(u32x2 v) { return (f32x4){bflo(v.x), bfhi(v.x), bflo(v.y), bfhi(v.y)}; }
__device__ __forceinline__ u32x2 pk4(f32x4 v) { u32x2 r; r.x = pk2(v[0], v[1]); r.y = pk2(v[2], v[3]); return r; }
__device__ __forceinline__ float rcpf_(float x) { return __builtin_amdgcn_rcpf(x); }
__device__ __forceinline__ float sigmoidf_(float x) { return rcpf_(1.f + __expf(-x)); }
__device__ __forceinline__ float siluf_(float x) { return x * rcpf_(1.f + __expf(-x)); }
__device__ __forceinline__ float softplusf_(float x) { return x > 20.f ? x : log1pf(__expf(x)); }
__device__ __forceinline__ float gelu_tanh(float x) { const float u = 1.5957691216057308f * (x + 0.044715f * x * x * x); return x * rcpf_(1.f + __expf(-u)); }
__device__ __forceinline__ float tanhf_(float x) { return 1.f - 2.f * rcpf_(1.f + __expf(2.f * x)); }
template <int CTRL> __device__ __forceinline__ float dppf(float x) { return __builtin_bit_cast(float, __builtin_amdgcn_mov_dpp(__builtin_bit_cast(int, x), CTRL, 0xf, 0xf, true)); }
__device__ __forceinline__ float red16(float x) {
    x += dppf<0xB1>(x); x += dppf<0x4E>(x); x += dppf<0x141>(x); x += dppf<0x128>(x); return x;
}
__device__ __forceinline__ void red16x2(float& x, float& y) {
    x += dppf<0xB1>(x); y += dppf<0xB1>(y); x += dppf<0x4E>(x); y += dppf<0x4E>(y);
    x += dppf<0x141>(x); y += dppf<0x141>(y); x += dppf<0x128>(x); y += dppf<0x128>(y);
}
__device__ __forceinline__ float dot4(const f32x4& a, const f32x4& b) { return (a[0] * b[0] + a[2] * b[2]) + (a[1] * b[1] + a[3] * b[3]); }
__device__ __forceinline__ float red64(float x) {
#pragma unroll
    for (int o = 32; o > 0; o >>= 1) x += __shfl_xor(x, o);
    return x;
}
__device__ __forceinline__ void lbar() { asm volatile("s_waitcnt lgkmcnt(0)" ::: "memory"); __builtin_amdgcn_s_barrier(); asm volatile("" ::: "memory"); }
__device__ __forceinline__ int seqpos(int dir, int n) { return dir == 0 ? n : (n < CTX ? (CTX - 1 - n) : (TT - 1 - (n - CTX))); }
__device__ __forceinline__ int s5pos(int j) { if (j < CTX) return j; const int tok = j - CTX; return CTX + (tok & 63) * 128 + (tok >> 6); }

#define XB_TMO      128
#define XB_XCNT(j)  (256  + 64 * (j))
#define XB_XSUB(j)  (1280 + 64 * (j))
#define XB_XGEN(j)  (2304 + 64 * (j))
#define XB_TOP      3328
#define XB_TOPGEN   3392
#define XCD_BAR_WORDS 3456
#define XB_SPIN_CAP (1u << 18)

__device__ __forceinline__ unsigned xb_ld(unsigned* p)              { return __hip_atomic_load(p, __ATOMIC_RELAXED, __HIP_MEMORY_SCOPE_AGENT); }
__device__ __forceinline__ unsigned xb_add(unsigned* p, unsigned v) { return __hip_atomic_fetch_add(p, v, __ATOMIC_RELAXED, __HIP_MEMORY_SCOPE_AGENT); }
__device__ __forceinline__ unsigned xb_xcc_id() { return (unsigned)__builtin_amdgcn_s_getreg((3 << 11) | 20) & 0xFu; }
#define XB_SPIN(cond, bar) do { unsigned _sp = 0; while (cond) { __builtin_amdgcn_s_sleep(1); \
    if ((++_sp & 255u) == 0u) { if (xb_ld(&(bar)[XB_TMO])) break; if (_sp > XB_SPIN_CAP) { atomicAdd(&(bar)[XB_TMO], 1u); break; } } } } while (0)

struct XcdBarrier {
    int wv;
    unsigned* bar; unsigned x;
    volatile LAS unsigned* st;
};

__device__ __forceinline__ XcdBarrier xcd_barrier_post(unsigned* bar, volatile LAS unsigned* st, int wv) {
    XcdBarrier b; b.bar = bar; b.x = xb_xcc_id(); b.st = st; b.wv = wv;
    if (wv == 0 && lane_id() == 0) (void)xb_add(&bar[XB_XCNT(b.x)], 1u);
    return b;
}
__device__ __forceinline__ void xcd_barrier_complete(unsigned* bar, unsigned x, unsigned& nloc, unsigned& nx) {
    const unsigned G = gridDim.x * gridDim.y * gridDim.z;
    unsigned sum, cnt, mine, sp = 0u;
    for (;;) {
        sum = 0u; cnt = 0u; mine = 0u;
#pragma unroll
        for (unsigned j = 0; j < 16; ++j) { const unsigned c = xb_ld(&bar[XB_XCNT(j)]); sum += c; cnt += (c > 0u) ? 1u : 0u; mine = (j == x) ? c : mine; }
        if (sum == G) break;
        __builtin_amdgcn_s_sleep(1);
        if ((++sp & 255u) == 0u) { if (xb_ld(&bar[XB_TMO])) break; if (sp > XB_SPIN_CAP) { atomicAdd(&bar[XB_TMO], 1u); break; } }
    }
    nloc = mine > 0u ? mine : 1u; nx = cnt > 0u ? cnt : 1u;
}

__device__ __forceinline__ void xcd_barrier(const XcdBarrier& b) {
    asm volatile("s_waitcnt vmcnt(0)" ::: "memory");
    __syncthreads();
    if (b.wv == 0 && lane_id() == 0) {
        unsigned* bar = b.bar;
        __builtin_amdgcn_s_waitcnt(0);
        unsigned nloc = b.st[0], nx = b.st[1];
        if (nloc == 0u) { xcd_barrier_complete(bar, b.x, nloc, nx); b.st[0] = nloc; b.st[1] = nx; }
        const unsigned old = xb_add(&bar[XB_XSUB(b.x)], 1u);
        const unsigned gen = old / nloc;
        if (old + 1u == (gen + 1u) * nloc) {
            __builtin_amdgcn_fence(__ATOMIC_RELEASE, "agent");
            asm volatile("s_waitcnt vmcnt(0)" ::: "memory");
            const unsigned og = xb_add(&bar[XB_TOP], 1u);
            const unsigned tg = og / nx;
            if (og + 1u == (tg + 1u) * nx) xb_add(&bar[XB_TOPGEN], 1u);
            else XB_SPIN(xb_ld(&bar[XB_TOPGEN]) == tg, bar);
            __builtin_amdgcn_fence(__ATOMIC_ACQUIRE, "agent");
            xb_add(&bar[XB_XGEN(b.x)], 1u);
            asm volatile("s_waitcnt vmcnt(0)" ::: "memory");
        } else {
            XB_SPIN(xb_ld(&bar[XB_XGEN(b.x)]) == gen, bar);
            __builtin_amdgcn_fence(__ATOMIC_ACQUIRE, "agent");
            asm volatile("s_waitcnt vmcnt(0)" ::: "memory");
        }
    }
    __syncthreads();
}


namespace pg8 {
constexpr int BM = 256, BK = 64, HALF = 128, HTB = HALF * BK * 2, NXCD = 8, WGM = 8;
__device__ __forceinline__ int lds_byte(int r, int c) { const int st = (r >> 4) * 2 + (c >> 5), rr = r & 15, cc = c & 31, ob = rr * 64 + cc * 2; return st * 1024 + (ob ^ (((ob >> 9) & 1) << 5)); }
__device__ __forceinline__ void stage_rc(int b, int& R, int& C) { const int st = b / 1024, sb = b % 1024, swz = sb ^ (((sb >> 9) & 1) << 5); R = (st >> 1) * 16 + swz / 64; C = (st & 1) * 32 + (swz % 64) / 2; }
__device__ __forceinline__ int perm32(int rho) { const int n = rho >> 4, i = rho & 15; return 8 * (i >> 2) + 4 * n + (i & 3); }
struct Unit { int pm, pn, grp; size_t aoff, boff; };
struct Gemm { const bf16_t* A; const bf16_t* Bt; int K, lda, ldb; };
struct Sched {
    int mode, nM, nN, nwg, G, c; size_t gA, gB, tA, tB;
    __device__ bool next(int i, Unit& u) const {
        const long L = (long)i * G + c; if (L >= nwg) return false;
        if (mode == 0) {
            int wgid = (int)L; { const int q = nwg / NXCD, r = nwg % NXCD, xcd = wgid % NXCD, off = wgid / NXCD; wgid = (xcd < r ? xcd * (q + 1) : r * (q + 1) + (xcd - r) * q) + off; }
            const int nig = WGM * nN, gid = wgid / nig, fm = gid * WGM, gsz = (nM - fm) < WGM ? (nM - fm) : WGM;
            u.pm = fm + ((wgid % nig) % gsz); u.pn = (wgid % nig) / gsz; u.grp = 0;
        } else {
            const int upg = nM * nN; u.grp = (int)L / upg; const int rem = (int)L % upg; u.pm = rem % nM; u.pn = rem / nM;
        }
        u.aoff = (size_t)u.grp * gA + (size_t)u.pm * tA; u.boff = (size_t)u.grp * gB + (size_t)u.pn * tB; return true;
    }
};

template <class Epi>
__device__ __forceinline__ void gemm_phase(LAS uchar* lds, const Gemm g, const Sched& S, const Epi& E, int wv) {
    const int tid = tid_of(wv), wid = __builtin_amdgcn_readfirstlane(tid >> 6), lane = tid & 63, wr = wid >> 2, wc = wid & 3, fr = lane & 15, fq = lane >> 4;
    const int K = g.K, nt = K / BK;
    unsigned voffA[2], voffB[2];
#pragma unroll
    for (int i = 0; i < 2; ++i) { int R, C; stage_rc(tid * 16 + i * 8192, R, C); const int Rb = Epi::PERM ? ((R & ~31) + perm32(R & 31)) : R;
        voffA[i] = (unsigned)(R * g.lda + C) * 2u; voffB[i] = (unsigned)(Rb * g.ldb + C) * 2u; }
    const size_t kstep = (size_t)(BK * 2);
    const size_t hstepA = (size_t)HALF * g.lda * 2, hstepB = (size_t)HALF * g.ldb * 2;
    const unsigned ldsw = (unsigned)wid * 1024u;
    const int aoff = lds_byte(wr * 64 + fr, fq * 8), boff = lds_byte(wc * 32 + fr, fq * 8);
#define PG8_SA(b, h) (((b) * 2 + (h)) * HTB)
#define PG8_SB(b, h) ((4 + (b) * 2 + (h)) * HTB)
#define PG8_STAGE(bufoff, gbase, voff) do { _Pragma("unroll") for (int _i = 0; _i < 2; ++_i) \
        __builtin_amdgcn_global_load_lds((const unsigned*)((const char*)(gbase) + (voff)[_i]), (LAS unsigned*)(lds + (bufoff) + ldsw + _i * 8192), 16, 0, 0); } while (0)
#define PG8_LDA(dst, b, h) do { _Pragma("unroll") for (int m = 0; m < 4; ++m) _Pragma("unroll") for (int k = 0; k < 2; ++k) dst[m][k] = *(const LAS bf16x8*)(lds + PG8_SA(b, h) + aoff + m * 2048 + k * 1024); } while (0)
#define PG8_LDB(dst, b, h) do { _Pragma("unroll") for (int n = 0; n < 2; ++n) _Pragma("unroll") for (int k = 0; k < 2; ++k) dst[n][k] = *(const LAS bf16x8*)(lds + PG8_SB(b, h) + boff + n * 2048 + k * 1024); } while (0)
#define PG8_MMA(ai, bj, At, Bt) do { __builtin_amdgcn_s_setprio(1); _Pragma("unroll") for (int m = 0; m < 4; ++m) _Pragma("unroll") for (int n = 0; n < 2; ++n) _Pragma("unroll") for (int k = 0; k < 2; ++k) \
        acc[ai][bj][m][n] = __builtin_amdgcn_mfma_f32_16x16x32_bf16(Bt[n][k], At[m][k], acc[ai][bj][m][n], 0, 0, 0); __builtin_amdgcn_s_setprio(0); } while (0)
#define PG8_WAIT_V(n) asm volatile("s_waitcnt vmcnt(" #n ")" ::: "memory")
#define PG8_WAIT_L(n) asm volatile("s_waitcnt lgkmcnt(" #n ")" ::: "memory")
#define PG8_BAR __builtin_amdgcn_s_barrier()
#define PG8_SCHED __builtin_amdgcn_sched_barrier(0)
    Unit cur, nxt; int ui = 0;
    if (!S.next(0, cur)) return;
    f32x4 acc[2][2][4][2];
#pragma unroll
    for (int a = 0; a < 2; ++a)
#pragma unroll
        for (int b = 0; b < 2; ++b)
#pragma unroll
            for (int m = 0; m < 4; ++m)
#pragma unroll
                for (int n = 0; n < 2; ++n) acc[a][b][m][n] = (f32x4){0.f, 0.f, 0.f, 0.f};
    bf16x8 At[4][2], B0[2][2], B1[2][2];
    const char* cA = (const char*)g.A + cur.aoff; const char* cB = (const char*)g.Bt + cur.boff;
    PG8_STAGE(PG8_SB(0, 0), cB, voffB); PG8_STAGE(PG8_SA(0, 0), cA, voffA); PG8_STAGE(PG8_SB(0, 1), cB + hstepB, voffB); PG8_STAGE(PG8_SA(0, 1), cA + hstepA, voffA);
    if (wr == 1) PG8_BAR;
    PG8_WAIT_V(4); PG8_BAR;
    PG8_STAGE(PG8_SB(1, 0), cB + kstep, voffB); PG8_STAGE(PG8_SA(1, 0), cA + kstep, voffA); PG8_STAGE(PG8_SB(1, 1), cB + hstepB + kstep, voffB);
    PG8_WAIT_V(6); PG8_BAR;
    for (;;) {
        const bool has_next = S.next(ui + 1, nxt);
        const char* nA = has_next ? (const char*)g.A + nxt.aoff : cA; const char* nB = has_next ? (const char*)g.Bt + nxt.boff : cB;
        for (int t = 0; t < nt; t += 2) {
            const bool last = (t == nt - 2);
            const char* a1 = cA + (size_t)(t + 1) * kstep;
            const char* a2 = last ? nA : cA + (size_t)(t + 2) * kstep; const char* b2 = last ? nB : cB + (size_t)(t + 2) * kstep;
            const char* a3 = a2 + kstep; const char* b3 = b2 + kstep;
            PG8_LDB(B0, 0, 0); PG8_SCHED; PG8_LDA(At, 0, 0); PG8_STAGE(PG8_SA(1, 1), a1 + hstepA, voffA);
            PG8_WAIT_L(8); PG8_BAR; PG8_WAIT_L(0); PG8_MMA(0, 0, At, B0); PG8_BAR; PG8_SCHED;
            PG8_LDB(B1, 0, 1); PG8_STAGE(PG8_SB(0, 0), b2, voffB);
            PG8_BAR; PG8_WAIT_L(0); PG8_MMA(0, 1, At, B1); PG8_BAR;
            PG8_LDA(At, 0, 1); PG8_STAGE(PG8_SA(0, 0), a2, voffA);
            PG8_BAR; PG8_WAIT_L(0); PG8_MMA(1, 0, At, B0); PG8_BAR; PG8_SCHED;
            PG8_STAGE(PG8_SB(0, 1), b2 + hstepB, voffB);
            PG8_WAIT_V(6); PG8_BAR; PG8_MMA(1, 1, At, B1); PG8_BAR;
            PG8_LDB(B0, 1, 0); PG8_SCHED; PG8_LDA(At, 1, 0); PG8_STAGE(PG8_SA(0, 1), a2 + hstepA, voffA);
            PG8_WAIT_L(8); PG8_BAR; PG8_WAIT_L(0); PG8_MMA(0, 0, At, B0); PG8_BAR; PG8_SCHED;
            PG8_LDB(B1, 1, 1); PG8_STAGE(PG8_SB(1, 0), b3, voffB);
            PG8_BAR; PG8_WAIT_L(0); PG8_MMA(0, 1, At, B1); PG8_BAR;
            PG8_LDA(At, 1, 1); PG8_STAGE(PG8_SA(1, 0), a3, voffA);
            PG8_BAR; PG8_WAIT_L(0); PG8_MMA(1, 0, At, B0); PG8_BAR; PG8_SCHED;
            PG8_STAGE(PG8_SB(1, 1), b3 + hstepB, voffB);
            PG8_WAIT_V(6); PG8_BAR; PG8_MMA(1, 1, At, B1); PG8_BAR;
        }
        E(acc, cur, wr, wc, fr, fq);
        if (!has_next) break;
#pragma unroll
        for (int a = 0; a < 2; ++a)
#pragma unroll
            for (int b = 0; b < 2; ++b)
#pragma unroll
                for (int m = 0; m < 4; ++m)
#pragma unroll
                    for (int n = 0; n < 2; ++n) acc[a][b][m][n] = (f32x4){0.f, 0.f, 0.f, 0.f};
        cur = nxt; cA = nA; cB = nB; ++ui;
    }
    PG8_WAIT_V(0);
    if (wr == 0) PG8_BAR;
    PG8_BAR;
#undef PG8_SA
#undef PG8_SB
#undef PG8_STAGE
#undef PG8_LDA
#undef PG8_LDB
#undef PG8_MMA
#undef PG8_WAIT_V
#undef PG8_WAIT_L
#undef PG8_BAR
#undef PG8_SCHED
}
}
using pg8::Unit;

struct EpiZ {
    static constexpr bool PERM = true;
    bf16_t* Z; bf16_t* A2;
    __device__ __forceinline__ void operator()(const f32x4 (&acc)[2][2][4][2], const Unit& u, int wr, int wc, int fr, int fq) const {
#pragma unroll
        for (int ai = 0; ai < 2; ++ai)
#pragma unroll
            for (int m = 0; m < 4; ++m) {
                const int r = u.pm * 256 + ai * 128 + wr * 64 + m * 16 + fr;
#pragma unroll
                for (int bj = 0; bj < 2; ++bj) {
                    const int c = u.pn * 256 + bj * 128 + wc * 32 + 8 * fq;
                    u32x4 w; w.x = pk2(acc[ai][bj][m][0][0], acc[ai][bj][m][0][1]); w.y = pk2(acc[ai][bj][m][0][2], acc[ai][bj][m][0][3]);
                    w.z = pk2(acc[ai][bj][m][1][0], acc[ai][bj][m][1][1]); w.w = pk2(acc[ai][bj][m][1][2], acc[ai][bj][m][1][3]);
                    if (u.pn == 0) {
                        const int b = r / TT, j = r - b * TT, n = s5pos(j), R = b * NCH + (n >> 5), s = n & 31, g = c >> 4, h0 = c & 15;
                        bf16_t* d0 = A2 + ((size_t)((g * 2) * GROWS + R)) * 640 + s * 16 + h0;
                        *(u32x4*)d0 = w; *(u32x4*)(d0 + (size_t)GROWS * 640) = w;
                    } else {
                        const int zc = c - 256;
                        if (zc < ZLD) *(u32x4*)(Z + (size_t)r * ZLD + zc) = w;
                    }
                }
            }
    }
};
struct EpiResid {
    static constexpr bool PERM = false;
    const float* xin; float* xout; const float* cin; float* cout; const float* mod; int gidx;
    __device__ __forceinline__ void operator()(const f32x4 (&acc)[2][2][4][2], const Unit& u, int wr, int wc, int fr, int fq) const {
        const int b = u.pm / 33, tb = u.pm - b * 33;
        const bool isctx = (tb == 0);
        const float* gate = mod + (size_t)(isctx ? 4 : b) * 6144 + gidx * 1024;
        const size_t row0 = isctx ? (size_t)b * CTX : (size_t)b * SEQ + (size_t)(tb - 1) * 256;
        const float* src = isctx ? cin : xin; float* dst = isctx ? cout : xout;
        const int col0 = u.pn * 256 + wc * 32 + 4 * fq;
#pragma unroll
        for (int ai = 0; ai < 2; ++ai)
#pragma unroll
            for (int m = 0; m < 4; ++m) {
                const size_t ro = (row0 + ai * 128 + wr * 64 + m * 16 + fr) * DM;
#pragma unroll
                for (int bj = 0; bj < 2; ++bj)
#pragma unroll
                    for (int n = 0; n < 2; ++n) {
                        const int c = col0 + bj * 128 + n * 16;
                        const f32x4 gv = *(const f32x4*)(gate + c); const f32x4 xv = *(const f32x4*)(src + ro + c);
                        *(f32x4*)(dst + ro + c) = xv + gv * acc[ai][bj][m][n];
                    }
                asm volatile("" ::: "memory");
            }
    }
};
struct EpiSwiGLU {
    static constexpr bool PERM = false;
    bf16_t* HID;
    __device__ __forceinline__ void operator()(const f32x4 (&acc)[2][2][4][2], const Unit& u, int wr, int wc, int fr, int fq) const {
#pragma unroll
        for (int ai = 0; ai < 2; ++ai)
#pragma unroll
            for (int m = 0; m < 4; ++m) {
                const size_t r = (size_t)(u.pm * 256 + ai * 128 + wr * 64 + m * 16 + fr);
#pragma unroll
                for (int bj = 0; bj < 2; ++bj) {
                    const int hc = u.pn * 128 + bj * 64 + wc * 16 + 4 * fq;
                    f32x4 o;
#pragma unroll
                    for (int i = 0; i < 4; ++i) o[i] = siluf_(acc[ai][bj][m][0][i]) * acc[ai][bj][m][1][i];
                    *(u32x2*)(HID + r * FFN + hc) = pk4(o);
                }
                asm volatile("" ::: "memory");
            }
    }
};
struct EpiHL {
    static constexpr bool PERM = false;
    float* HL;
    __device__ __forceinline__ void operator()(const f32x4 (&acc)[2][2][4][2], const Unit& u, int wr, int wc, int fr, int fq) const {
#pragma unroll
        for (int ai = 0; ai < 2; ++ai)
#pragma unroll
            for (int m = 0; m < 4; ++m) {
                const int R = u.pm * 256 + ai * 128 + wr * 64 + m * 16 + fr;
                if (R < GROWS) {
                    float* rp = HL + ((size_t)u.grp * GROWS + R) * 256 + wc * 32 + 4 * fq;
#pragma unroll
                    for (int bj = 0; bj < 2; ++bj)
#pragma unroll
                        for (int n = 0; n < 2; ++n) *(f32x4*)(rp + bj * 128 + n * 16) = acc[ai][bj][m][n];
                }
                asm volatile("" ::: "memory");
            }
    }
};
struct EpiY5 {
    static constexpr bool PERM = true;
    bf16_t* Y5;
    __device__ __forceinline__ void operator()(const f32x4 (&acc)[2][2][4][2], const Unit& u, int wr, int wc, int fr, int fq) const {
#pragma unroll
        for (int ai = 0; ai < 2; ++ai)
#pragma unroll
            for (int m = 0; m < 4; ++m) {
                const int R = u.pm * 256 + ai * 128 + wr * 64 + m * 16 + fr;
                if (R < GROWS) {
                    bf16_t* rp = Y5 + ((size_t)u.grp * GROWS + R) * 512 + u.pn * 256 + wc * 32 + 8 * fq;
#pragma unroll
                    for (int bj = 0; bj < 2; ++bj) {
                        u32x4 w; w.x = pk2(acc[ai][bj][m][0][0], acc[ai][bj][m][0][1]); w.y = pk2(acc[ai][bj][m][0][2], acc[ai][bj][m][0][3]);
                        w.z = pk2(acc[ai][bj][m][1][0], acc[ai][bj][m][1][1]); w.w = pk2(acc[ai][bj][m][1][2], acc[ai][bj][m][1][3]);
                        *(u32x4*)(rp + bj * 128) = w;
                    }
                }
            }
    }
};

__device__ __forceinline__ pg8::Sched sched_static(int M, int N, int lda, int ldb) {
    pg8::Sched S; S.mode = 0; S.nM = M / 256; S.nN = N / 256; S.nwg = S.nM * S.nN; S.G = gridDim.x; S.c = bidx();
    S.gA = 0; S.gB = 0; S.tA = (size_t)256 * lda * 2; S.tB = (size_t)256 * ldb * 2; return S;
}

__device__ __forceinline__ void phase_mod(const PP& p, float* sm) {
    float* sv = sm;
    float* part = sm + 5 * 1024;
    const int tid = tid_of(p.wv), w = tid >> 6, lane = tid & 63;
    for (int i = tid; i < 5 * 1024; i += 512) { const int v = i >> 10, k = i & 1023; const float x = v < 4 ? p.in[I_C][v * 1024 + k] : p.in[I_CCTX][k]; sv[i] = siluf_(x); }
    __syncthreads();
    float* mod = (float*)(p.ws + OFF_MOD);
    for (int it = bidx(); it < DEPTH * 48; it += gridDim.x) {
        const int l = it / 48, cb = it - l * 48, col = cb * 128 + 2 * lane;
        const float* W = p.in[I_ADAW] + (size_t)l * 1024 * 6144 + col;
        f32x2 a[5];
#pragma unroll
        for (int i = 0; i < 5; ++i) a[i] = (f32x2){0.f, 0.f};
#pragma unroll 8
        for (int k = w * 128; k < w * 128 + 128; ++k) {
            const f32x2 wv = *(const f32x2*)(W + (size_t)k * 6144);
#pragma unroll
            for (int i = 0; i < 5; ++i) a[i] += sv[i * 1024 + k] * wv;
        }
#pragma unroll
        for (int i = 0; i < 5; ++i) { part[(w * 5 + i) * 128 + 2 * lane] = a[i].x; part[(w * 5 + i) * 128 + 2 * lane + 1] = a[i].y; }
        __syncthreads();
        for (int o = tid; o < 640; o += 512) { const int i = o >> 7, cc = o & 127; float s = 0.f;
#pragma unroll
            for (int ww = 0; ww < 8; ++ww) s += part[(ww * 5 + i) * 128 + cc];
            mod[((size_t)l * 5 + i) * 6144 + cb * 128 + cc] = s + p.in[I_ADAB][l * 6144 + cb * 128 + cc]; }
        __syncthreads();
    }
}

__device__ __forceinline__ int n_coef_blocks() { return gridDim.x >= 128 ? 64 : 0; }
__device__ __forceinline__ void convT_tile(const float* src, const float* src2, int ldn, bf16_t* dst, int K, int kind, int n0, int k0, float* sm, int wv) {
    const int tid = tid_of(wv);
    {
        const int nn = tid & 63, kq = tid >> 6;
        const int np = n0 + nn; const float* s = src; int col;
        if (kind == 0) col = np < 256 ? 2968 + np : (np < 3224 ? np - 256 : -1);
        else if (kind == 1) col = np;
        else { const int G = np >> 5, w = np & 31; col = 16 * G + (w & 15); if (w >= 16) s = src2; }
#pragma unroll
        for (int i = 0; i < 8; ++i) { const int kk = kq + 8 * i; sm[kk * 65 + nn] = col >= 0 ? s[(size_t)(k0 + kk) * ldn + col] : 0.f; }
    }
    __syncthreads();
    {
        const int n = tid >> 3, ks = (tid & 7) * 8;
        u32x4 w; w.x = pk2(sm[(ks + 0) * 65 + n], sm[(ks + 1) * 65 + n]); w.y = pk2(sm[(ks + 2) * 65 + n], sm[(ks + 3) * 65 + n]);
        w.z = pk2(sm[(ks + 4) * 65 + n], sm[(ks + 5) * 65 + n]); w.w = pk2(sm[(ks + 6) * 65 + n], sm[(ks + 7) * 65 + n]);
        *(u32x4*)(dst + (size_t)(n0 + n) * K + k0 + ks) = w;
    }
    __syncthreads();
}
__device__ __forceinline__ void phase_convw(const PP& p, int l, float* sm, int w0, int nwb, int ffn) {
    constexpr int T0 = 832, T1 = T0 + 256, T2 = T1 + 1408, T3 = T2 + 704, T4 = T3 + 12, T5 = T4 + 12, T6 = T5 + 12, T7 = T6 + 16;
    const int wb = bidx() - w0;
    if (wb < 0 || wb >= nwb) return;
    const int nt = ffn ? (T3 - T1) : (T7 - (T3 - T1));
    for (int tt = wb; tt < nt; tt += nwb) {
        const int t = ffn ? tt + T1 : (tt < T1 ? tt : tt + (T3 - T1));
        if (t < T0) { convT_tile(p.in[I_WIN] + (size_t)l * 1024 * 3224, nullptr, 3224, (bf16_t*)(p.ws + OFF_WIN), 1024, 0, (t >> 4) * 64, (t & 15) * 64, sm, p.wv); }
        else if (t < T1) { const int q = t - T0; convT_tile(p.in[I_WOUT] + (size_t)l * 1024 * 1024, nullptr, 1024, (bf16_t*)(p.ws + OFF_WOUT), 1024, 1, (q >> 4) * 64, (q & 15) * 64, sm, p.wv); }
        else if (t < T2) { const int q = t - T1; convT_tile(p.in[I_FG8] + (size_t)l * 1024 * FFN, p.in[I_FU] + (size_t)l * 1024 * FFN, FFN, (bf16_t*)(p.ws + OFF_WGU), 1024, 2, (q >> 4) * 64, (q & 15) * 64, sm, p.wv); }
        else if (t < T3) { const int q = t - T2; convT_tile(p.in[I_FD] + (size_t)l * FFN * 1024, nullptr, 1024, (bf16_t*)(p.ws + OFF_WDN), FFN, 1, (q / 44) * 64, (q % 44) * 64, sm, p.wv); }
        else if (t < T4) { const int q = t - T3, d = q / 6; convT_tile(p.in[I_WUP] + ((size_t)l * 2 + d) * 64 * 384, nullptr, 384, (bf16_t*)(p.ws + OFF_WUP) + d * 384 * 64, 64, 1, (q % 6) * 64, 0, sm, p.wv); }
        else if (t < T5) { const int q = t - T4, d = q / 6; convT_tile(p.in[I_AUP] + ((size_t)l * 2 + d) * 64 * 384, nullptr, 384, (bf16_t*)(p.ws + OFF_AUP) + d * 384 * 64, 64, 1, (q % 6) * 64, 0, sm, p.wv); }
        else if (t < T6) { const int q = t - T5; convT_tile(p.in[I_GUP] + (size_t)l * 128 * 384, nullptr, 384, (bf16_t*)(p.ws + OFF_GUP), 128, 1, (q >> 1) * 64, (q & 1) * 64, sm, p.wv); }
        else { const int q = t - T6; convT_tile(p.in[I_GLUW] + (size_t)l * 256 * 256, nullptr, 256, (bf16_t*)(p.ws + OFF_GLU), 256, 1, (q >> 2) * 64, (q & 3) * 64, sm, p.wv); }
    }
}

__device__ __forceinline__ void phase_s5coef(const PP& p, int l, float* sm) {
    float* pw = sm;
    float* bb = pw + 33 * 128;
    float* cc = bb + 2048;
    float* Kt = cc + 2048;
    const int tid = tid_of(p.wv);
    bf16_t* TF = (bf16_t*)(p.ws + OFF_TF); bf16_t* E2 = (bf16_t*)(p.ws + OFF_E2); float* DP = (float*)(p.ws + OFF_DP);
    for (int item = (int)gridDim.x - 1 - (int)bidx(); item < 64; item += gridDim.x) {
        const int it = item >> 1, part = item & 1, g = it >> 1, dir = it & 1;
        const size_t base = ((size_t)l * 2 + dir) * 16 + g;
        if (tid < 64) {
            const int q = tid;
            const float lre = p.in[I_LRE][base * 64 + q], lim = p.in[I_LIM][base * 64 + q], dt = __expf(p.in[I_LDT][base]);
            const float mag = __expf(lre * dt); float sn, cs; sincosf(lim * dt, &sn, &cs);
            const float are = mag * cs, aim = mag * sn, den = lre * lre + lim * lim;
            const float fre = ((are - 1.f) * lre + aim * lim) / den, fim = (aim * lre - (are - 1.f) * lim) / den;
            float pr = 1.f, pi = 0.f;
            for (int m = 0; m <= 32; ++m) { pw[(m * 64 + q) * 2] = pr; pw[(m * 64 + q) * 2 + 1] = pi; const float nr = pr * are - pi * aim, ni = pr * aim + pi * are; pr = nr; pi = ni; }
            for (int h = 0; h < 16; ++h) { const float br = p.in[I_BRE][(base * 64 + q) * 16 + h], bi = p.in[I_BIM][(base * 64 + q) * 16 + h];
                bb[(q * 16 + h) * 2] = fre * br - fim * bi; bb[(q * 16 + h) * 2 + 1] = fre * bi + fim * br; }
            if (part == 0) { DP[(it * 64 + q) * 2] = pw[(32 * 64 + q) * 2]; DP[(it * 64 + q) * 2 + 1] = pw[(32 * 64 + q) * 2 + 1]; }
        }
        for (int i = tid; i < 1024; i += 512) { const int h = i >> 6, q = i & 63; cc[i * 2] = p.in[I_CRE][(base * 16 + h) * 64 + q]; cc[i * 2 + 1] = p.in[I_CIM][(base * 16 + h) * 64 + q]; }
        __syncthreads();
        {
            const int lag = tid >> 4, hp = tid & 15;
            float s[16];
#pragma unroll
            for (int h = 0; h < 16; ++h) s[h] = 0.f;
            for (int q = 0; q < 64; ++q) {
                const f32x2 c2 = *(const f32x2*)(cc + (hp * 64 + q) * 2), w2 = *(const f32x2*)(pw + (lag * 64 + q) * 2);
                const float xr = c2.x * w2.x - c2.y * w2.y, xi = c2.x * w2.y + c2.y * w2.x;
#pragma unroll
                for (int h4 = 0; h4 < 8; ++h4) { const f32x4 b4 = *(const f32x4*)(bb + (q * 16 + 2 * h4) * 2); s[2 * h4] += xr * b4[0] - xi * b4[1]; s[2 * h4 + 1] += xr * b4[2] - xi * b4[3]; }
            }
#pragma unroll
            for (int h4 = 0; h4 < 4; ++h4) *(f32x4*)(Kt + lag * 256 + hp * 16 + 4 * h4) = (f32x4){s[4 * h4], s[4 * h4 + 1], s[4 * h4 + 2], s[4 * h4 + 3]};
        }
        __syncthreads();
        bf16_t* tf = TF + (size_t)it * 512 * 640;
        for (int o = part * 256 * 320 + tid; o < (part + 1) * 256 * 320; o += 512) {
            const int row = o / 320, c2 = (o - row * 320) * 2, t = row >> 4, hp = row & 15;
            float v[2];
            if (c2 < 512) {
#pragma unroll
                for (int e = 0; e < 2; ++e) { const int col = c2 + e, s = col >> 4, h = col & 15; const int lag = dir == 0 ? t - s : s - t; v[e] = lag >= 0 ? Kt[lag * 256 + hp * 16 + h] : 0.f; }
            } else {
                const int q = (c2 - 512) >> 1, m = dir == 0 ? t + 1 : 32 - t;
                const float cr = cc[(hp * 64 + q) * 2], ci = cc[(hp * 64 + q) * 2 + 1], wr_ = pw[(m * 64 + q) * 2], wi = pw[(m * 64 + q) * 2 + 1];
                v[0] = cr * wr_ - ci * wi; v[1] = -(cr * wi + ci * wr_);
            }
            *(unsigned*)(tf + (size_t)row * 640 + c2) = pk2(v[0], v[1]);
        }
        bf16_t* e2 = E2 + ((size_t)g * 256 + dir * 128) * 512;
        for (int o = part * 64 * 256 + tid; o < (part + 1) * 64 * 256; o += 512) {
            const int row = o >> 8, c2 = (o & 255) * 2, q = row >> 1, ri = row & 1; float v[2];
#pragma unroll
            for (int e = 0; e < 2; ++e) { const int col = c2 + e, s = col >> 4, h = col & 15, ex = dir == 0 ? 31 - s : s;
                const float wr_ = pw[(ex * 64 + q) * 2], wi = pw[(ex * 64 + q) * 2 + 1], br = bb[(q * 16 + h) * 2], bi = bb[(q * 16 + h) * 2 + 1];
                v[e] = ri == 0 ? (wr_ * br - wi * bi) : (wr_ * bi + wi * br); }
            *(unsigned*)(e2 + (size_t)row * 512 + c2) = pk2(v[0], v[1]);
        }
        __syncthreads();
    }
}

__device__ __forceinline__ void phase_norm(const PP& p, int l, int which, const float* xsrc, const float* csrc, int share) {
    const int nwb = (int)gridDim.x - (share ? n_coef_blocks() : 0);
    if (bidx() >= nwb) return;
    const int lane = tid_of(p.wv) & 63, gw = bidx() * 8 + (tid_of(p.wv) >> 6), nw = nwb * 8;
    const float* gain = p.in[which == 0 ? I_N1G : I_N2G] + l * 1024;
    const float* mod = (const float*)(p.ws + OFF_MOD) + (size_t)l * 5 * 6144;
    bf16_t* H = (bf16_t*)(p.ws + OFF_H);
    for (int r = gw; r < MROWS; r += nw) {
        const int b = r / TT, j = r - b * TT;
        const float* src = j < CTX ? csrc + ((size_t)b * CTX + j) * DM : xsrc + ((size_t)b * SEQ + (j - CTX)) * DM;
        const float* mv = mod + (size_t)(j < CTX ? 4 : b) * 6144 + (which == 0 ? 0 : 3072);
        f32x4 v[4]; float ss = 0.f;
#pragma unroll
        for (int i = 0; i < 4; ++i) { v[i] = *(const f32x4*)(src + i * 256 + lane * 4); ss += v[i][0] * v[i][0] + v[i][1] * v[i][1] + v[i][2] * v[i][2] + v[i][3] * v[i][3]; }
        ss = red64(ss);
        const float rs = __builtin_amdgcn_rsqf(ss * (1.f / 1024.f) + 1e-6f);
#pragma unroll
        for (int i = 0; i < 4; ++i) {
            const int c = i * 256 + lane * 4;
            const f32x4 gv = *(const f32x4*)(gain + c), sh = *(const f32x4*)(mv + c), sc = *(const f32x4*)(mv + 1024 + c);
            const f32x4 y = v[i] * rs * gv * (sc + 1.f) + sh;
            *(u32x2*)(H + (size_t)r * DM + c) = pk4(y);
        }
    }
}
__device__ __forceinline__ void phase_final(const PP& p) {
    const int lane = tid_of(p.wv) & 63, gw = bidx() * 8 + (tid_of(p.wv) >> 6), nw = gridDim.x * 8;
    const float* gain = p.in[I_FG];
    for (int r = gw; r < NB * SEQ; r += nw) {
        float* src = p.out + (size_t)r * DM;
        f32x4 v[4]; float ss = 0.f;
#pragma unroll
        for (int i = 0; i < 4; ++i) { v[i] = *(const f32x4*)(src + i * 256 + lane * 4); ss += v[i][0] * v[i][0] + v[i][1] * v[i][1] + v[i][2] * v[i][2] + v[i][3] * v[i][3]; }
        ss = red64(ss);
        const float rs = __builtin_amdgcn_rsqf(ss * (1.f / 1024.f) + 1e-6f);
#pragma unroll
        for (int i = 0; i < 4; ++i) { const int c = i * 256 + lane * 4; const f32x4 gv = *(const f32x4*)(gain + c); *(f32x4*)(src + c) = v[i] * rs * gv; }
    }
}

struct Nb3 { u32x2 pv, cu, nx; };
__device__ __forceinline__ Nb3 ld3(const bf16_t* Z, int row, bool hp, bool hn, int col) {
    Nb3 o; const bf16_t* q = Z + (size_t)row * ZLD + col;
    o.cu = *(const u32x2*)q;
    o.pv = hp ? *(const u32x2*)(q - ZLD) : (u32x2){0u, 0u};
    o.nx = hn ? *(const u32x2*)(q + ZLD) : (u32x2){0u, 0u};
    return o;
}
__device__ __forceinline__ f32x4 shiftmix(const Nb3& v, const float* mu) {
    const f32x4 c = unpk4(v.cu), a = unpk4(v.pv), n = unpk4(v.nx), m = *(const f32x4*)mu;
    return c + ((a + n) * 0.5f - c) * m;
}


constexpr int RWP_LD = 896;
__device__ __forceinline__ void phase_rwprep(const PP& p, int l) {
    const bf16_t* Z = (const bf16_t*)(p.ws + OFF_Z);
    bf16_t* RWP = (bf16_t*)(p.ws + OFF_H);
    const float* mu = p.in[I_MU] + l * 1408;
    const int nth = gridDim.x * 512;
    for (int idx = bidx() * 512 + tid_of(p.wv); idx < MROWS * 224; idx += nth) {
        const int row = idx / 224, qd = idx - row * 224, col0 = 4 * qd, zc = col0 < 768 ? col0 : col0 + 384;
        const int b = row / TT, j = row - b * TT;
        const bool hp = (j != 0) && (j != CTX), hn = (j != CTX - 1) && (j != TT - 1);
        f32x4 v = shiftmix(ld3(Z, row, hp, hn, zc), mu + zc);
        if (col0 >= 768 && col0 < 832) {
#pragma unroll
            for (int i = 0; i < 4; ++i) v[i] = tanhf_(v[i]);
        }
        *(u32x2*)(RWP + (size_t)row * RWP_LD + col0) = pk4(v);
    }
}

namespace ck {
constexpr int PC_STRIDE = 18432, PCB_BYTES = 36864, WKS0 = 73728, WKS_BYTES = 9216, WKP0 = 110592, WKP_BYTES = 3072, SW0 = 116736, SAA0 = 134144, SY0 = 151552, CST0 = 159744, SWLD = 68, SWBUF = 32 * 68;
__device__ __forceinline__ bf16x8 mk8(u32x2 lo, u32x2 hi) { u32x4 t; t.x = lo.x; t.y = lo.y; t.z = hi.x; t.w = hi.y; return __builtin_bit_cast(bf16x8, t); }
__device__ __forceinline__ bf16x8 pk8z(f32x4 v) { return mk8(pk4(v), (u32x2){0u, 0u}); }
#define CK_MFMA(a, b, c) __builtin_amdgcn_mfma_f32_16x16x32_bf16(a, b, c, 0, 0, 0)
__device__ __forceinline__ int krow(int k) { return (k & ~3) | ((k + (k >> 3)) & 3); }
template <int TYPE, bool MIDBAR>
__device__ __forceinline__ void prep_wave(const char* pc, char* wkp, char* wks, int lane) {
    const int row16 = lane & 15, q = lane >> 4;
    const u32x2 Z2 = (u32x2){0u, 0u};
    const f32x4 z4 = (f32x4){0.f, 0.f, 0.f, 0.f};
    float* AMak = (float*)wkp; float* AMrb = (float*)(wkp + 1024); float* AMrk = (float*)(wkp + 2048);
    bf16_t* W1row = (bf16_t*)wks; bf16_t* R2row = (bf16_t*)(wks + 2304);
    const bf16_t* GA = (const bf16_t*)pc; const bf16_t* GR = (const bf16_t*)(pc + 2304); const bf16_t* GB = (const bf16_t*)(pc + 4608);
    const bf16_t* GK = (const bf16_t*)(pc + (TYPE == 0 ? 6912 : 4608));
    const bf16_t* GAT = (const bf16_t*)(pc + 9216); const bf16_t* VT = (const bf16_t*)(pc + 15360);
    const float* gc = (const float*)(pc + 17408);
    f32x4 gab = z4, gabT = z4, gak = z4, grb = z4, grk = z4;
#pragma unroll
    for (int ks = 0; ks < 2; ++ks) {
        const int o = row16 * 72 + 8 * q + 32 * ks;
        const bf16x8 ra = *(const bf16x8*)(GA + o), rr = *(const bf16x8*)(GR + o), cbf = *(const bf16x8*)(GB + o), ckf = *(const bf16x8*)(GK + o);
        gab = CK_MFMA(ra, cbf, gab); gabT = CK_MFMA(cbf, ra, gabT); gak = CK_MFMA(ra, ckf, gak); grb = CK_MFMA(rr, cbf, grb); grk = CK_MFMA(rr, ckf, grk);
    }
#pragma unroll
    for (int r = 0; r < 4; ++r) {
        const int t = 4 * q + r, i = row16; const bool ks_ = i < t, kl = i <= t;
        float dS = 1.f, dL = 1.f, dT = 1.f;
        if (TYPE == 1) { const float gi = gc[i]; dS = __expf(ks_ ? gc[t > 0 ? t - 1 : 0] - gi : 0.f); dL = __expf(kl ? gc[t] - gi : 0.f);
                         const int t2 = row16, i2 = 4 * q + r; dT = __expf(i2 < t2 ? gc[t2 - 1] - gc[i2] : 0.f); }
        gab[r] = ks_ ? gab[r] * dS : 0.f; gak[r] = ks_ ? gak[r] * dS : 0.f; grb[r] = kl ? grb[r] * dL : 0.f; grk[r] = kl ? grk[r] * dL : 0.f;
        gabT[r] = (4 * q + r < row16) ? gabT[r] * dT : 0.f;
    }
    f32x4 A = gab, AT = gabT, MT;
#pragma unroll
    for (int r = 0; r < 4; ++r) MT[r] = AT[r] + ((4 * q + r == row16) ? 1.f : 0.f);
#pragma unroll
    for (int s = 0; s < 3; ++s) {
        const bf16x8 pa = pk8z(A), pat = pk8z(AT);
        const f32x4 A2 = CK_MFMA(pat, pa, z4);
        MT = CK_MFMA(pk8z(A2), pk8z(MT), MT);
        if (s < 2) { AT = CK_MFMA(pa, pat, z4); A = A2; }
    }
    if (MIDBAR) lbar();
    const bf16x8 mplain = pk8z(MT);
    bf16x8 mfA = mplain;
    if (TYPE == 1) mfA = pk8z(MT * *(const f32x4*)(gc + 32 + 4 * q));
#pragma unroll
    for (int r = 0; r < 4; ++r) { AMak[(4 * q + r) * 16 + row16] = gak[r]; AMrb[(4 * q + r) * 16 + row16] = grb[r]; AMrk[(4 * q + r) * 16 + row16] = grk[r]; }
    const f32x4 aak4 = *(const f32x4*)(AMak + row16 * 16 + 4 * q), arb4 = *(const f32x4*)(AMrb + row16 * 16 + 4 * q), ark4 = *(const f32x4*)(AMrk + row16 * 16 + 4 * q);
    const bf16x8 arbB = pk8z(arb4);
#pragma unroll
    for (int nt = 0; nt < 4; ++nt) {
        const bf16x8 gfB = mk8(*(const u32x2*)(GAT + krow(16 * nt + row16) * 16 + 4 * q), Z2);
        const f32x4 W1n = CK_MFMA(mfA, gfB, z4);
        const f32x4 W1T = CK_MFMA(gfB, mfA, z4);
        *(u32x2*)(W1row + row16 * 72 + 16 * nt + 4 * q) = pk4(W1T);
        f32x4 cin = unpk4(*(const u32x2*)(GR + row16 * 72 + 16 * nt + 4 * q));
        if (TYPE == 1) cin = cin * gc[16 + row16];
        const f32x4 R2T = CK_MFMA(pk8z(W1n), arbB, cin);
        *(u32x2*)(R2row + row16 * 72 + 16 * nt + 4 * q) = pk4(R2T);
    }
    const bf16x8 aakA = pk8z(aak4), arbk = mk8(pk4(arb4), pk4(ark4));
#pragma unroll
    for (int vt = 0; vt < 2; ++vt) {
        const u32x2 vtf = *(const u32x2*)(VT + krow(16 * vt + row16) * 16 + 4 * q);
        const f32x4 AV = CK_MFMA(aakA, mk8(vtf, Z2), z4);
        const f32x4 W2 = CK_MFMA(mplain, pk8z(AV), z4);
        const f32x4 Y3 = CK_MFMA(arbk, mk8(pk4(W2), vtf), z4);
        f32x4* C2 = (f32x4*)(wks + 4608 + vt * 2048);
        C2[lane] = W2; C2[64 + lane] = Y3;
    }
}
template <int TYPE>
__device__ __forceinline__ void seq_wave(const char* pc, const char* wks, float* sYc, int vt, int lane, f32x4 (&Sreg)[4]) {
    const int row16 = lane & 15, q = lane >> 4;
    const bf16_t* W1row = (const bf16_t*)wks; const bf16_t* R2row = (const bf16_t*)(wks + 2304); const f32x4* C2 = (const f32x4*)(wks + 4608 + vt * 2048);
    const bf16_t* GBT = (const bf16_t*)(pc + 11264); const bf16_t* GKT = (const bf16_t*)(pc + (TYPE == 0 ? 13312 : 11264)); const bf16_t* VST = (const bf16_t*)(pc + 16384);
    const float* gc = (const float*)(pc + 17408); const float* pC = (const float*)(pc + 17664);
    f32x4 U = C2[lane], Y = C2[64 + lane];
#pragma unroll
    for (int ks = 0; ks < 2; ++ks) {
        const bf16x8 sf = mk8(pk4(Sreg[2 * ks]), pk4(Sreg[2 * ks + 1]));
        const bf16x8 a1 = mk8(*(const u32x2*)(W1row + row16 * 72 + 32 * ks + 4 * q), *(const u32x2*)(W1row + row16 * 72 + 32 * ks + 16 + 4 * q));
        const bf16x8 a2 = mk8(*(const u32x2*)(R2row + row16 * 72 + 32 * ks + 4 * q), *(const u32x2*)(R2row + row16 * 72 + 32 * ks + 16 + 4 * q));
        U = CK_MFMA(a1, sf, U);
        Y = CK_MFMA(a2, sf, Y);
    }
#pragma unroll
    for (int r = 0; r < 4; ++r) sYc[(4 * q + r) * 32 + 16 * vt + row16] = Y[r];
    if (TYPE == 1) U = U * *(const f32x4*)(gc + 48 + 4 * q);
    const bf16x8 ub = mk8(pk4(U), *(const u32x2*)(VST + krow(16 * vt + row16) * 16 + 4 * q));
#pragma unroll
    for (int kt = 0; kt < 4; ++kt) {
        const bf16x8 ak = mk8(*(const u32x2*)(GBT + krow(16 * kt + row16) * 16 + 4 * q), *(const u32x2*)(GKT + krow(16 * kt + row16) * 16 + 4 * q));
        const f32x4 pc4 = *(const f32x4*)(pC + 16 * kt + 4 * q);
        if (TYPE == 0) Sreg[kt] = CK_MFMA(ak, ub, Sreg[kt]) * pc4;
        else Sreg[kt] = CK_MFMA(ak, ub, Sreg[kt] * pc4);
    }
}
template <int TYPE, class F>
__device__ __forceinline__ void seq_role(char* cb, int vt, int lane, F&& extra) {
    f32x4 Sreg[4];
#pragma unroll
    for (int i = 0; i < 4; ++i) Sreg[i] = (f32x4){0.f, 0.f, 0.f, 0.f};
    extra(0); lbar(); extra(1); lbar();
    for (int k = 0; k <= NCH; ++k) {
        if (k > 0) {
            const int kb = k - 1;
            seq_wave<TYPE>(cb + (kb & 1) * PCB_BYTES, cb + WKS0 + ((kb & 1) * 2 + 0) * WKS_BYTES, (float*)(cb + SY0 + (kb & 1) * 4096), vt, lane, Sreg);
            seq_wave<TYPE>(cb + (kb & 1) * PCB_BYTES + PC_STRIDE, cb + WKS0 + ((kb & 1) * 2 + 1) * WKS_BYTES, (float*)(cb + SY0 + (kb & 1) * 4096) + 16 * 32, vt, lane, Sreg);
        }
        lbar();
        extra(k + 2);
        lbar();
    }
}
template <int TYPE>
__device__ __forceinline__ void prep_role(char* cb, int c, int lane) {
    lbar(); lbar();
    for (int k = 0; k <= NCH; ++k) {
        if (k < NCH) prep_wave<TYPE, true>(cb + (k & 1) * PCB_BYTES + c * PC_STRIDE, cb + WKP0 + c * WKP_BYTES, cb + WKS0 + ((k & 1) * 2 + c) * WKS_BYTES, lane);
        else lbar();
        lbar();
    }
}
__device__ __forceinline__ float red8(float x) { x += dppf<0xB1>(x); x += dppf<0x4E>(x); x += dppf<0x141>(x); return x; }
__device__ __forceinline__ void st8T(bf16_t* base, int row0, int t, u32x4 v) {
    const int r = row0 >> 3;
    base[(row0 + 0 + ((0 + r) & 3)) * 16 + t] = (bf16_t)v.x; base[(row0 + 0 + ((1 + r) & 3)) * 16 + t] = (bf16_t)(v.x >> 16); base[(row0 + 0 + ((2 + r) & 3)) * 16 + t] = (bf16_t)v.y; base[(row0 + 0 + ((3 + r) & 3)) * 16 + t] = (bf16_t)(v.y >> 16);
    base[(row0 + 4 + ((0 + r) & 3)) * 16 + t] = (bf16_t)v.z; base[(row0 + 4 + ((1 + r) & 3)) * 16 + t] = (bf16_t)(v.z >> 16); base[(row0 + 4 + ((2 + r) & 3)) * 16 + t] = (bf16_t)v.w; base[(row0 + 4 + ((3 + r) & 3)) * 16 + t] = (bf16_t)(v.w >> 16);
}
__device__ __forceinline__ u32x4 pk8(const f32x4& a, const f32x4& b) { u32x4 r; r.x = pk2(a[0], a[1]); r.y = pk2(a[2], a[3]); r.z = pk2(b[0], b[1]); r.w = pk2(b[2], b[3]); return r; }
__device__ __forceinline__ void unpk8(u32x4 v, f32x4& a, f32x4& b) { a = (f32x4){bflo(v.x), bfhi(v.x), bflo(v.y), bfhi(v.y)}; b = (f32x4){bflo(v.z), bfhi(v.z), bflo(v.w), bfhi(v.w)}; }
}

__device__ __forceinline__ void rwkv_job(const PP& p, int l, int job, float* sm) {
    char* cb = (char*)sm;
    float* sW = (float*)(cb + ck::SW0); float* sAA = (float*)(cb + ck::SAA0); float* cst = (float*)(cb + ck::CST0);
    const int half = job & 1, dir = (job >> 1) & 1, bh = job >> 2, b = bh / 6, h = bh - b * 6;
    const int tid = tid_of(p.wv), w = tid >> 6, lane = tid & 63;
    const bf16_t* Z = (const bf16_t*)(p.ws + OFF_Z); const bf16_t* RWP = (const bf16_t*)(p.ws + OFF_H);
    bf16_t* Y = (bf16_t*)(p.ws + OFF_YO) + (size_t)dir * MROWS * 384;
    float* BC = (float*)(p.ws + OFF_BC) + (size_t)dir * MROWS * 6;
    if (tid < 64) { cst[tid] = p.in[I_KK][l * 384 + h * 64 + tid]; cst[64 + tid] = p.in[I_KA][l * 384 + h * 64 + tid]; cst[128 + tid] = p.in[I_RK][l * 384 + h * 64 + tid];
        cst[192 + tid] = p.in[I_MU][l * 1408 + 768 + h * 64 + tid];
        cst[256 + tid] = p.in[I_W0][((size_t)l * 2 + dir) * 384 + h * 64 + tid]; cst[320 + tid] = p.in[I_A0][((size_t)l * 2 + dir) * 384 + h * 64 + tid]; }
    lbar();
    if (w < 2) ck::prep_role<0>(cb, w, lane);
    else if (w == 4 || w == 5) {
        const int mt = w - 4, fr = lane & 15, fq = lane >> 4;
        bf16x8 wfw[4][2], wfa[4][2];
#pragma unroll
        for (int nt = 0; nt < 4; ++nt) {
            const bf16_t* wu = (const bf16_t*)(p.ws + OFF_WUP) + ((size_t)dir * 384 + h * 64 + nt * 16 + fr) * 64 + fq * 8;
            const bf16_t* au = (const bf16_t*)(p.ws + OFF_AUP) + ((size_t)dir * 384 + h * 64 + nt * 16 + fr) * 64 + fq * 8;
            wfw[nt][0] = *(const bf16x8*)wu; wfw[nt][1] = *(const bf16x8*)(wu + 32); wfa[nt][0] = *(const bf16x8*)au; wfa[nt][1] = *(const bf16x8*)(au + 32);
        }
        bf16x8 xw[2], xa[2];
        auto loadm = [&](int blk) {
            if (blk < NCH) {
                const int jm = seqpos(dir, blk * 32 + mt * 16 + fr);
                const bf16_t* mp = RWP + (size_t)(b * TT + jm) * RWP_LD + 768 + fq * 8;
                xw[0] = *(const bf16x8*)mp; xw[1] = *(const bf16x8*)(mp + 32); xa[0] = *(const bf16x8*)(mp + 64); xa[1] = *(const bf16x8*)(mp + 96);
            }
        };
        loadm(0);
        auto lora = [&](int blk) {
            if (blk >= NCH) return;
            float* sWb = sW + (blk & 1) * ck::SWBUF; float* sAb = sAA + (blk & 1) * ck::SWBUF;
#pragma unroll
            for (int nt = 0; nt < 4; ++nt) {
                f32x4 aw = (f32x4){0.f, 0.f, 0.f, 0.f}, aa = aw;
#pragma unroll
                for (int ks = 0; ks < 2; ++ks) { aw = CK_MFMA(xw[ks], wfw[nt][ks], aw); aa = CK_MFMA(xa[ks], wfa[nt][ks], aa); }
                const float w0s = cst[256 + nt * 16 + fr], a0s = cst[320 + nt * 16 + fr];
                f32x4 G = (f32x4){0.f, 0.f, 0.f, 0.f};
#pragma unroll
                for (int i = 0; i < 4; ++i) {
                    const float lw = -0.6065306597126334f * sigmoidf_(aw[i] + w0s);
                    G = __builtin_amdgcn_mfma_f32_16x16x4f32((4 * fq + i <= fr) ? 1.f : 0.f, lw, G, 0, 0, 0);
                }
#pragma unroll
                for (int i = 0; i < 4; ++i) {
                    sWb[(mt * 16 + 4 * fq + i) * ck::SWLD + nt * 16 + fr] = G[i];
                    sAb[(mt * 16 + 4 * fq + i) * ck::SWLD + nt * 16 + fr] = sigmoidf_(aa[i] + a0s);
                }
            }
            loadm(blk + 1);
        };
        ck::seq_role<0>(cb, w - 4, lane, lora);
    }

    else {
        const int ew = (w & 1) + ((w >> 2) << 1);
        const int stid = ew * 64 + lane, es = stid >> 3, c8 = stid & 7, ec = h * 64 + 8 * c8, c = es >> 4, t = es & 15;
        struct PF { u32x4 r, k, vp, vc, vn; int row; };
        PF setA, setB;
        const float* sW_ = sW; const float* sAA_ = sAA;
        auto prefetch = [&](PF& s, int blk) {
            if (blk < NCH) {
                const int j = seqpos(dir, blk * 32 + es);
                const bool hp = (j != 0) && (j != CTX), hn = (j != CTX - 1) && (j != TT - 1);
                s.row = b * TT + j;
                const bf16_t* rp = RWP + (size_t)s.row * RWP_LD;
                s.r = *(const u32x4*)(rp + ec); s.k = *(const u32x4*)(rp + 384 + ec);
                const bf16_t* zp = Z + (size_t)s.row * ZLD + 768 + ec;
                s.vc = *(const u32x4*)zp; s.vp = hp ? *(const u32x4*)(zp - ZLD) : (u32x4){0u, 0u, 0u, 0u}; s.vn = hn ? *(const u32x4*)(zp + ZLD) : (u32x4){0u, 0u, 0u, 0u};
            }
        };
        auto flush = [&](int blk) {
            const float* sYb = (const float*)(cb + ck::SY0 + (blk & 1) * 4096);
            const int s = stid >> 3, v4 = (stid & 7) * 4, j = seqpos(dir, blk * 32 + s);
            *(u32x2*)(Y + (size_t)(b * TT + j) * 384 + h * 64 + half * 32 + v4) = pk4(*(const f32x4*)(sYb + s * 32 + v4));
        };
        auto stage = [&](int blk, PF& ps) {
            f32x4 r0, r1, k0, k1, v0, v1;
            ck::unpk8(ps.r, r0, r1); ck::unpk8(ps.k, k0, k1);
            {
                f32x4 a0, a1, c0, c1, n0, n1; ck::unpk8(ps.vp, a0, a1); ck::unpk8(ps.vc, c0, c1); ck::unpk8(ps.vn, n0, n1);
                const f32x4 m0 = *(const f32x4*)(cst + 192 + 8 * c8), m1 = *(const f32x4*)(cst + 196 + 8 * c8);
                v0 = c0 + ((a0 + n0) * 0.5f - c0) * m0; v1 = c1 + ((a1 + n1) * 0.5f - c1) * m1;
            }
            const int myrow = ps.row;
            u32x4 ga, gr, gb, gk, vb; f32x4 x0, x1; float bon;
            auto comp = [&]() {
                const float* sW = sW_ + (blk & 1) * ck::SWBUF; const float* sAA = sAA_ + (blk & 1) * ck::SWBUF;
                const f32x4 a40 = *(const f32x4*)(sAA + es * ck::SWLD + 8 * c8), a41 = *(const f32x4*)(sAA + es * ck::SWLD + 8 * c8 + 4);
                const f32x4 kd0 = k0 * ((a40 - 1.f) * *(const f32x4*)(cst + 64 + 8 * c8) + 1.f), kd1 = k1 * ((a41 - 1.f) * *(const f32x4*)(cst + 68 + 8 * c8) + 1.f);
                const f32x4 kk0 = k0 * *(const f32x4*)(cst + 8 * c8), kk1 = k1 * *(const f32x4*)(cst + 4 + 8 * c8);
                const float ssq = ck::red8(kk0[0] * kk0[0] + kk0[1] * kk0[1] + kk0[2] * kk0[2] + kk0[3] * kk0[3] + kk1[0] * kk1[0] + kk1[1] * kk1[1] + kk1[2] * kk1[2] + kk1[3] * kk1[3]);
                const float rn = __builtin_amdgcn_rsqf(ssq + 1e-6f);
                const f32x4 kn0 = kk0 * rn, kn1 = kk1 * rn;
                const f32x4 tb0 = r0 * kd0 * *(const f32x4*)(cst + 128 + 8 * c8), tb1 = r1 * kd1 * *(const f32x4*)(cst + 132 + 8 * c8);
                bon = ck::red8(tb0[0] + tb0[1] + tb0[2] + tb0[3] + tb1[0] + tb1[1] + tb1[2] + tb1[3]);
                const f32x4 G0 = *(const f32x4*)(sW + es * ck::SWLD + 8 * c8), G1 = *(const f32x4*)(sW + es * ck::SWLD + 8 * c8 + 4);
                const f32x4 T0 = *(const f32x4*)(sW + (16 * c + 15) * ck::SWLD + 8 * c8), T1 = *(const f32x4*)(sW + (16 * c + 15) * ck::SWLD + 8 * c8 + 4);
                f32x4 L0 = (f32x4){0.f, 0.f, 0.f, 0.f}, L1 = L0;
                if (t > 0) { L0 = *(const f32x4*)(sW + (es - 1) * ck::SWLD + 8 * c8); L1 = *(const f32x4*)(sW + (es - 1) * ck::SWLD + 8 * c8 + 4); }
                f32x4 P0, P1, Q0, Q1, I0, I1;
#pragma unroll
                for (int e = 0; e < 4; ++e) { P0[e] = __expf(G0[e]); P1[e] = __expf(G1[e]); Q0[e] = __expf(L0[e]); Q1[e] = __expf(L1[e]); I0[e] = __expf(-G0[e]); I1[e] = __expf(-G1[e]); x0[e] = __expf(T0[e]); x1[e] = __expf(T1[e]); }
                ga = ck::pk8(-kn0 * Q0, -kn1 * Q1); gb = ck::pk8(kn0 * a40 * I0, kn1 * a41 * I1); gk = ck::pk8(kd0 * I0, kd1 * I1); gr = ck::pk8(r0 * P0, r1 * P1);
                vb = ck::pk8(v0, v1);
            };
            if (blk > 0) comp();
            lbar();
            if (blk == 0) comp();
            prefetch(ps, blk + 2);
            if (blk > 1) flush(blk - 2);
            char* pc = cb + (blk & 1) * ck::PCB_BYTES + c * ck::PC_STRIDE;
            if (c8 == 0 && half == 0) BC[(size_t)myrow * 6 + h] = bon;
            *(u32x4*)(pc + (t * 72 + 8 * c8) * 2) = ga;
            *(u32x4*)(pc + 2304 + (t * 72 + 8 * c8) * 2) = gr;
            *(u32x4*)(pc + 4608 + (t * 72 + 8 * c8) * 2) = gb;
            *(u32x4*)(pc + 6912 + (t * 72 + 8 * c8) * 2) = gk;
            ck::st8T((bf16_t*)(pc + 9216), 8 * c8, t, ga); ck::st8T((bf16_t*)(pc + 11264), 8 * c8, t, gb); ck::st8T((bf16_t*)(pc + 13312), 8 * c8, t, gk);
            if (t == 15) { *(f32x4*)(pc + 17664 + 32 * c8) = x0; *(f32x4*)(pc + 17664 + 32 * c8 + 16) = x1; }
            if ((c8 >> 2) == half) { ck::st8T((bf16_t*)(pc + 15360), 8 * c8 - 32 * half, t, vb); ck::st8T((bf16_t*)(pc + 16384), 8 * c8 - 32 * half, t, vb); }
            lbar();
        };
        prefetch(setA, 0); prefetch(setB, 1);
        stage(0, setA);
        for (int k = 0; k < NCH; k += 2) {
            if (k + 1 < NCH) stage(k + 1, setB); else { lbar(); lbar(); }
            if (k + 2 < NCH) stage(k + 2, setA); else { lbar(); lbar(); }
        }
        lbar(); lbar();
        flush(NCH - 2); flush(NCH - 1);
    }
}

__device__ __forceinline__ void gdn_job(const PP& p, int l, int job, float* sm) {
    char* cb = (char*)sm;
    float* sSC = (float*)(cb + ck::SW0);
    float* cst = (float*)(cb + ck::CST0);
    const int half = job & 1, dir = (job >> 1) & 1, bh = job >> 2, b = bh / 6, h = bh - b * 6;
    const int tid = tid_of(p.wv), w = tid >> 6, lane = tid & 63;
    const bf16_t* Z = (const bf16_t*)(p.ws + OFF_Z);
    bf16_t* Y = (bf16_t*)(p.ws + OFF_YO) + (size_t)(2 + dir) * MROWS * 384;
    for (int i = tid; i < 576; i += 512) { const int a = i >> 6, cc = i & 63; cst[i] = p.in[I_CONV][(size_t)l * 3 * 1152 + (a / 3) * 1152 + (a % 3) * 384 + h * 64 + cc]; }
    lbar();
    if (w < 2) ck::prep_role<1>(cb, w, lane);
    else if (w == 4 || w == 5) ck::seq_role<1>(cb, w - 4, lane, [](int) {});
    else {
        const int ew = (w & 1) + ((w >> 2) << 1);
        const int stid = ew * 64 + lane, es = stid >> 3, c8 = stid & 7, ec = h * 64 + 8 * c8, c = es >> 4, t = es & 15;
        const float aexp = __expf(p.in[I_ALOG][((size_t)l * 2 + dir) * 6 + h]), dtb = p.in[I_DTB][((size_t)l * 2 + dir) * 6 + h];
        struct PF { u32x4 x[3][3]; bf16_t be, ai; };
        PF setA, setB;
        auto prefetch = [&](PF& s, int blk) {
            if (blk < NCH) {
                const int j = seqpos(dir, blk * 32 + es);
                const bool hp = (j != 0) && (j != CTX), hn = (j != CTX - 1) && (j != TT - 1);
                const bf16_t* zp = Z + (size_t)(b * TT + j) * ZLD + 1408 + ec;
#pragma unroll
                for (int a = 0; a < 3; ++a) {
                    s.x[a][1] = *(const u32x4*)(zp + a * 384);
                    s.x[a][0] = hp ? *(const u32x4*)(zp + a * 384 - ZLD) : (u32x4){0u, 0u, 0u, 0u};
                    s.x[a][2] = hn ? *(const u32x4*)(zp + a * 384 + ZLD) : (u32x4){0u, 0u, 0u, 0u};
                }
                s.be = zp[1152 - ec + dir * 6 + h]; s.ai = zp[1164 - ec + dir * 6 + h];
            }
        };
        auto flush = [&](int blk) {
            const float* sYb = (const float*)(cb + ck::SY0 + (blk & 1) * 4096);
            const int s = stid >> 3, v4 = (stid & 7) * 4, j = seqpos(dir, blk * 32 + s);
            *(u32x2*)(Y + (size_t)(b * TT + j) * 384 + h * 64 + half * 32 + v4) = pk4(*(const f32x4*)(sYb + s * 32 + v4));
        };
        auto stage = [&](int blk, PF& ps) {
            f32x4 o[3][2];
#pragma unroll
            for (int a = 0; a < 3; ++a) {
                f32x4 p0, p1, c0, c1, n0, n1; ck::unpk8(ps.x[a][0], p0, p1); ck::unpk8(ps.x[a][1], c0, c1); ck::unpk8(ps.x[a][2], n0, n1);
                o[a][0] = p0 * *(const f32x4*)(cst + (0 * 3 + a) * 64 + 8 * c8) + c0 * *(const f32x4*)(cst + (1 * 3 + a) * 64 + 8 * c8) + n0 * *(const f32x4*)(cst + (2 * 3 + a) * 64 + 8 * c8);
                o[a][1] = p1 * *(const f32x4*)(cst + (0 * 3 + a) * 64 + 8 * c8 + 4) + c1 * *(const f32x4*)(cst + (1 * 3 + a) * 64 + 8 * c8 + 4) + n1 * *(const f32x4*)(cst + (2 * 3 + a) * 64 + 8 * c8 + 4);
#pragma unroll
                for (int e = 0; e < 4; ++e) { o[a][0][e] = siluf_(o[a][0][e]); o[a][1][e] = siluf_(o[a][1][e]); }
            }
            float sq = 0.f, sk = 0.f;
#pragma unroll
            for (int e = 0; e < 4; ++e) { sq += o[0][0][e] * o[0][0][e] + o[0][1][e] * o[0][1][e]; sk += o[1][0][e] * o[1][0][e] + o[1][1][e] * o[1][1][e]; }
            sq = ck::red8(sq); sk = ck::red8(sk);
            const float qn = __builtin_amdgcn_rsqf(sq + 1e-6f) * 0.125f, kn = __builtin_amdgcn_rsqf(sk + 1e-6f);
            const f32x4 q0 = o[0][0] * qn, q1 = o[0][1] * qn, k0 = o[1][0] * kn, k1 = o[1][1] * kn;
            const float beta = sigmoidf_(bf2f(ps.be));
            const float xg = bf2f(ps.ai) + dtb; const float gl = -aexp * (xg > 20.f ? xg : __logf(1.f + __expf(xg)));
            if (c8 == 0) { sSC[es * 4] = beta; sSC[es * 4 + 1] = gl; }
            lbar();
            prefetch(ps, blk + 2);
            if (blk > 1) flush(blk - 2);
            char* pc = cb + (blk & 1) * ck::PCB_BYTES + c * ck::PC_STRIDE;
            float g = 0.f, gm1 = 0.f, gt = 0.f;
#pragma unroll
            for (int i = 0; i < 16; ++i) { const float lg = sSC[(16 * c + i) * 4 + 1]; gt += lg; if (i <= t) g += lg; if (i < t) gm1 += lg; }
            const float ac = -__expf(gl) * beta;
            const u32x4 ga = ck::pk8(k0 * ac, k1 * ac), kb = ck::pk8(k0, k1);
            *(u32x4*)(pc + (t * 72 + 8 * c8) * 2) = ga;
            *(u32x4*)(pc + 2304 + (t * 72 + 8 * c8) * 2) = ck::pk8(q0, q1);
            *(u32x4*)(pc + 4608 + (t * 72 + 8 * c8) * 2) = kb;
            ck::st8T((bf16_t*)(pc + 9216), 8 * c8, t, ga); ck::st8T((bf16_t*)(pc + 11264), 8 * c8, t, kb);
            const float us = __expf(gt - g);
            if (t == 15) { const float pv = __expf(gt); const f32x4 pv4 = (f32x4){pv, pv, pv, pv}; *(f32x4*)(pc + 17664 + 32 * c8) = pv4; *(f32x4*)(pc + 17664 + 32 * c8 + 16) = pv4; }
            if (c8 == 0) { float* sc4 = (float*)(pc + 17408); sc4[t] = g; sc4[16 + t] = __expf(g); sc4[32 + t] = __expf(gm1); sc4[48 + t] = us; }
            if ((c8 >> 2) == half) {
                const f32x4 v0 = o[2][0] * beta, v1 = o[2][1] * beta;
                ck::st8T((bf16_t*)(pc + 15360), 8 * c8 - 32 * half, t, ck::pk8(v0, v1)); ck::st8T((bf16_t*)(pc + 16384), 8 * c8 - 32 * half, t, ck::pk8(v0 * us, v1 * us));
            }
            lbar();
        };
        prefetch(setA, 0); prefetch(setB, 1);
        stage(0, setA);
        for (int k = 0; k < NCH; k += 2) {
            if (k + 1 < NCH) stage(k + 1, setB); else { lbar(); lbar(); }
            if (k + 2 < NCH) stage(k + 2, setA); else { lbar(); lbar(); }
        }
        lbar(); lbar();
        flush(NCH - 2); flush(NCH - 1);
    }
}

__device__ __forceinline__ void s5_job(const PP& p, int it, LAS uchar* lds) {
    const int g = it >> 1, dir = it & 1, tid = tid_of(p.wv), w = tid >> 6, q = tid & 63;
    bf16_t* A2 = (bf16_t*)(p.ws + OFF_A2) + (size_t)it * GROWS * 640;
    if (w < 4) {
        const float* HL = (const float*)(p.ws + OFF_HL) + (size_t)g * GROWS * 256 + dir * 128 + 2 * q;
        const float* DP = (const float*)(p.ws + OFF_DP) + (it * 64 + q) * 2;
        const float dr = DP[0], di = DP[1]; float hr = 0.f, hi = 0.f;
        for (int i0 = 0; i0 < NCH; i0 += 8) {
            f32x2 hl[8]; int Rr[8];
#pragma unroll
            for (int e = 0; e < 8; ++e) { const int i = i0 + e; const int c = dir == 0 ? i : (i < 8 ? 7 - i : NCH - 1 - (i - 8)); Rr[e] = w * NCH + c; hl[e] = *(const f32x2*)(HL + (size_t)Rr[e] * 256); }
#pragma unroll
            for (int e = 0; e < 8; ++e) {
                *(unsigned*)(A2 + (size_t)Rr[e] * 640 + 512 + 2 * q) = pk2(hr, hi);
                const float nr = dr * hr - di * hi + hl[e].x, ni = dr * hi + di * hr + hl[e].y; hr = nr; hi = ni;
            }
        }
    }
    __builtin_amdgcn_fence(__ATOMIC_RELEASE, "agent");
    asm volatile("s_waitcnt vmcnt(0)" ::: "memory");
    __syncthreads();
    __builtin_amdgcn_fence(__ATOMIC_ACQUIRE, "agent");
    asm volatile("s_waitcnt vmcnt(0)" ::: "memory");
    __syncthreads();
    pg8::Gemm gm; gm.A = (const bf16_t*)(p.ws + OFF_A2); gm.Bt = (const bf16_t*)(p.ws + OFF_TF); gm.K = 640; gm.lda = 640; gm.ldb = 640;
    pg8::Sched S; S.mode = 1; S.nM = 5; S.nN = 2; S.nwg = (it + 1) * 10; S.G = 1; S.c = it * 10;
    S.gA = (size_t)GROWS * 640 * 2; S.gB = (size_t)512 * 640 * 2; S.tA = (size_t)256 * 640 * 2; S.tB = (size_t)256 * 640 * 2;
    EpiY5 E; E.Y5 = (bf16_t*)(p.ws + OFF_Y5);
    pg8::gemm_phase(lds, gm, S, E, p.wv);
}


constexpr int GRW_SPLIT = 27000;
__device__ __forceinline__ bf16_t* grw_row(char* ws, int row) {
    return row < GRW_SPLIT ? (bf16_t*)(ws + OFF_TF) + (size_t)row * 384 : (bf16_t*)(ws + OFF_HL) + (size_t)(row - GRW_SPLIT) * 384;
}
__device__ __forceinline__ void phase_gaterw(const PP& p, int l, int gw, int nw) {
    int lane = lane_id(); asm volatile("" : "+v"(lane));
    const int fr = lane & 15, fq = lane >> 4;
    const bf16_t* Z = (const bf16_t*)(p.ws + OFF_Z); const bf16_t* GUP = (const bf16_t*)(p.ws + OFF_GUP);
    const float* mu = p.in[I_MU] + l * 1408;
    for (int item = gw; item < MROWS / 16; item += nw) {
        const int row = item * 16 + fr, b = row / TT, j = row - b * TT;
        const bool hp = (j != 0) && (j != CTX), hn = (j != CTX - 1) && (j != TT - 1);
        bf16x8 gfrag[4];
#pragma unroll
        for (int ks = 0; ks < 4; ++ks) {
            const int c0 = 1280 + ks * 32 + fq * 8;
            const Nb3 a = ld3(Z, row, hp, hn, c0), bq = ld3(Z, row, hp, hn, c0 + 4);
            f32x4 x0 = shiftmix(a, mu + c0), x1 = shiftmix(bq, mu + c0 + 4);
#pragma unroll
            for (int i = 0; i < 4; ++i) { x0[i] = sigmoidf_(x0[i]); x1[i] = sigmoidf_(x1[i]); }
            const u32x2 lo = pk4(x0), hi2 = pk4(x1); u32x4 t; t.x = lo.x; t.y = lo.y; t.z = hi2.x; t.w = hi2.y; gfrag[ks] = __builtin_bit_cast(bf16x8, t);
        }
        bf16_t* gr = grw_row(p.ws, row);
#pragma unroll 4
        for (int n24 = 0; n24 < 24; ++n24) {
            f32x4 ga = (f32x4){0.f, 0.f, 0.f, 0.f};
            const bf16_t* wp = GUP + (size_t)(n24 * 16 + fr) * 128 + fq * 8;
#pragma unroll
            for (int ks = 0; ks < 4; ++ks) ga = __builtin_amdgcn_mfma_f32_16x16x32_bf16(*(const bf16x8*)(wp + ks * 32), gfrag[ks], ga, 0, 0, 0);
            *(u32x2*)(gr + n24 * 16 + fq * 4) = pk4(ga);
        }
    }
}
__device__ __forceinline__ void phase_s5post(const PP& p, int l, int gw, int nw) {
    int lane = lane_id(); asm volatile("" : "+v"(lane));
    const int fr = lane & 15, fq = lane >> 4;
    const bf16_t* A2 = (const bf16_t*)(p.ws + OFF_A2); const bf16_t* Y5 = (const bf16_t*)(p.ws + OFF_Y5); bf16_t* Y5w = (bf16_t*)(p.ws + OFF_Y5);
    const bf16_t* GLU = (const bf16_t*)(p.ws + OFF_GLU);
    for (int item = gw; item < MROWS / 16; item += nw) {
        const int row = item * 16 + fr, b = row / TT, j = row - b * TT;
        {
            const int n = s5pos(j), R = b * NCH + (n >> 5), t = n & 31;
            const size_t GS5 = (size_t)GROWS * 512;
            bf16x8 yf[8];
#pragma unroll
            for (int ks = 0; ks < 8; ++ks) {
                const int ch = ks * 32 + fq * 8, g = ch >> 4, hh = ch & 15;
                const u32x4 y0 = *(const u32x4*)(Y5 + (size_t)(g * 2) * GS5 + (size_t)R * 512 + t * 16 + hh), y1 = *(const u32x4*)(Y5 + (size_t)(g * 2 + 1) * GS5 + (size_t)R * 512 + t * 16 + hh);
                const u32x4 uu = *(const u32x4*)(A2 + ((size_t)(g * 2) * GROWS + R) * 640 + t * 16 + hh);
                const float* dv = p.in[I_S5D] + l * 256 + ch;
                float v[8];
#pragma unroll
                for (int e = 0; e < 4; ++e) {
                    v[2 * e] = gelu_tanh(bflo(y0[e]) + bflo(y1[e]) + dv[2 * e] * bflo(uu[e]));
                    v[2 * e + 1] = gelu_tanh(bfhi(y0[e]) + bfhi(y1[e]) + dv[2 * e + 1] * bfhi(uu[e]));
                }
                u32x4 tq; tq.x = pk2(v[0], v[1]); tq.y = pk2(v[2], v[3]); tq.z = pk2(v[4], v[5]); tq.w = pk2(v[6], v[7]); yf[ks] = __builtin_bit_cast(bf16x8, tq);
                asm volatile("" ::: "memory");
            }
#pragma unroll 1
            for (int nt = 0; nt < 16; ++nt) {
                f32x4 a = (f32x4){0.f, 0.f, 0.f, 0.f};
                const bf16_t* wp = GLU + (size_t)(nt * 16 + fr) * 256 + fq * 8;
#pragma unroll
                for (int ks = 0; ks < 8; ++ks) a = __builtin_amdgcn_mfma_f32_16x16x32_bf16(*(const bf16x8*)(wp + ks * 32), yf[ks], a, 0, 0, 0);
                const int ch = nt * 16 + fq * 4, hh = ch & 15;
                const u32x2 y0 = *(const u32x2*)(Y5 + (size_t)(nt * 2) * GS5 + (size_t)R * 512 + t * 16 + hh), y1 = *(const u32x2*)(Y5 + (size_t)(nt * 2 + 1) * GS5 + (size_t)R * 512 + t * 16 + hh);
                const u32x2 uu = *(const u32x2*)(A2 + ((size_t)(nt * 2) * GROWS + R) * 640 + t * 16 + hh);
                const f32x4 dv = *(const f32x4*)(p.in[I_S5D] + l * 256 + ch), gb = *(const f32x4*)(p.in[I_GLUB] + l * 256 + ch);
                const f32x4 ys = unpk4(y0) + unpk4(y1) + dv * unpk4(uu);
                f32x4 o;
#pragma unroll
                for (int i = 0; i < 4; ++i) { const float yy = gelu_tanh(ys[i]); o[i] = yy * sigmoidf_(a[i] + gb[i]); }
                *(u32x2*)(Y5w + (size_t)(nt * 2) * GS5 + (size_t)R * 512 + t * 16 + hh) = pk4(o);
                asm volatile("" ::: "memory");
            }
        }
    }
}

__device__ __forceinline__ void phase_post(const PP& p, int l) {
    const int lane = tid_of(p.wv) & 63, gw = bidx() * 8 + (tid_of(p.wv) >> 6), nw = gridDim.x * 8, fr = lane & 15, fq = lane >> 4;
    const bf16_t* Z = (const bf16_t*)(p.ws + OFF_Z);
    const bf16_t* YO = (const bf16_t*)(p.ws + OFF_YO);
    const float* BC = (const float*)(p.ws + OFF_BC);
    const bf16_t* A2 = (const bf16_t*)(p.ws + OFF_A2); const bf16_t* Y5 = (const bf16_t*)(p.ws + OFF_Y5);
    const bf16_t* GUP = (const bf16_t*)(p.ws + OFF_GUP); const bf16_t* GLU = (const bf16_t*)(p.ws + OFF_GLU);
    bf16_t* MIX = (bf16_t*)(p.ws + OFF_H);
    const float* mu = p.in[I_MU] + l * 1408;
    const size_t YS = (size_t)MROWS * 384;
    for (int it3 = gw; it3 < 2 * (MROWS / 16); it3 += nw) {
      const int item = it3 >> 1, part = 1 + (((it3 / nw) + it3) & 1);
      if (part == 1) {
        const int row = item * 16 + fr, b = row / TT, j = row - b * TT;
        const bool hp = (j != 0) && (j != CTX), hn = (j != CTX - 1) && (j != TT - 1);
        const bf16_t* gr = grw_row(p.ws, row);
#pragma unroll 2
        for (int h = 0; h < 6; ++h) {
            f32x4 ga[4], y[4]; float s1 = 0.f;
#pragma unroll
            for (int nt = 0; nt < 4; ++nt) {
                const int c = h * 64 + nt * 16 + fq * 4;
                ga[nt] = unpk4(*(const u32x2*)(gr + c));
                y[nt] = unpk4(*(const u32x2*)(YO + (size_t)row * 384 + c)) + unpk4(*(const u32x2*)(YO + YS + (size_t)row * 384 + c));
                s1 += y[nt][0] + y[nt][1] + y[nt][2] + y[nt][3];
            }
            s1 += __shfl_xor(s1, 16); s1 += __shfl_xor(s1, 32);
            const float mean = s1 * (1.f / 64.f); float s2 = 0.f;
#pragma unroll
            for (int nt = 0; nt < 4; ++nt) { y[nt] = y[nt] - mean; s2 += y[nt][0] * y[nt][0] + y[nt][1] * y[nt][1] + y[nt][2] * y[nt][2] + y[nt][3] * y[nt][3]; }
            s2 += __shfl_xor(s2, 16); s2 += __shfl_xor(s2, 32);
            const float rstd = __builtin_amdgcn_rsqf(s2 * (1.f / 64.f) + 64e-5f);
            const float bon = BC[(size_t)row * 6 + h] + BC[(size_t)MROWS * 6 + (size_t)row * 6 + h];
#pragma unroll
            for (int nt = 0; nt < 4; ++nt) {
                const int c = h * 64 + nt * 16 + fq * 4;
                const f32x4 lg = *(const f32x4*)(p.in[I_LNG] + l * 384 + c), lb = *(const f32x4*)(p.in[I_LNB] + l * 384 + c);
                const f32x4 vs = shiftmix(ld3(Z, row, hp, hn, 768 + c), mu + 768 + c);
                const f32x4 o = (y[nt] * rstd * lg + lb + vs * bon) * ga[nt];
                *(u32x2*)(MIX + (size_t)row * DM + c) = pk4(o);

            }
        }
      } else if (part == 2) {

        const int row = item * 16 + fr;
#pragma unroll 3
        for (int h = 0; h < 6; ++h) {
            f32x4 o[4]; float s2 = 0.f;
#pragma unroll
            for (int nt = 0; nt < 4; ++nt) {
                const int c = h * 64 + nt * 16 + fq * 4;
                o[nt] = unpk4(*(const u32x2*)(YO + 2 * YS + (size_t)row * 384 + c)) + unpk4(*(const u32x2*)(YO + 3 * YS + (size_t)row * 384 + c));
                s2 += o[nt][0] * o[nt][0] + o[nt][1] * o[nt][1] + o[nt][2] * o[nt][2] + o[nt][3] * o[nt][3];
            }
            s2 += __shfl_xor(s2, 16); s2 += __shfl_xor(s2, 32);
            const float rs = __builtin_amdgcn_rsqf(s2 * (1.f / 64.f) + 1e-6f);
#pragma unroll
            for (int nt = 0; nt < 4; ++nt) {
                const int c = h * 64 + nt * 16 + fq * 4;
                const f32x4 gn = *(const f32x4*)(p.in[I_GNG] + l * 64 + nt * 16 + fq * 4);
                f32x4 gt = unpk4(*(const u32x2*)(Z + (size_t)row * ZLD + 2584 + c));
#pragma unroll
                for (int i = 0; i < 4; ++i) gt[i] = siluf_(gt[i]);
                *(u32x2*)(MIX + (size_t)row * DM + 384 + c) = pk4(o[nt] * rs * gn * gt);
            }
        }
        {
        const int b = row / TT, j = row - b * TT;
        const int n = s5pos(j), R = b * NCH + (n >> 5), t = n & 31;
        const size_t GS5 = (size_t)GROWS * 512;
#pragma unroll 4
        for (int nt = 0; nt < 16; ++nt)
            *(u32x2*)(MIX + (size_t)row * DM + 768 + nt * 16 + fq * 4) = *(const u32x2*)(Y5 + (size_t)(nt * 2) * GS5 + (size_t)R * 512 + t * 16 + fq * 4);
        }
      }
    }
}

__global__ void __launch_bounds__(512) fwd_mega(P kp) {
    extern __shared__ __attribute__((aligned(16))) uchar shm[];
    cg::grid_group grid = cg::this_grid();
    float* sm = (float*)shm;
    LAS uchar* lds = (LAS uchar*)shm;
    const int nblk = gridDim.x;
    if (threadIdx.x == 0) {
        unsigned long long* tab = (unsigned long long*)(shm + TAB_OFF);
#pragma unroll
        for (int i = 0; i < N_IN; ++i) tab[i] = (unsigned long long)kp.in[i];
        tab[N_IN] = (unsigned long long)kp.out; tab[N_IN + 1] = (unsigned long long)kp.ws;
    }
    if (threadIdx.x == 0) { volatile LAS unsigned* st0 = (volatile LAS unsigned*)(lds + TAB_OFF + 384); st0[0] = 0u; st0[1] = 0u; st0[2] = 0u; st0[3] = 0u; }
    __syncthreads();
    const PP p = mkp(__builtin_amdgcn_readfirstlane((int)(threadIdx.x >> 6)));
    const XcdBarrier xb = xcd_barrier_post((unsigned*)(p.ws + OFF_BAR), (volatile LAS unsigned*)(lds + TAB_OFF + 384), p.wv);

    phase_mod(p, sm);
    __syncthreads();
    phase_s5coef(p, 0, sm);
    phase_convw(p, 0, sm, 0, nblk - n_coef_blocks(), 0);
    {
        float* cr = (float*)(p.ws + OFF_CTXR);
        for (size_t i = (size_t)bidx() * 512 + tid_of(p.wv); i < (size_t)NB * CTX * DM / 4; i += (size_t)nblk * 512) ((f32x4*)cr)[i] = ((const f32x4*)p.in[I_CTX])[i];
    }
    grid.sync();

    for (int l = 0; l < DEPTH; ++l) {
        const float* xsrc = l == 0 ? p.in[I_X] : p.out;
        float* ctxr = (float*)(p.ws + OFF_CTXR);
        const float* modl = (const float*)(p.ws + OFF_MOD) + (size_t)l * 5 * 6144;
        phase_norm(p, l, 0, xsrc, ctxr, 0);
        xcd_barrier(xb);
        {
            pg8::Gemm gm; gm.A = (const bf16_t*)(p.ws + OFF_H); gm.Bt = (const bf16_t*)(p.ws + OFF_WIN); gm.K = 1024; gm.lda = 1024; gm.ldb = 1024;
            EpiZ E; E.Z = (bf16_t*)(p.ws + OFF_Z); E.A2 = (bf16_t*)(p.ws + OFF_A2);
            pg8::gemm_phase(lds, gm, sched_static(MROWS, 3328, 1024, 1024), E, p.wv);
        }
        xcd_barrier(xb);
        {
            pg8::Gemm gm; gm.A = (const bf16_t*)(p.ws + OFF_A2); gm.Bt = (const bf16_t*)(p.ws + OFF_E2); gm.K = 512; gm.lda = 640; gm.ldb = 512;
            pg8::Sched S; S.mode = 1; S.nM = 5; S.nN = 1; S.nwg = 80; S.G = nblk; S.c = bidx();
            S.gA = (size_t)2 * GROWS * 640 * 2; S.gB = (size_t)256 * 512 * 2; S.tA = (size_t)256 * 640 * 2; S.tB = 0;
            EpiHL E; E.HL = (float*)(p.ws + OFF_HL);
            pg8::gemm_phase(lds, gm, S, E, p.wv);
        }
        phase_rwprep(p, l);
        xcd_barrier(xb);
        for (int job = bidx(); job < 224; job += nblk) {
            if (job < 96) rwkv_job(p, l, job, sm);
            else if (job < 192) gdn_job(p, l, job - 96, sm);
            else {
                s5_job(p, job - 192, lds);
                asm volatile("s_waitcnt vmcnt(0)" ::: "memory");
                __syncthreads();
                if (tid_of(p.wv) == 0) { __builtin_amdgcn_fence(__ATOMIC_RELEASE, "agent"); asm volatile("s_waitcnt vmcnt(0)" ::: "memory");
                    __hip_atomic_fetch_add((unsigned*)(p.ws + OFF_BAR) + 3600 + l, 1u, __ATOMIC_RELAXED, __HIP_MEMORY_SCOPE_AGENT); }
            }
            __syncthreads();
        }
        const bool s5_helpers = nblk >= 224;
        const int hb0 = s5_helpers ? 192 : 0;
        if (bidx() >= hb0) {
            const int tid = tid_of(p.wv);
            if (tid == 0) {
                while (__hip_atomic_load((unsigned*)(p.ws + OFF_BAR) + 3600 + l, __ATOMIC_RELAXED, __HIP_MEMORY_SCOPE_AGENT) < 32u) __builtin_amdgcn_s_sleep(8);
                __builtin_amdgcn_fence(__ATOMIC_ACQUIRE, "agent");
                asm volatile("s_waitcnt vmcnt(0)" ::: "memory");
            }
            __syncthreads();
            phase_s5post(p, l, (bidx() - hb0) * 8 + (tid >> 6), (nblk - hb0) * 8);
            phase_gaterw(p, l, (bidx() - hb0) * 8 + (tid >> 6), (nblk - hb0) * 8);
            __syncthreads();
            phase_convw(p, l, sm, hb0, nblk - hb0, 1);
        }
        xcd_barrier(xb);
        phase_post(p, l);
        xcd_barrier(xb);
        {
            pg8::Gemm gm; gm.A = (const bf16_t*)(p.ws + OFF_H); gm.Bt = (const bf16_t*)(p.ws + OFF_WOUT); gm.K = 1024; gm.lda = 1024; gm.ldb = 1024;
            EpiResid E; E.xin = xsrc; E.xout = p.out; E.cin = l == 0 ? p.in[I_CTX] : ctxr; E.cout = ctxr; E.mod = modl; E.gidx = 2;
            pg8::gemm_phase(lds, gm, sched_static(MROWS, 1024, 1024, 1024), E, p.wv);
        }
        xcd_barrier(xb);
        phase_norm(p, l, 1, p.out, ctxr, 0);
        xcd_barrier(xb);
        {
            pg8::Gemm gm; gm.A = (const bf16_t*)(p.ws + OFF_H); gm.Bt = (const bf16_t*)(p.ws + OFF_WGU); gm.K = 1024; gm.lda = 1024; gm.ldb = 1024;
            EpiSwiGLU E; E.HID = (bf16_t*)(p.ws + OFF_Z);
            pg8::gemm_phase(lds, gm, sched_static(MROWS, 5632, 1024, 1024), E, p.wv);
        }
        xcd_barrier(xb);
        {
            pg8::Gemm gm; gm.A = (const bf16_t*)(p.ws + OFF_Z); gm.Bt = (const bf16_t*)(p.ws + OFF_WDN); gm.K = FFN; gm.lda = FFN; gm.ldb = FFN;
            EpiResid E; E.xin = p.out; E.xout = p.out; E.cin = ctxr; E.cout = ctxr; E.mod = modl; E.gidx = 5;
            pg8::gemm_phase(lds, gm, sched_static(MROWS, 1024, FFN, FFN), E, p.wv);
        }
        if (l + 1 < DEPTH) {
            const int nx = (528 % nblk);
            __syncthreads();
            phase_s5coef(p, l + 1, sm);
            const int ncb = n_coef_blocks();
            const bool wide = nblk - nx - ncb >= 64;
            phase_convw(p, l + 1, sm, wide ? nx : 0, wide ? nblk - nx - ncb : nblk, 0);
        }
        xcd_barrier(xb);
    }
    phase_final(p);
}

extern "C" void kernel_launch(void* const* d_in, const int* in_sizes, int n_in, void* d_out, int out_size, void* d_ws, size_t ws_size, hipStream_t stream) {
    static int grid_blocks = 0;
    if (!grid_blocks) {
        int dev = 0, cus = 0, per_cu = 0;
        hipGetDevice(&dev);
        hipDeviceGetAttribute(&cus, hipDeviceAttributeMultiprocessorCount, dev);
        if (hipFuncSetAttribute((const void*)fwd_mega, hipFuncAttributeMaxDynamicSharedMemorySize, LDS_TOTAL) != hipSuccess) fprintf(stderr, "hipFuncSetAttribute failed\n");
        hipOccupancyMaxActiveBlocksPerMultiprocessor(&per_cu, (const void*)fwd_mega, 512, LDS_TOTAL);
        if (per_cu < 1) per_cu = 1;
        if (per_cu > 1) per_cu = 1;
        grid_blocks = cus * per_cu;
    }
    if (ws_size < WS_NEED) fprintf(stderr, "workspace too small: %zu < %zu\n", ws_size, (size_t)WS_NEED);
    P p{};
    for (int i = 0; i < N_IN; ++i) p.in[i] = (const float*)d_in[i];
    p.out = (float*)d_out; p.ws = (char*)d_ws;
    (void)hipMemsetAsync((char*)d_ws + OFF_BAR, 0, 16384, stream);
    void* args[] = {&p};
    hipError_t e = hipLaunchCooperativeKernel((void*)fwd_mega, dim3(grid_blocks), dim3(512), args, LDS_TOTAL, stream);
    if (e != hipSuccess) fprintf(stderr, "cooperative launch failed: %s (grid %d)\n", hipGetErrorString(e), grid_blocks);
}
```

```cpp
#include <hip/hip_runtime.h>
#include <hip/hip_cooperative_groups.h>
#include <cstdio>
namespace cg = cooperative_groups;

#define LAS __attribute__((address_space(3)))
typedef unsigned short bf16_t;
typedef unsigned char uchar;
typedef short bf16x8 __attribute__((ext_vector_type(8)));
typedef float f32x4 __attribute__((ext_vector_type(4)));
typedef float f32x2 __attribute__((ext_vector_type(2)));
typedef unsigned u32x4 __attribute__((ext_vector_type(4)));
typedef unsigned u32x2 __attribute__((ext_vector_type(2)));

constexpr int DM = 1024, NB = 4, SEQ = 8192, CTX = 256, TT = 8448, MROWS = 33792, DEPTH = 4;
constexpr int FFN = 2816, ZLD = 2968, NCH = 264  , GROWS = 1056  ;
constexpr int LDSB = 131072;
constexpr int LDS_TOTAL = 163840, TAB_OFF = 162816;

enum { I_X = 0, I_C, I_CTX, I_CCTX, I_N1G, I_N2G, I_FG, I_ADAW, I_ADAB, I_WIN, I_WOUT, I_MU, I_W0, I_WUP, I_A0, I_AUP, I_GUP, I_KK, I_KA, I_RK,
       I_LNG, I_LNB, I_CONV, I_ALOG, I_DTB, I_GNG, I_LRE, I_LIM, I_LDT, I_BRE, I_BIM, I_CRE, I_CIM, I_S5D, I_GLUW, I_GLUB, I_FG8, I_FU, I_FD, N_IN };

constexpr size_t OFF_WIN = 0;
constexpr size_t OFF_WOUT = OFF_WIN + 6815744;
constexpr size_t OFF_WGU = OFF_WOUT + 2097152;
constexpr size_t OFF_WDN = OFF_WGU + 11534336;
constexpr size_t OFF_WUP = OFF_WDN + 5767168;
constexpr size_t OFF_AUP = OFF_WUP + 98304;
constexpr size_t OFF_GUP = OFF_AUP + 98304;
constexpr size_t OFF_GLU = OFF_GUP + 98304;
constexpr size_t OFF_TF = OFF_GLU + 131072;
constexpr size_t OFF_E2 = OFF_TF + 20971520;
constexpr size_t OFF_DP = OFF_E2 + 4194304;
constexpr size_t OFF_MOD = OFF_DP + 16384;
constexpr size_t OFF_CTXR = OFF_MOD + 491520;
constexpr size_t OFF_BC = OFF_CTXR + 4194304;
constexpr size_t OFF_H = OFF_BC + 1622016;
constexpr size_t OFF_Z = OFF_H + 69206016;
constexpr size_t OFF_YO = OFF_Z + 200589312;
constexpr size_t OFF_A2 = OFF_YO + 103809024;
constexpr size_t OFF_Y5 = OFF_A2 + 43581440;
constexpr size_t OFF_HL = OFF_Y5 + 34603008;
constexpr size_t OFF_BAR = OFF_HL + 17301504;
constexpr size_t WS_NEED = OFF_BAR + 16384;

struct P { const float* in[N_IN]; float* out; char* ws; };
__device__ __forceinline__ char* ldp(int i) {
    extern __shared__ __attribute__((aligned(16))) unsigned char shm_[];
    const unsigned long long v = ((const unsigned long long*)(shm_ + TAB_OFF))[i];
    const unsigned lo = __builtin_amdgcn_readfirstlane((unsigned)v), hi = __builtin_amdgcn_readfirstlane((unsigned)(v >> 32));
    return (char*)(__attribute__((address_space(1))) char*)(((unsigned long long)hi << 32) | lo);
}
struct PIn { __device__ __forceinline__ const float* operator[](int i) const { return (const float*)ldp(i); } };
struct PP { PIn in; float* out; char* ws; int wv; };
__device__ __forceinline__ PP mkp(int wv) { PP q; q.out = (float*)ldp(N_IN); q.ws = ldp(N_IN + 1); q.wv = wv; return q; }

__device__ __forceinline__ int lane_id() { return (int)__builtin_amdgcn_mbcnt_hi(~0u, __builtin_amdgcn_mbcnt_lo(~0u, 0u)); }
__device__ __forceinline__ int tid_of(int wv) { int t = wv * 64 + lane_id(); asm volatile("" : "+v"(t)); return t; }
__device__ __forceinline__ int bidx() { int t = blockIdx.x; asm volatile("" : "+s"(t)); return t; }
__device__ __forceinline__ bf16_t f2bf(float f) { unsigned u = __float_as_uint(f); u += 0x7FFFu + ((u >> 16) & 1u); return (bf16_t)(u >> 16); }
typedef __bf16 bf16v2_t __attribute__((ext_vector_type(2)));
__device__ __forceinline__ unsigned pk2(float lo, float hi) { f32x2 f; f.x = lo; f.y = hi; return __builtin_bit_cast(unsigned, __builtin_convertvector(f, bf16v2_t)); }
__device__ __forceinline__ float bflo(unsigned u) { return __uint_as_float(u << 16); }
__device__ __forceinline__ float bfhi(unsigned u) { return __uint_as_float(u & 0xFFFF0000u); }
__device__ __forceinline__ float bf2f(bf16_t b) { return __uint_as_float(((unsigned)b) << 16); }
__device__ __forceinline__ f32x4 unpk4(u32x2 v) { return (f32x4){bflo(v.x), bfhi(v.x), bflo(v.y), bfhi(v.y)}; }
__device__ __forceinline__ u32x2 pk4(f32x4 v) { u32x2 r; r.x = pk2(v[0], v[1]); r.y = pk2(v[2], v[3]); return r; }
__device__ __forceinline__ float rcpf_(float x) { return __builtin_amdgcn_rcpf(x); }
__device__ __forceinline__ float sigmoidf_(float x) { return rcpf_(1.f + __expf(-x)); }
__device__ __forceinline__ float siluf_(float x) { return x * rcpf_(1.f + __expf(-x)); }
__device__ __forceinline__ float softplusf_(float x) { return x > 20.f ? x : log1pf(__expf(x)); }
__device__ __forceinline__ float gelu_tanh(float x) { const float u = 1.5957691216057308f * (x + 0.044715f * x * x * x); return x * rcpf_(1.f + __expf(-u)); }
__device__ __forceinline__ float tanhf_(float x) { return 1.f - 2.f * rcpf_(1.f + __expf(2.f * x)); }
template <int CTRL> __device__ __forceinline__ float dppf(float x) { return __builtin_bit_cast(float, __builtin_amdgcn_mov_dpp(__builtin_bit_cast(int, x), CTRL, 0xf, 0xf, true)); }
__device__ __forceinline__ float red16(float x) {
    x += dppf<0xB1>(x); x += dppf<0x4E>(x); x += dppf<0x141>(x); x += dppf<0x128>(x); return x;
}
__device__ __forceinline__ void red16x2(float& x, float& y) {
    x += dppf<0xB1>(x); y += dppf<0xB1>(y); x += dppf<0x4E>(x); y += dppf<0x4E>(y);
    x += dppf<0x141>(x); y += dppf<0x141>(y); x += dppf<0x128>(x); y += dppf<0x128>(y);
}
__device__ __forceinline__ float dot4(const f32x4& a, const f32x4& b) { return (a[0] * b[0] + a[2] * b[2]) + (a[1] * b[1] + a[3] * b[3]); }
__device__ __forceinline__ float red64(float x) {
#pragma unroll
    for (int o = 32; o > 0; o >>= 1) x += __shfl_xor(x, o);
    return x;
}
__device__ __forceinline__ void lbar() { asm volatile("s_waitcnt lgkmcnt(0)" ::: "memory"); __builtin_amdgcn_s_barrier(); asm volatile("" ::: "memory"); }
__device__ __forceinline__ int seqpos(int dir, int n) { return dir == 0 ? n : (n < CTX ? (CTX - 1 - n) : (TT - 1 - (n - CTX))); }
__device__ __forceinline__ int s5pos(int j) { if (j < CTX) return j; const int tok = j - CTX; return CTX + (tok & 63) * 128 + (tok >> 6); }

#define XB_TMO      128
#define XB_XCNT(j)  (256  + 64 * (j))
#define XB_XSUB(j)  (1280 + 64 * (j))
#define XB_XGEN(j)  (2304 + 64 * (j))
#define XB_TOP      3328
#define XB_TOPGEN   3392
#define XCD_BAR_WORDS 3456
#define XB_SPIN_CAP (1u << 18)

__device__ __forceinline__ unsigned xb_ld(unsigned* p)              { return __hip_atomic_load(p, __ATOMIC_RELAXED, __HIP_MEMORY_SCOPE_AGENT); }
__device__ __forceinline__ unsigned xb_add(unsigned* p, unsigned v) { return __hip_atomic_fetch_add(p, v, __ATOMIC_RELAXED, __HIP_MEMORY_SCOPE_AGENT); }
__device__ __forceinline__ unsigned xb_xcc_id() { return (unsigned)__builtin_amdgcn_s_getreg((3 << 11) | 20) & 0xFu; }
#define XB_SPIN(cond, bar) do { unsigned _sp = 0; while (cond) { __builtin_amdgcn_s_sleep(1); \
    if ((++_sp & 255u) == 0u) { if (xb_ld(&(bar)[XB_TMO])) break; if (_sp > XB_SPIN_CAP) { atomicAdd(&(bar)[XB_TMO], 1u); break; } } } } while (0)

struct XcdBarrier {
    int wv;
    unsigned* bar; unsigned x;
    volatile LAS unsigned* st;
};

__device__ __forceinline__ XcdBarrier xcd_barrier_post(unsigned* bar, volatile LAS unsigned* st, int wv) {
    XcdBarrier b; b.bar = bar; b.x = xb_xcc_id(); b.st = st; b.wv = wv;
    if (wv == 0 && lane_id() == 0) (void)xb_add(&bar[XB_XCNT(b.x)], 1u);
    return b;
}
__device__ __forceinline__ void xcd_barrier_complete(unsigned* bar, unsigned x, unsigned& nloc, unsigned& nx) {
    const unsigned G = gridDim.x * gridDim.y * gridDim.z;
    unsigned sum, cnt, mine, sp = 0u;
    for (;;) {
        sum = 0u; cnt = 0u; mine = 0u;
#pragma unroll
        for (unsigned j = 0; j < 16; ++j) { const unsigned c = xb_ld(&bar[XB_XCNT(j)]); sum += c; cnt += (c > 0u) ? 1u : 0u; mine = (j == x) ? c : mine; }
        if (sum == G) break;
        __builtin_amdgcn_s_sleep(1);
        if ((++sp & 255u) == 0u) { if (xb_ld(&bar[XB_TMO])) break; if (sp > XB_SPIN_CAP) { atomicAdd(&bar[XB_TMO], 1u); break; } }
    }
    nloc = mine > 0u ? mine : 1u; nx = cnt > 0u ? cnt : 1u;
}

__device__ __forceinline__ void xcd_barrier(const XcdBarrier& b) {
    asm volatile("s_waitcnt vmcnt(0)" ::: "memory");
    __syncthreads();
    if (b.wv == 0 && lane_id() == 0) {
        unsigned* bar = b.bar;
        __builtin_amdgcn_s_waitcnt(0);
        unsigned nloc = b.st[0], nx = b.st[1];
        if (nloc == 0u) { xcd_barrier_complete(bar, b.x, nloc, nx); b.st[0] = nloc; b.st[1] = nx; }
        const unsigned old = xb_add(&bar[XB_XSUB(b.x)], 1u);
        const unsigned gen = old / nloc;
        if (old + 1u == (gen + 1u) * nloc) {
            __builtin_amdgcn_fence(__ATOMIC_RELEASE, "agent");
            asm volatile("s_waitcnt vmcnt(0)" ::: "memory");
            const unsigned og = xb_add(&bar[XB_TOP], 1u);
            const unsigned tg = og / nx;
            if (og + 1u == (tg + 1u) * nx) xb_add(&bar[XB_TOPGEN], 1u);
            else XB_SPIN(xb_ld(&bar[XB_TOPGEN]) == tg, bar);
            __builtin_amdgcn_fence(__ATOMIC_ACQUIRE, "agent");
            xb_add(&bar[XB_XGEN(b.x)], 1u);
            asm volatile("s_waitcnt vmcnt(0)" ::: "memory");
        } else {
            XB_SPIN(xb_ld(&bar[XB_XGEN(b.x)]) == gen, bar);
            __builtin_amdgcn_fence(__ATOMIC_ACQUIRE, "agent");
            asm volatile("s_waitcnt vmcnt(0)" ::: "memory");
        }
    }
    __syncthreads();
}


namespace pg8 {
constexpr int BM = 256, BK = 64, HALF = 128, HTB = HALF * BK * 2, NXCD = 8, WGM = 8;
__device__ __forceinline__ int lds_byte(int r, int c) { const int st = (r >> 4) * 2 + (c >> 5), rr = r & 15, cc = c & 31, ob = rr * 64 + cc * 2; return st * 1024 + (ob ^ (((ob >> 9) & 1) << 5)); }
__device__ __forceinline__ void stage_rc(int b, int& R, int& C) { const int st = b / 1024, sb = b % 1024, swz = sb ^ (((sb >> 9) & 1) << 5); R = (st >> 1) * 16 + swz / 64; C = (st & 1) * 32 + (swz % 64) / 2; }
__device__ __forceinline__ int perm32(int rho) { const int n = rho >> 4, i = rho & 15; return 8 * (i >> 2) + 4 * n + (i & 3); }
struct Unit { int pm, pn, grp; size_t aoff, boff; };
struct Gemm { const bf16_t* A; const bf16_t* Bt; int K, lda, ldb; };
struct Sched {
    int mode, nM, nN, nwg, G, c; size_t gA, gB, tA, tB;
    __device__ bool next(int i, Unit& u) const {
        const long L = (long)i * G + c; if (L >= nwg) return false;
        if (mode == 0) {
            int wgid = (int)L; { const int q = nwg / NXCD, r = nwg % NXCD, xcd = wgid % NXCD, off = wgid / NXCD; wgid = (xcd < r ? xcd * (q + 1) : r * (q + 1) + (xcd - r) * q) + off; }
            const int nig = WGM * nN, gid = wgid / nig, fm = gid * WGM, gsz = (nM - fm) < WGM ? (nM - fm) : WGM;
            u.pm = fm + ((wgid % nig) % gsz); u.pn = (wgid % nig) / gsz; u.grp = 0;
        } else {
            const int upg = nM * nN; u.grp = (int)L / upg; const int rem = (int)L % upg; u.pm = rem % nM; u.pn = rem / nM;
        }
        u.aoff = (size_t)u.grp * gA + (size_t)u.pm * tA; u.boff = (size_t)u.grp * gB + (size_t)u.pn * tB; return true;
    }
};

template <class Epi>
__device__ __forceinline__ void gemm_phase(LAS uchar* lds, const Gemm g, const Sched& S, const Epi& E, int wv) {
    const int tid = tid_of(wv), wid = __builtin_amdgcn_readfirstlane(tid >> 6), lane = tid & 63, wr = wid >> 2, wc = wid & 3, fr = lane & 15, fq = lane >> 4;
    const int K = g.K, nt = K / BK;
    unsigned voffA[2], voffB[2];
#pragma unroll
    for (int i = 0; i < 2; ++i) { int R, C; stage_rc(tid * 16 + i * 8192, R, C); const int Rb = Epi::PERM ? ((R & ~31) + perm32(R & 31)) : R;
        voffA[i] = (unsigned)(R * g.lda + C) * 2u; voffB[i] = (unsigned)(Rb * g.ldb + C) * 2u; }
    const size_t kstep = (size_t)(BK * 2);
    const size_t hstepA = (size_t)HALF * g.lda * 2, hstepB = (size_t)HALF * g.ldb * 2;
    const unsigned ldsw = (unsigned)wid * 1024u;
    const int aoff = lds_byte(wr * 64 + fr, fq * 8), boff = lds_byte(wc * 32 + fr, fq * 8);
#define PG8_SA(b, h) (((b) * 2 + (h)) * HTB)
#define PG8_SB(b, h) ((4 + (b) * 2 + (h)) * HTB)
#define PG8_STAGE(bufoff, gbase, voff) do { _Pragma("unroll") for (int _i = 0; _i < 2; ++_i) \
        __builtin_amdgcn_global_load_lds((const unsigned*)((const char*)(gbase) + (voff)[_i]), (LAS unsigned*)(lds + (bufoff) + ldsw + _i * 8192), 16, 0, 0); } while (0)
#define PG8_LDA(dst, b, h) do { _Pragma("unroll") for (int m = 0; m < 4; ++m) _Pragma("unroll") for (int k = 0; k < 2; ++k) dst[m][k] = *(const LAS bf16x8*)(lds + PG8_SA(b, h) + aoff + m * 2048 + k * 1024); } while (0)
#define PG8_LDB(dst, b, h) do { _Pragma("unroll") for (int n = 0; n < 2; ++n) _Pragma("unroll") for (int k = 0; k < 2; ++k) dst[n][k] = *(const LAS bf16x8*)(lds + PG8_SB(b, h) + boff + n * 2048 + k * 1024); } while (0)
#define PG8_MMA(ai, bj, At, Bt) do { __builtin_amdgcn_s_setprio(1); _Pragma("unroll") for (int m = 0; m < 4; ++m) _Pragma("unroll") for (int n = 0; n < 2; ++n) _Pragma("unroll") for (int k = 0; k < 2; ++k) \
        acc[ai][bj][m][n] = __builtin_amdgcn_mfma_f32_16x16x32_bf16(Bt[n][k], At[m][k], acc[ai][bj][m][n], 0, 0, 0); __builtin_amdgcn_s_setprio(0); } while (0)
#define PG8_WAIT_V(n) asm volatile("s_waitcnt vmcnt(" #n ")" ::: "memory")
#define PG8_WAIT_L(n) asm volatile("s_waitcnt lgkmcnt(" #n ")" ::: "memory")
#define PG8_BAR __builtin_amdgcn_s_barrier()
#define PG8_SCHED __builtin_amdgcn_sched_barrier(0)
    Unit cur, nxt; int ui = 0;
    if (!S.next(0, cur)) return;
    f32x4 acc[2][2][4][2];
#pragma unroll
    for (int a = 0; a < 2; ++a)
#pragma unroll
        for (int b = 0; b < 2; ++b)
#pragma unroll
            for (int m = 0; m < 4; ++m)
#pragma unroll
                for (int n = 0; n < 2; ++n) acc[a][b][m][n] = (f32x4){0.f, 0.f, 0.f, 0.f};
    bf16x8 At[4][2], B0[2][2], B1[2][2];
    const char* cA = (const char*)g.A + cur.aoff; const char* cB = (const char*)g.Bt + cur.boff;
    PG8_STAGE(PG8_SB(0, 0), cB, voffB); PG8_STAGE(PG8_SA(0, 0), cA, voffA); PG8_STAGE(PG8_SB(0, 1), cB + hstepB, voffB); PG8_STAGE(PG8_SA(0, 1), cA + hstepA, voffA);
    if (wr == 1) PG8_BAR;
    PG8_WAIT_V(4); PG8_BAR;
    PG8_STAGE(PG8_SB(1, 0), cB + kstep, voffB); PG8_STAGE(PG8_SA(1, 0), cA + kstep, voffA); PG8_STAGE(PG8_SB(1, 1), cB + hstepB + kstep, voffB);
    PG8_WAIT_V(6); PG8_BAR;
    for (;;) {
        const bool has_next = S.next(ui + 1, nxt);
        const char* nA = has_next ? (const char*)g.A + nxt.aoff : cA; const char* nB = has_next ? (const char*)g.Bt + nxt.boff : cB;
        for (int t = 0; t < nt; t += 2) {
            const bool last = (t == nt - 2);
            const char* a1 = cA + (size_t)(t + 1) * kstep;
            const char* a2 = last ? nA : cA + (size_t)(t + 2) * kstep; const char* b2 = last ? nB : cB + (size_t)(t + 2) * kstep;
            const char* a3 = a2 + kstep; const char* b3 = b2 + kstep;
            PG8_LDB(B0, 0, 0); PG8_SCHED; PG8_LDA(At, 0, 0); PG8_STAGE(PG8_SA(1, 1), a1 + hstepA, voffA);
            PG8_WAIT_L(8); PG8_BAR; PG8_WAIT_L(0); PG8_MMA(0, 0, At, B0); PG8_BAR; PG8_SCHED;
            PG8_LDB(B1, 0, 1); PG8_STAGE(PG8_SB(0, 0), b2, voffB);
            PG8_BAR; PG8_WAIT_L(0); PG8_MMA(0, 1, At, B1); PG8_BAR;
            PG8_LDA(At, 0, 1); PG8_STAGE(PG8_SA(0, 0), a2, voffA);
            PG8_BAR; PG8_WAIT_L(0); PG8_MMA(1, 0, At, B0); PG8_BAR; PG8_SCHED;
            PG8_STAGE(PG8_SB(0, 1), b2 + hstepB, voffB);
            PG8_WAIT_V(6); PG8_BAR; PG8_MMA(1, 1, At, B1); PG8_BAR;
            PG8_LDB(B0, 1, 0); PG8_SCHED; PG8_LDA(At, 1, 0); PG8_STAGE(PG8_SA(0, 1), a2 + hstepA, voffA);
            PG8_WAIT_L(8); PG8_BAR; PG8_WAIT_L(0); PG8_MMA(0, 0, At, B0); PG8_BAR; PG8_SCHED;
            PG8_LDB(B1, 1, 1); PG8_STAGE(PG8_SB(1, 0), b3, voffB);
            PG8_BAR; PG8_WAIT_L(0); PG8_MMA(0, 1, At, B1); PG8_BAR;
            PG8_LDA(At, 1, 1); PG8_STAGE(PG8_SA(1, 0), a3, voffA);
            PG8_BAR; PG8_WAIT_L(0); PG8_MMA(1, 0, At, B0); PG8_BAR; PG8_SCHED;
            PG8_STAGE(PG8_SB(1, 1), b3 + hstepB, voffB);
            PG8_WAIT_V(6); PG8_BAR; PG8_MMA(1, 1, At, B1); PG8_BAR;
        }
        E(acc, cur, wr, wc, fr, fq);
        if (!has_next) break;
#pragma unroll
        for (int a = 0; a < 2; ++a)
#pragma unroll
            for (int b = 0; b < 2; ++b)
#pragma unroll
                for (int m = 0; m < 4; ++m)
#pragma unroll
                    for (int n = 0; n < 2; ++n) acc[a][b][m][n] = (f32x4){0.f, 0.f, 0.f, 0.f};
        cur = nxt; cA = nA; cB = nB; ++ui;
    }
    PG8_WAIT_V(0);
    if (wr == 0) PG8_BAR;
    PG8_BAR;
#undef PG8_SA
#undef PG8_SB
#undef PG8_STAGE
#undef PG8_LDA
#undef PG8_LDB
#undef PG8_MMA
#undef PG8_WAIT_V
#undef PG8_WAIT_L
#undef PG8_BAR
#undef PG8_SCHED
}
}
using pg8::Unit;

struct EpiZ {
    static constexpr bool PERM = true;
    bf16_t* Z; bf16_t* A2;
    __device__ __forceinline__ void operator()(const f32x4 (&acc)[2][2][4][2], const Unit& u, int wr, int wc, int fr, int fq) const {
#pragma unroll
        for (int ai = 0; ai < 2; ++ai)
#pragma unroll
            for (int m = 0; m < 4; ++m) {
                const int r = u.pm * 256 + ai * 128 + wr * 64 + m * 16 + fr;
#pragma unroll
                for (int bj = 0; bj < 2; ++bj) {
                    const int c = u.pn * 256 + bj * 128 + wc * 32 + 8 * fq;
                    u32x4 w; w.x = pk2(acc[ai][bj][m][0][0], acc[ai][bj][m][0][1]); w.y = pk2(acc[ai][bj][m][0][2], acc[ai][bj][m][0][3]);
                    w.z = pk2(acc[ai][bj][m][1][0], acc[ai][bj][m][1][1]); w.w = pk2(acc[ai][bj][m][1][2], acc[ai][bj][m][1][3]);
                    if (u.pn == 0) {
                        const int b = r / TT, j = r - b * TT, n = s5pos(j), R = b * NCH + (n >> 5), s = n & 31, g = c >> 4, h0 = c & 15;
                        bf16_t* d0 = A2 + ((size_t)((g * 2) * GROWS + R)) * 640 + s * 16 + h0;
                        *(u32x4*)d0 = w; *(u32x4*)(d0 + (size_t)GROWS * 640) = w;
                    } else {
                        const int zc = c - 256;
                        if (zc < ZLD) *(u32x4*)(Z + (size_t)r * ZLD + zc) = w;
                    }
                }
            }
    }
};
struct EpiResid {
    static constexpr bool PERM = false;
    const float* xin; float* xout; const float* cin; float* cout; const float* mod; int gidx;
    __device__ __forceinline__ void operator()(const f32x4 (&acc)[2][2][4][2], const Unit& u, int wr, int wc, int fr, int fq) const {
        const int b = u.pm / 33, tb = u.pm - b * 33;
        const bool isctx = (tb == 0);
        const float* gate = mod + (size_t)(isctx ? 4 : b) * 6144 + gidx * 1024;
        const size_t row0 = isctx ? (size_t)b * CTX : (size_t)b * SEQ + (size_t)(tb - 1) * 256;
        const float* src = isctx ? cin : xin; float* dst = isctx ? cout : xout;
        const int col0 = u.pn * 256 + wc * 32 + 4 * fq;
#pragma unroll
        for (int ai = 0; ai < 2; ++ai)
#pragma unroll
            for (int m = 0; m < 4; ++m) {
                const size_t ro = (row0 + ai * 128 + wr * 64 + m * 16 + fr) * DM;
#pragma unroll
                for (int bj = 0; bj < 2; ++bj)
#pragma unroll
                    for (int n = 0; n < 2; ++n) {
                        const int c = col0 + bj * 128 + n * 16;
                        const f32x4 gv = *(const f32x4*)(gate + c); const f32x4 xv = *(const f32x4*)(src + ro + c);
                        *(f32x4*)(dst + ro + c) = xv + gv * acc[ai][bj][m][n];
                    }
                asm volatile("" ::: "memory");
            }
    }
};
struct EpiSwiGLU {
    static constexpr bool PERM = false;
    bf16_t* HID;
    __device__ __forceinline__ void operator()(const f32x4 (&acc)[2][2][4][2], const Unit& u, int wr, int wc, int fr, int fq) const {
#pragma unroll
        for (int ai = 0; ai < 2; ++ai)
#pragma unroll
            for (int m = 0; m < 4; ++m) {
                const size_t r = (size_t)(u.pm * 256 + ai * 128 + wr * 64 + m * 16 + fr);
#pragma unroll
                for (int bj = 0; bj < 2; ++bj) {
                    const int hc = u.pn * 128 + bj * 64 + wc * 16 + 4 * fq;
                    f32x4 o;
#pragma unroll
                    for (int i = 0; i < 4; ++i) o[i] = siluf_(acc[ai][bj][m][0][i]) * acc[ai][bj][m][1][i];
                    *(u32x2*)(HID + r * FFN + hc) = pk4(o);
                }
                asm volatile("" ::: "memory");
            }
    }
};
struct EpiHL {
    static constexpr bool PERM = false;
    float* HL;
    __device__ __forceinline__ void operator()(const f32x4 (&acc)[2][2][4][2], const Unit& u, int wr, int wc, int fr, int fq) const {
#pragma unroll
        for (int ai = 0; ai < 2; ++ai)
#pragma unroll
            for (int m = 0; m < 4; ++m) {
                const int R = u.pm * 256 + ai * 128 + wr * 64 + m * 16 + fr;
                if (R < GROWS) {
                    float* rp = HL + ((size_t)u.grp * GROWS + R) * 256 + wc * 32 + 4 * fq;
#pragma unroll
                    for (int bj = 0; bj < 2; ++bj)
#pragma unroll
                        for (int n = 0; n < 2; ++n) *(f32x4*)(rp + bj * 128 + n * 16) = acc[ai][bj][m][n];
                }
                asm volatile("" ::: "memory");
            }
    }
};
struct EpiY5 {
    static constexpr bool PERM = true;
    bf16_t* Y5;
    __device__ __forceinline__ void operator()(const f32x4 (&acc)[2][2][4][2], const Unit& u, int wr, int wc, int fr, int fq) const {
#pragma unroll
        for (int ai = 0; ai < 2; ++ai)
#pragma unroll
            for (int m = 0; m < 4; ++m) {
                const int R = u.pm * 256 + ai * 128 + wr * 64 + m * 16 + fr;
                if (R < GROWS) {
                    bf16_t* rp = Y5 + ((size_t)u.grp * GROWS + R) * 512 + u.pn * 256 + wc * 32 + 8 * fq;
#pragma unroll
                    for (int bj = 0; bj < 2; ++bj) {
                        u32x4 w; w.x = pk2(acc[ai][bj][m][0][0], acc[ai][bj][m][0][1]); w.y = pk2(acc[ai][bj][m][0][2], acc[ai][bj][m][0][3]);
                        w.z = pk2(acc[ai][bj][m][1][0], acc[ai][bj][m][1][1]); w.w = pk2(acc[ai][bj][m][1][2], acc[ai][bj][m][1][3]);
                        *(u32x4*)(rp + bj * 128) = w;
                    }
                }
            }
    }
};

__device__ __forceinline__ pg8::Sched sched_static(int M, int N, int lda, int ldb) {
    pg8::Sched S; S.mode = 0; S.nM = M / 256; S.nN = N / 256; S.nwg = S.nM * S.nN; S.G = gridDim.x; S.c = bidx();
    S.gA = 0; S.gB = 0; S.tA = (size_t)256 * lda * 2; S.tB = (size_t)256 * ldb * 2; return S;
}

__device__ __forceinline__ void phase_mod(const PP& p, float* sm) {
    float* sv = sm;
    float* part = sm + 5 * 1024;
    const int tid = tid_of(p.wv), w = tid >> 6, lane = tid & 63;
    for (int i = tid; i < 5 * 1024; i += 512) { const int v = i >> 10, k = i & 1023; const float x = v < 4 ? p.in[I_C][v * 1024 + k] : p.in[I_CCTX][k]; sv[i] = siluf_(x); }
    __syncthreads();
    float* mod = (float*)(p.ws + OFF_MOD);
    for (int it = bidx(); it < DEPTH * 48; it += gridDim.x) {
        const int l = it / 48, cb = it - l * 48, col = cb * 128 + 2 * lane;
        const float* W = p.in[I_ADAW] + (size_t)l * 1024 * 6144 + col;
        f32x2 a[5];
#pragma unroll
        for (int i = 0; i < 5; ++i) a[i] = (f32x2){0.f, 0.f};
#pragma unroll 8
        for (int k = w * 128; k < w * 128 + 128; ++k) {
            const f32x2 wv = *(const f32x2*)(W + (size_t)k * 6144);
#pragma unroll
            for (int i = 0; i < 5; ++i) a[i] += sv[i * 1024 + k] * wv;
        }
#pragma unroll
        for (int i = 0; i < 5; ++i) { part[(w * 5 + i) * 128 + 2 * lane] = a[i].x; part[(w * 5 + i) * 128 + 2 * lane + 1] = a[i].y; }
        __syncthreads();
        for (int o = tid; o < 640; o += 512) { const int i = o >> 7, cc = o & 127; float s = 0.f;
#pragma unroll
            for (int ww = 0; ww < 8; ++ww) s += part[(ww * 5 + i) * 128 + cc];
            mod[((size_t)l * 5 + i) * 6144 + cb * 128 + cc] = s + p.in[I_ADAB][l * 6144 + cb * 128 + cc]; }
        __syncthreads();
    }
}

__device__ __forceinline__ int n_coef_blocks() { return gridDim.x >= 128 ? 64 : 0; }
__device__ __forceinline__ void convT_tile(const float* src, const float* src2, int ldn, bf16_t* dst, int K, int kind, int n0, int k0, float* sm, int wv) {
    const int tid = tid_of(wv);
    {
        const int nn = tid & 63, kq = tid >> 6;
        const int np = n0 + nn; const float* s = src; int col;
        if (kind == 0) col = np < 256 ? 2968 + np : (np < 3224 ? np - 256 : -1);
        else if (kind == 1) col = np;
        else { const int G = np >> 5, w = np & 31; col = 16 * G + (w & 15); if (w >= 16) s = src2; }
#pragma unroll
        for (int i = 0; i < 8; ++i) { const int kk = kq + 8 * i; sm[kk * 65 + nn] = col >= 0 ? s[(size_t)(k0 + kk) * ldn + col] : 0.f; }
    }
    __syncthreads();
    {
        const int n = tid >> 3, ks = (tid & 7) * 8;
        u32x4 w; w.x = pk2(sm[(ks + 0) * 65 + n], sm[(ks + 1) * 65 + n]); w.y = pk2(sm[(ks + 2) * 65 + n], sm[(ks + 3) * 65 + n]);
        w.z = pk2(sm[(ks + 4) * 65 + n], sm[(ks + 5) * 65 + n]); w.w = pk2(sm[(ks + 6) * 65 + n], sm[(ks + 7) * 65 + n]);
        *(u32x4*)(dst + (size_t)(n0 + n) * K + k0 + ks) = w;
    }
    __syncthreads();
}
__device__ __forceinline__ void phase_convw(const PP& p, int l, float* sm, int w0, int nwb, int ffn) {
    constexpr int T0 = 832, T1 = T0 + 256, T2 = T1 + 1408, T3 = T2 + 704, T4 = T3 + 12, T5 = T4 + 12, T6 = T5 + 12, T7 = T6 + 16;
    const int wb = bidx() - w0;
    if (wb < 0 || wb >= nwb) return;
    const int nt = ffn ? (T3 - T1) : (T7 - (T3 - T1));
    for (int tt = wb; tt < nt; tt += nwb) {
        const int t = ffn ? tt + T1 : (tt < T1 ? tt : tt + (T3 - T1));
        if (t < T0) { convT_tile(p.in[I_WIN] + (size_t)l * 1024 * 3224, nullptr, 3224, (bf16_t*)(p.ws + OFF_WIN), 1024, 0, (t >> 4) * 64, (t & 15) * 64, sm, p.wv); }
        else if (t < T1) { const int q = t - T0; convT_tile(p.in[I_WOUT] + (size_t)l * 1024 * 1024, nullptr, 1024, (bf16_t*)(p.ws + OFF_WOUT), 1024, 1, (q >> 4) * 64, (q & 15) * 64, sm, p.wv); }
        else if (t < T2) { const int q = t - T1; convT_tile(p.in[I_FG8] + (size_t)l * 1024 * FFN, p.in[I_FU] + (size_t)l * 1024 * FFN, FFN, (bf16_t*)(p.ws + OFF_WGU), 1024, 2, (q >> 4) * 64, (q & 15) * 64, sm, p.wv); }
        else if (t < T3) { const int q = t - T2; convT_tile(p.in[I_FD] + (size_t)l * FFN * 1024, nullptr, 1024, (bf16_t*)(p.ws + OFF_WDN), FFN, 1, (q / 44) * 64, (q % 44) * 64, sm, p.wv); }
        else if (t < T4) { const int q = t - T3, d = q / 6; convT_tile(p.in[I_WUP] + ((size_t)l * 2 + d) * 64 * 384, nullptr, 384, (bf16_t*)(p.ws + OFF_WUP) + d * 384 * 64, 64, 1, (q % 6) * 64, 0, sm, p.wv); }
        else if (t < T5) { const int q = t - T4, d = q / 6; convT_tile(p.in[I_AUP] + ((size_t)l * 2 + d) * 64 * 384, nullptr, 384, (bf16_t*)(p.ws + OFF_AUP) + d * 384 * 64, 64, 1, (q % 6) * 64, 0, sm, p.wv); }
        else if (t < T6) { const int q = t - T5; convT_tile(p.in[I_GUP] + (size_t)l * 128 * 384, nullptr, 384, (bf16_t*)(p.ws + OFF_GUP), 128, 1, (q >> 1) * 64, (q & 1) * 64, sm, p.wv); }
        else { const int q = t - T6; convT_tile(p.in[I_GLUW] + (size_t)l * 256 * 256, nullptr, 256, (bf16_t*)(p.ws + OFF_GLU), 256, 1, (q >> 2) * 64, (q & 3) * 64, sm, p.wv); }
    }
}

__device__ __forceinline__ void phase_s5coef(const PP& p, int l, float* sm) {
    float* pw = sm;
    float* bb = pw + 33 * 128;
    float* cc = bb + 2048;
    float* Kt = cc + 2048;
    const int tid = tid_of(p.wv);
    bf16_t* TF = (bf16_t*)(p.ws + OFF_TF); bf16_t* E2 = (bf16_t*)(p.ws + OFF_E2); float* DP = (float*)(p.ws + OFF_DP);
    for (int item = (int)gridDim.x - 1 - (int)bidx(); item < 64; item += gridDim.x) {
        const int it = item >> 1, part = item & 1, g = it >> 1, dir = it & 1;
        const size_t base = ((size_t)l * 2 + dir) * 16 + g;
        if (tid < 64) {
            const int q = tid;
            const float lre = p.in[I_LRE][base * 64 + q], lim = p.in[I_LIM][base * 64 + q], dt = __expf(p.in[I_LDT][base]);
            const float mag = __expf(lre * dt); float sn, cs; sincosf(lim * dt, &sn, &cs);
            const float are = mag * cs, aim = mag * sn, den = lre * lre + lim * lim;
            const float fre = ((are - 1.f) * lre + aim * lim) / den, fim = (aim * lre - (are - 1.f) * lim) / den;
            float pr = 1.f, pi = 0.f;
            for (int m = 0; m <= 32; ++m) { pw[(m * 64 + q) * 2] = pr; pw[(m * 64 + q) * 2 + 1] = pi; const float nr = pr * are - pi * aim, ni = pr * aim + pi * are; pr = nr; pi = ni; }
            for (int h = 0; h < 16; ++h) { const float br = p.in[I_BRE][(base * 64 + q) * 16 + h], bi = p.in[I_BIM][(base * 64 + q) * 16 + h];
                bb[(q * 16 + h) * 2] = fre * br - fim * bi; bb[(q * 16 + h) * 2 + 1] = fre * bi + fim * br; }
            if (part == 0) { DP[(it * 64 + q) * 2] = pw[(32 * 64 + q) * 2]; DP[(it * 64 + q) * 2 + 1] = pw[(32 * 64 + q) * 2 + 1]; }
        }
        for (int i = tid; i < 1024; i += 512) { const int h = i >> 6, q = i & 63; cc[i * 2] = p.in[I_CRE][(base * 16 + h) * 64 + q]; cc[i * 2 + 1] = p.in[I_CIM][(base * 16 + h) * 64 + q]; }
        __syncthreads();
        {
            const int lag = tid >> 4, hp = tid & 15;
            float s[16];
#pragma unroll
            for (int h = 0; h < 16; ++h) s[h] = 0.f;
            for (int q = 0; q < 64; ++q) {
                const f32x2 c2 = *(const f32x2*)(cc + (hp * 64 + q) * 2), w2 = *(const f32x2*)(pw + (lag * 64 + q) * 2);
                const float xr = c2.x * w2.x - c2.y * w2.y, xi = c2.x * w2.y + c2.y * w2.x;
#pragma unroll
                for (int h4 = 0; h4 < 8; ++h4) { const f32x4 b4 = *(const f32x4*)(bb + (q * 16 + 2 * h4) * 2); s[2 * h4] += xr * b4[0] - xi * b4[1]; s[2 * h4 + 1] += xr * b4[2] - xi * b4[3]; }
            }
#pragma unroll
            for (int h4 = 0; h4 < 4; ++h4) *(f32x4*)(Kt + lag * 256 + hp * 16 + 4 * h4) = (f32x4){s[4 * h4], s[4 * h4 + 1], s[4 * h4 + 2], s[4 * h4 + 3]};
        }
        __syncthreads();
        bf16_t* tf = TF + (size_t)it * 512 * 640;
        for (int o = part * 256 * 320 + tid; o < (part + 1) * 256 * 320; o += 512) {
            const int row = o / 320, c2 = (o - row * 320) * 2, t = row >> 4, hp = row & 15;
            float v[2];
            if (c2 < 512) {
#pragma unroll
                for (int e = 0; e < 2; ++e) { const int col = c2 + e, s = col >> 4, h = col & 15; const int lag = dir == 0 ? t - s : s - t; v[e] = lag >= 0 ? Kt[lag * 256 + hp * 16 + h] : 0.f; }
            } else {
                const int q = (c2 - 512) >> 1, m = dir == 0 ? t + 1 : 32 - t;
                const float cr = cc[(hp * 64 + q) * 2], ci = cc[(hp * 64 + q) * 2 + 1], wr_ = pw[(m * 64 + q) * 2], wi = pw[(m * 64 + q) * 2 + 1];
                v[0] = cr * wr_ - ci * wi; v[1] = -(cr * wi + ci * wr_);
            }
            *(unsigned*)(tf + (size_t)row * 640 + c2) = pk2(v[0], v[1]);
        }
        bf16_t* e2 = E2 + ((size_t)g * 256 + dir * 128) * 512;
        for (int o = part * 64 * 256 + tid; o < (part + 1) * 64 * 256; o += 512) {
            const int row = o >> 8, c2 = (o & 255) * 2, q = row >> 1, ri = row & 1; float v[2];
#pragma unroll
            for (int e = 0; e < 2; ++e) { const int col = c2 + e, s = col >> 4, h = col & 15, ex = dir == 0 ? 31 - s : s;
                const float wr_ = pw[(ex * 64 + q) * 2], wi = pw[(ex * 64 + q) * 2 + 1], br = bb[(q * 16 + h) * 2], bi = bb[(q * 16 + h) * 2 + 1];
                v[e] = ri == 0 ? (wr_ * br - wi * bi) : (wr_ * bi + wi * br); }
            *(unsigned*)(e2 + (size_t)row * 512 + c2) = pk2(v[0], v[1]);
        }
        __syncthreads();
    }
}

__device__ __forceinline__ void phase_norm(const PP& p, int l, int which, const float* xsrc, const float* csrc, int share) {
    const int nwb = (int)gridDim.x - (share ? n_coef_blocks() : 0);
    if (bidx() >= nwb) return;
    const int lane = tid_of(p.wv) & 63, gw = bidx() * 8 + (tid_of(p.wv) >> 6), nw = nwb * 8;
    const float* gain = p.in[which == 0 ? I_N1G : I_N2G] + l * 1024;
    const float* mod = (const float*)(p.ws + OFF_MOD) + (size_t)l * 5 * 6144;
    bf16_t* H = (bf16_t*)(p.ws + OFF_H);
    for (int r = gw; r < MROWS; r += nw) {
        const int b = r / TT, j = r - b * TT;
        const float* src = j < CTX ? csrc + ((size_t)b * CTX + j) * DM : xsrc + ((size_t)b * SEQ + (j - CTX)) * DM;
        const float* mv = mod + (size_t)(j < CTX ? 4 : b) * 6144 + (which == 0 ? 0 : 3072);
        f32x4 v[4]; float ss = 0.f;
#pragma unroll
        for (int i = 0; i < 4; ++i) { v[i] = *(const f32x4*)(src + i * 256 + lane * 4); ss += v[i][0] * v[i][0] + v[i][1] * v[i][1] + v[i][2] * v[i][2] + v[i][3] * v[i][3]; }
        ss = red64(ss);
        const float rs = __builtin_amdgcn_rsqf(ss * (1.f / 1024.f) + 1e-6f);
#pragma unroll
        for (int i = 0; i < 4; ++i) {
            const int c = i * 256 + lane * 4;
            const f32x4 gv = *(const f32x4*)(gain + c), sh = *(const f32x4*)(mv + c), sc = *(const f32x4*)(mv + 1024 + c);
            const f32x4 y = v[i] * rs * gv * (sc + 1.f) + sh;
            *(u32x2*)(H + (size_t)r * DM + c) = pk4(y);
        }
    }
}
__device__ __forceinline__ void phase_final(const PP& p) {
    const int lane = tid_of(p.wv) & 63, gw = bidx() * 8 + (tid_of(p.wv) >> 6), nw = gridDim.x * 8;
    const float* gain = p.in[I_FG];
    for (int r = gw; r < NB * SEQ; r += nw) {
        float* src = p.out + (size_t)r * DM;
        f32x4 v[4]; float ss = 0.f;
#pragma unroll
        for (int i = 0; i < 4; ++i) { v[i] = *(const f32x4*)(src + i * 256 + lane * 4); ss += v[i][0] * v[i][0] + v[i][1] * v[i][1] + v[i][2] * v[i][2] + v[i][3] * v[i][3]; }
        ss = red64(ss);
        const float rs = __builtin_amdgcn_rsqf(ss * (1.f / 1024.f) + 1e-6f);
#pragma unroll
        for (int i = 0; i < 4; ++i) { const int c = i * 256 + lane * 4; const f32x4 gv = *(const f32x4*)(gain + c); *(f32x4*)(src + c) = v[i] * rs * gv; }
    }
}

struct Nb3 { u32x2 pv, cu, nx; };
__device__ __forceinline__ Nb3 ld3(const bf16_t* Z, int row, bool hp, bool hn, int col) {
    Nb3 o; const bf16_t* q = Z + (size_t)row * ZLD + col;
    o.cu = *(const u32x2*)q;
    o.pv = hp ? *(const u32x2*)(q - ZLD) : (u32x2){0u, 0u};
    o.nx = hn ? *(const u32x2*)(q + ZLD) : (u32x2){0u, 0u};
    return o;
}
__device__ __forceinline__ f32x4 shiftmix(const Nb3& v, const float* mu) {
    const f32x4 c = unpk4(v.cu), a = unpk4(v.pv), n = unpk4(v.nx), m = *(const f32x4*)mu;
    return c + ((a + n) * 0.5f - c) * m;
}


constexpr int RWP_LD = 896;
__device__ __forceinline__ void phase_rwprep(const PP& p, int l) {
    const bf16_t* Z = (const bf16_t*)(p.ws + OFF_Z);
    bf16_t* RWP = (bf16_t*)(p.ws + OFF_H);
    const float* mu = p.in[I_MU] + l * 1408;
    const int nth = gridDim.x * 512;
    for (int idx = bidx() * 512 + tid_of(p.wv); idx < MROWS * 224; idx += nth) {
        const int row = idx / 224, qd = idx - row * 224, col0 = 4 * qd, zc = col0 < 768 ? col0 : col0 + 384;
        const int b = row / TT, j = row - b * TT;
        const bool hp = (j != 0) && (j != CTX), hn = (j != CTX - 1) && (j != TT - 1);
        f32x4 v = shiftmix(ld3(Z, row, hp, hn, zc), mu + zc);
        if (col0 >= 768 && col0 < 832) {
#pragma unroll
            for (int i = 0; i < 4; ++i) v[i] = tanhf_(v[i]);
        }
        *(u32x2*)(RWP + (size_t)row * RWP_LD + col0) = pk4(v);
    }
}

namespace ck {
constexpr int PC_STRIDE = 18432, PCB_BYTES = 36864, WKS0 = 73728, WKS_BYTES = 9216, WKP0 = 110592, WKP_BYTES = 3072, SW0 = 116736, SAA0 = 133120, SY0 = 149504, CST0 = 157696;
__device__ __forceinline__ bf16x8 mk8(u32x2 lo, u32x2 hi) { u32x4 t; t.x = lo.x; t.y = lo.y; t.z = hi.x; t.w = hi.y; return __builtin_bit_cast(bf16x8, t); }
__device__ __forceinline__ bf16x8 pk8z(f32x4 v) { return mk8(pk4(v), (u32x2){0u, 0u}); }
#define CK_MFMA(a, b, c) __builtin_amdgcn_mfma_f32_16x16x32_bf16(a, b, c, 0, 0, 0)
__device__ __forceinline__ int krow(int k) { return (k & ~3) | ((k + (k >> 3)) & 3); }
template <int TYPE, bool MIDBAR>
__device__ __forceinline__ void prep_wave(const char* pc, char* wkp, char* wks, int lane) {
    const int row16 = lane & 15, q = lane >> 4;
    const u32x2 Z2 = (u32x2){0u, 0u};
    const f32x4 z4 = (f32x4){0.f, 0.f, 0.f, 0.f};
    float* AMak = (float*)wkp; float* AMrb = (float*)(wkp + 1024); float* AMrk = (float*)(wkp + 2048);
    bf16_t* W1row = (bf16_t*)wks; bf16_t* R2row = (bf16_t*)(wks + 2304);
    const bf16_t* GA = (const bf16_t*)pc; const bf16_t* GR = (const bf16_t*)(pc + 2304); const bf16_t* GB = (const bf16_t*)(pc + 4608);
    const bf16_t* GK = (const bf16_t*)(pc + (TYPE == 0 ? 6912 : 4608));
    const bf16_t* GAT = (const bf16_t*)(pc + 9216); const bf16_t* VT = (const bf16_t*)(pc + 15360);
    const float* gc = (const float*)(pc + 17408);
    f32x4 gab = z4, gabT = z4, gak = z4, grb = z4, grk = z4;
#pragma unroll
    for (int ks = 0; ks < 2; ++ks) {
        const int o = row16 * 72 + 8 * q + 32 * ks;
        const bf16x8 ra = *(const bf16x8*)(GA + o), rr = *(const bf16x8*)(GR + o), cbf = *(const bf16x8*)(GB + o), ckf = *(const bf16x8*)(GK + o);
        gab = CK_MFMA(ra, cbf, gab); gabT = CK_MFMA(cbf, ra, gabT); gak = CK_MFMA(ra, ckf, gak); grb = CK_MFMA(rr, cbf, grb); grk = CK_MFMA(rr, ckf, grk);
    }
#pragma unroll
    for (int r = 0; r < 4; ++r) {
        const int t = 4 * q + r, i = row16; const bool ks_ = i < t, kl = i <= t;
        float dS = 1.f, dL = 1.f, dT = 1.f;
        if (TYPE == 1) { const float gi = gc[i]; dS = __expf(ks_ ? gc[t > 0 ? t - 1 : 0] - gi : 0.f); dL = __expf(kl ? gc[t] - gi : 0.f);
                         const int t2 = row16, i2 = 4 * q + r; dT = __expf(i2 < t2 ? gc[t2 - 1] - gc[i2] : 0.f); }
        gab[r] = ks_ ? gab[r] * dS : 0.f; gak[r] = ks_ ? gak[r] * dS : 0.f; grb[r] = kl ? grb[r] * dL : 0.f; grk[r] = kl ? grk[r] * dL : 0.f;
        gabT[r] = (4 * q + r < row16) ? gabT[r] * dT : 0.f;
    }
    f32x4 A = gab, AT = gabT, MT;
#pragma unroll
    for (int r = 0; r < 4; ++r) MT[r] = AT[r] + ((4 * q + r == row16) ? 1.f : 0.f);
#pragma unroll
    for (int s = 0; s < 3; ++s) {
        const bf16x8 pa = pk8z(A), pat = pk8z(AT);
        const f32x4 A2 = CK_MFMA(pat, pa, z4);
        MT = CK_MFMA(pk8z(A2), pk8z(MT), MT);
        if (s < 2) { AT = CK_MFMA(pa, pat, z4); A = A2; }
    }
    if (MIDBAR) lbar();
    const bf16x8 mplain = pk8z(MT);
    bf16x8 mfA = mplain;
    if (TYPE == 1) mfA = pk8z(MT * *(const f32x4*)(gc + 32 + 4 * q));
#pragma unroll
    for (int r = 0; r < 4; ++r) { AMak[(4 * q + r) * 16 + row16] = gak[r]; AMrb[(4 * q + r) * 16 + row16] = grb[r]; AMrk[(4 * q + r) * 16 + row16] = grk[r]; }
    const f32x4 aak4 = *(const f32x4*)(AMak + row16 * 16 + 4 * q), arb4 = *(const f32x4*)(AMrb + row16 * 16 + 4 * q), ark4 = *(const f32x4*)(AMrk + row16 * 16 + 4 * q);
    const bf16x8 arbB = pk8z(arb4);
#pragma unroll
    for (int nt = 0; nt < 4; ++nt) {
        const bf16x8 gfB = mk8(*(const u32x2*)(GAT + krow(16 * nt + row16) * 16 + 4 * q), Z2);
        const f32x4 W1n = CK_MFMA(mfA, gfB, z4);
        const f32x4 W1T = CK_MFMA(gfB, mfA, z4);
        *(u32x2*)(W1row + row16 * 72 + 16 * nt + 4 * q) = pk4(W1T);
        f32x4 cin = unpk4(*(const u32x2*)(GR + row16 * 72 + 16 * nt + 4 * q));
        if (TYPE == 1) cin = cin * gc[16 + row16];
        const f32x4 R2T = CK_MFMA(pk8z(W1n), arbB, cin);
        *(u32x2*)(R2row + row16 * 72 + 16 * nt + 4 * q) = pk4(R2T);
    }
    const bf16x8 aakA = pk8z(aak4), arbk = mk8(pk4(arb4), pk4(ark4));
#pragma unroll
    for (int vt = 0; vt < 2; ++vt) {
        const u32x2 vtf = *(const u32x2*)(VT + krow(16 * vt + row16) * 16 + 4 * q);
        const f32x4 AV = CK_MFMA(aakA, mk8(vtf, Z2), z4);
        const f32x4 W2 = CK_MFMA(mplain, pk8z(AV), z4);
        const f32x4 Y3 = CK_MFMA(arbk, mk8(pk4(W2), vtf), z4);
        f32x4* C2 = (f32x4*)(wks + 4608 + vt * 2048);
        C2[lane] = W2; C2[64 + lane] = Y3;
    }
}
template <int TYPE>
__device__ __forceinline__ void seq_wave(const char* pc, const char* wks, float* sYc, int vt, int lane, f32x4 (&Sreg)[4]) {
    const int row16 = lane & 15, q = lane >> 4;
    const bf16_t* W1row = (const bf16_t*)wks; const bf16_t* R2row = (const bf16_t*)(wks + 2304); const f32x4* C2 = (const f32x4*)(wks + 4608 + vt * 2048);
    const bf16_t* GBT = (const bf16_t*)(pc + 11264); const bf16_t* GKT = (const bf16_t*)(pc + (TYPE == 0 ? 13312 : 11264)); const bf16_t* VST = (const bf16_t*)(pc + 16384);
    const float* gc = (const float*)(pc + 17408); const float* pC = (const float*)(pc + 17664);
    f32x4 U = C2[lane], Y = C2[64 + lane];
#pragma unroll
    for (int ks = 0; ks < 2; ++ks) {
        const bf16x8 sf = mk8(pk4(Sreg[2 * ks]), pk4(Sreg[2 * ks + 1]));
        const bf16x8 a1 = mk8(*(const u32x2*)(W1row + row16 * 72 + 32 * ks + 4 * q), *(const u32x2*)(W1row + row16 * 72 + 32 * ks + 16 + 4 * q));
        const bf16x8 a2 = mk8(*(const u32x2*)(R2row + row16 * 72 + 32 * ks + 4 * q), *(const u32x2*)(R2row + row16 * 72 + 32 * ks + 16 + 4 * q));
        U = CK_MFMA(a1, sf, U);
        Y = CK_MFMA(a2, sf, Y);
    }
#pragma unroll
    for (int r = 0; r < 4; ++r) sYc[(4 * q + r) * 32 + 16 * vt + row16] = Y[r];
    if (TYPE == 1) U = U * *(const f32x4*)(gc + 48 + 4 * q);
    const bf16x8 ub = mk8(pk4(U), *(const u32x2*)(VST + krow(16 * vt + row16) * 16 + 4 * q));
#pragma unroll
    for (int kt = 0; kt < 4; ++kt) {
        const bf16x8 ak = mk8(*(const u32x2*)(GBT + krow(16 * kt + row16) * 16 + 4 * q), *(const u32x2*)(GKT + krow(16 * kt + row16) * 16 + 4 * q));
        const f32x4 pc4 = *(const f32x4*)(pC + 16 * kt + 4 * q);
        if (TYPE == 0) Sreg[kt] = CK_MFMA(ak, ub, Sreg[kt]) * pc4;
        else Sreg[kt] = CK_MFMA(ak, ub, Sreg[kt] * pc4);
    }
}
template <int TYPE, class F>
__device__ __forceinline__ void seq_role(char* cb, int vt, int lane, F&& extra) {
    f32x4 Sreg[4];
#pragma unroll
    for (int i = 0; i < 4; ++i) Sreg[i] = (f32x4){0.f, 0.f, 0.f, 0.f};
    extra(0); lbar(); extra(1); lbar();
    for (int k = 0; k <= NCH; ++k) {
        if (k > 0) {
            const int kb = k - 1;
            seq_wave<TYPE>(cb + (kb & 1) * PCB_BYTES, cb + WKS0 + ((kb & 1) * 2 + 0) * WKS_BYTES, (float*)(cb + SY0 + (kb & 1) * 4096), vt, lane, Sreg);
            seq_wave<TYPE>(cb + (kb & 1) * PCB_BYTES + PC_STRIDE, cb + WKS0 + ((kb & 1) * 2 + 1) * WKS_BYTES, (float*)(cb + SY0 + (kb & 1) * 4096) + 16 * 32, vt, lane, Sreg);
        }
        lbar();
        extra(k + 2);
        lbar();
    }
}
template <int TYPE>
__device__ __forceinline__ void prep_role(char* cb, int c, int lane) {
    lbar(); lbar();
    for (int k = 0; k <= NCH; ++k) {
        if (k < NCH) prep_wave<TYPE, true>(cb + (k & 1) * PCB_BYTES + c * PC_STRIDE, cb + WKP0 + c * WKP_BYTES, cb + WKS0 + ((k & 1) * 2 + c) * WKS_BYTES, lane);
        else lbar();
        lbar();
    }
}
__device__ __forceinline__ float red8(float x) { x += dppf<0xB1>(x); x += dppf<0x4E>(x); x += dppf<0x141>(x); return x; }
__device__ __forceinline__ void st8T(bf16_t* base, int row0, int t, u32x4 v) {
    const int r = row0 >> 3;
    base[(row0 + 0 + ((0 + r) & 3)) * 16 + t] = (bf16_t)v.x; base[(row0 + 0 + ((1 + r) & 3)) * 16 + t] = (bf16_t)(v.x >> 16); base[(row0 + 0 + ((2 + r) & 3)) * 16 + t] = (bf16_t)v.y; base[(row0 + 0 + ((3 + r) & 3)) * 16 + t] = (bf16_t)(v.y >> 16);
    base[(row0 + 4 + ((0 + r) & 3)) * 16 + t] = (bf16_t)v.z; base[(row0 + 4 + ((1 + r) & 3)) * 16 + t] = (bf16_t)(v.z >> 16); base[(row0 + 4 + ((2 + r) & 3)) * 16 + t] = (bf16_t)v.w; base[(row0 + 4 + ((3 + r) & 3)) * 16 + t] = (bf16_t)(v.w >> 16);
}
__device__ __forceinline__ u32x4 pk8(const f32x4& a, const f32x4& b) { u32x4 r; r.x = pk2(a[0], a[1]); r.y = pk2(a[2], a[3]); r.z = pk2(b[0], b[1]); r.w = pk2(b[2], b[3]); return r; }
__device__ __forceinline__ void unpk8(u32x4 v, f32x4& a, f32x4& b) { a = (f32x4){bflo(v.x), bfhi(v.x), bflo(v.y), bfhi(v.y)}; b = (f32x4){bflo(v.z), bfhi(v.z), bflo(v.w), bfhi(v.w)}; }
}

__device__ __forceinline__ void rwkv_job(const PP& p, int l, int job, float* sm) {
    char* cb = (char*)sm;
    float* sW = (float*)(cb + ck::SW0); float* sAA = (float*)(cb + ck::SAA0); float* cst = (float*)(cb + ck::CST0);
    const int half = job & 1, dir = (job >> 1) & 1, bh = job >> 2, b = bh / 6, h = bh - b * 6;
    const int tid = tid_of(p.wv), w = tid >> 6, lane = tid & 63;
    const bf16_t* Z = (const bf16_t*)(p.ws + OFF_Z); const bf16_t* RWP = (const bf16_t*)(p.ws + OFF_H);
    bf16_t* Y = (bf16_t*)(p.ws + OFF_YO) + (size_t)dir * MROWS * 384;
    float* BC = (float*)(p.ws + OFF_BC) + (size_t)dir * MROWS * 6;
    if (tid < 64) { cst[tid] = p.in[I_KK][l * 384 + h * 64 + tid]; cst[64 + tid] = p.in[I_KA][l * 384 + h * 64 + tid]; cst[128 + tid] = p.in[I_RK][l * 384 + h * 64 + tid];
        cst[192 + tid] = p.in[I_MU][l * 1408 + 768 + h * 64 + tid];
        cst[256 + tid] = p.in[I_W0][((size_t)l * 2 + dir) * 384 + h * 64 + tid]; cst[320 + tid] = p.in[I_A0][((size_t)l * 2 + dir) * 384 + h * 64 + tid]; }
    lbar();
    if (w < 2) ck::prep_role<0>(cb, w, lane);
    else if (w == 4 || w == 5) {
        const int mt = w - 4, fr = lane & 15, fq = lane >> 4;
        bf16x8 wfw[4][2], wfa[4][2];
#pragma unroll
        for (int nt = 0; nt < 4; ++nt) {
            const bf16_t* wu = (const bf16_t*)(p.ws + OFF_WUP) + ((size_t)dir * 384 + h * 64 + nt * 16 + fr) * 64 + fq * 8;
            const bf16_t* au = (const bf16_t*)(p.ws + OFF_AUP) + ((size_t)dir * 384 + h * 64 + nt * 16 + fr) * 64 + fq * 8;
            wfw[nt][0] = *(const bf16x8*)wu; wfw[nt][1] = *(const bf16x8*)(wu + 32); wfa[nt][0] = *(const bf16x8*)au; wfa[nt][1] = *(const bf16x8*)(au + 32);
        }
        bf16x8 xw[2], xa[2];
        auto loadm = [&](int blk) {
            if (blk < NCH) {
                const int jm = seqpos(dir, blk * 32 + mt * 16 + fr);
                const bf16_t* mp = RWP + (size_t)(b * TT + jm) * RWP_LD + 768 + fq * 8;
                xw[0] = *(const bf16x8*)mp; xw[1] = *(const bf16x8*)(mp + 32); xa[0] = *(const bf16x8*)(mp + 64); xa[1] = *(const bf16x8*)(mp + 96);
            }
        };
        loadm(0);
        auto lora = [&](int blk) {
            if (blk >= NCH) return;
            float* sWb = sW + (blk & 1) * 2048; float* sAb = sAA + (blk & 1) * 2048;
#pragma unroll
            for (int nt = 0; nt < 4; ++nt) {
                f32x4 aw = (f32x4){0.f, 0.f, 0.f, 0.f}, aa = aw;
#pragma unroll
                for (int ks = 0; ks < 2; ++ks) { aw = CK_MFMA(xw[ks], wfw[nt][ks], aw); aa = CK_MFMA(xa[ks], wfa[nt][ks], aa); }
                const float w0s = cst[256 + nt * 16 + fr], a0s = cst[320 + nt * 16 + fr];
                f32x4 G = (f32x4){0.f, 0.f, 0.f, 0.f};
#pragma unroll
                for (int i = 0; i < 4; ++i) {
                    const float lw = -0.6065306597126334f * sigmoidf_(aw[i] + w0s);
                    G = __builtin_amdgcn_mfma_f32_16x16x4f32((4 * fq + i <= fr) ? 1.f : 0.f, lw, G, 0, 0, 0);
                }
#pragma unroll
                for (int i = 0; i < 4; ++i) {
                    sWb[(mt * 16 + 4 * fq + i) * 64 + nt * 16 + fr] = G[i];
                    sAb[(mt * 16 + 4 * fq + i) * 64 + nt * 16 + fr] = sigmoidf_(aa[i] + a0s);
                }
            }
            loadm(blk + 1);
        };
        ck::seq_role<0>(cb, w - 4, lane, lora);
    }

    else {
        const int ew = (w & 1) + ((w >> 2) << 1);
        const int stid = ew * 64 + lane, es = stid >> 3, c8 = stid & 7, ec = h * 64 + 8 * c8, c = es >> 4, t = es & 15;
        struct PF { u32x4 r, k, vp, vc, vn; int row; };
        PF setA, setB;
        const float* sW_ = sW; const float* sAA_ = sAA;
        auto prefetch = [&](PF& s, int blk) {
            if (blk < NCH) {
                const int j = seqpos(dir, blk * 32 + es);
                const bool hp = (j != 0) && (j != CTX), hn = (j != CTX - 1) && (j != TT - 1);
                s.row = b * TT + j;
                const bf16_t* rp = RWP + (size_t)s.row * RWP_LD;
                s.r = *(const u32x4*)(rp + ec); s.k = *(const u32x4*)(rp + 384 + ec);
                const bf16_t* zp = Z + (size_t)s.row * ZLD + 768 + ec;
                s.vc = *(const u32x4*)zp; s.vp = hp ? *(const u32x4*)(zp - ZLD) : (u32x4){0u, 0u, 0u, 0u}; s.vn = hn ? *(const u32x4*)(zp + ZLD) : (u32x4){0u, 0u, 0u, 0u};
            }
        };
        auto flush = [&](int blk) {
            const float* sYb = (const float*)(cb + ck::SY0 + (blk & 1) * 4096);
            const int s = stid >> 3, v4 = (stid & 7) * 4, j = seqpos(dir, blk * 32 + s);
            *(u32x2*)(Y + (size_t)(b * TT + j) * 384 + h * 64 + half * 32 + v4) = pk4(*(const f32x4*)(sYb + s * 32 + v4));
        };
        auto stage = [&](int blk, PF& ps) {
            f32x4 r0, r1, k0, k1, v0, v1;
            ck::unpk8(ps.r, r0, r1); ck::unpk8(ps.k, k0, k1);
            {
                f32x4 a0, a1, c0, c1, n0, n1; ck::unpk8(ps.vp, a0, a1); ck::unpk8(ps.vc, c0, c1); ck::unpk8(ps.vn, n0, n1);
                const f32x4 m0 = *(const f32x4*)(cst + 192 + 8 * c8), m1 = *(const f32x4*)(cst + 196 + 8 * c8);
                v0 = c0 + ((a0 + n0) * 0.5f - c0) * m0; v1 = c1 + ((a1 + n1) * 0.5f - c1) * m1;
            }
            const int myrow = ps.row;
            u32x4 ga, gr, gb, gk, vb; f32x4 x0, x1; float bon;
            auto comp = [&]() {
                const float* sW = sW_ + (blk & 1) * 2048; const float* sAA = sAA_ + (blk & 1) * 2048;
                const f32x4 a40 = *(const f32x4*)(sAA + es * 64 + 8 * c8), a41 = *(const f32x4*)(sAA + es * 64 + 8 * c8 + 4);
                const f32x4 kd0 = k0 * ((a40 - 1.f) * *(const f32x4*)(cst + 64 + 8 * c8) + 1.f), kd1 = k1 * ((a41 - 1.f) * *(const f32x4*)(cst + 68 + 8 * c8) + 1.f);
                const f32x4 kk0 = k0 * *(const f32x4*)(cst + 8 * c8), kk1 = k1 * *(const f32x4*)(cst + 4 + 8 * c8);
                const float ssq = ck::red8(kk0[0] * kk0[0] + kk0[1] * kk0[1] + kk0[2] * kk0[2] + kk0[3] * kk0[3] + kk1[0] * kk1[0] + kk1[1] * kk1[1] + kk1[2] * kk1[2] + kk1[3] * kk1[3]);
                const float rn = __builtin_amdgcn_rsqf(ssq + 1e-6f);
                const f32x4 kn0 = kk0 * rn, kn1 = kk1 * rn;
                const f32x4 tb0 = r0 * kd0 * *(const f32x4*)(cst + 128 + 8 * c8), tb1 = r1 * kd1 * *(const f32x4*)(cst + 132 + 8 * c8);
                bon = ck::red8(tb0[0] + tb0[1] + tb0[2] + tb0[3] + tb1[0] + tb1[1] + tb1[2] + tb1[3]);
                const f32x4 G0 = *(const f32x4*)(sW + es * 64 + 8 * c8), G1 = *(const f32x4*)(sW + es * 64 + 8 * c8 + 4);
                const f32x4 T0 = *(const f32x4*)(sW + (16 * c + 15) * 64 + 8 * c8), T1 = *(const f32x4*)(sW + (16 * c + 15) * 64 + 8 * c8 + 4);
                f32x4 L0 = (f32x4){0.f, 0.f, 0.f, 0.f}, L1 = L0;
                if (t > 0) { L0 = *(const f32x4*)(sW + (es - 1) * 64 + 8 * c8); L1 = *(const f32x4*)(sW + (es - 1) * 64 + 8 * c8 + 4); }
                f32x4 P0, P1, Q0, Q1, I0, I1;
#pragma unroll
                for (int e = 0; e < 4; ++e) { P0[e] = __expf(G0[e]); P1[e] = __expf(G1[e]); Q0[e] = __expf(L0[e]); Q1[e] = __expf(L1[e]); I0[e] = __expf(-G0[e]); I1[e] = __expf(-G1[e]); x0[e] = __expf(T0[e]); x1[e] = __expf(T1[e]); }
                ga = ck::pk8(-kn0 * Q0, -kn1 * Q1); gb = ck::pk8(kn0 * a40 * I0, kn1 * a41 * I1); gk = ck::pk8(kd0 * I0, kd1 * I1); gr = ck::pk8(r0 * P0, r1 * P1);
                vb = ck::pk8(v0, v1);
            };
            if (blk > 0) comp();
            lbar();
            if (blk == 0) comp();
            prefetch(ps, blk + 2);
            if (blk > 1) flush(blk - 2);
            char* pc = cb + (blk & 1) * ck::PCB_BYTES + c * ck::PC_STRIDE;
            if (c8 == 0 && half == 0) BC[(size_t)myrow * 6 + h] = bon;
            *(u32x4*)(pc + (t * 72 + 8 * c8) * 2) = ga;
            *(u32x4*)(pc + 2304 + (t * 72 + 8 * c8) * 2) = gr;
            *(u32x4*)(pc + 4608 + (t * 72 + 8 * c8) * 2) = gb;
            *(u32x4*)(pc + 6912 + (t * 72 + 8 * c8) * 2) = gk;
            ck::st8T((bf16_t*)(pc + 9216), 8 * c8, t, ga); ck::st8T((bf16_t*)(pc + 11264), 8 * c8, t, gb); ck::st8T((bf16_t*)(pc + 13312), 8 * c8, t, gk);
            if (t == 15) { *(f32x4*)(pc + 17664 + 32 * c8) = x0; *(f32x4*)(pc + 17664 + 32 * c8 + 16) = x1; }
            if ((c8 >> 2) == half) { ck::st8T((bf16_t*)(pc + 15360), 8 * c8 - 32 * half, t, vb); ck::st8T((bf16_t*)(pc + 16384), 8 * c8 - 32 * half, t, vb); }
            lbar();
        };
        prefetch(setA, 0); prefetch(setB, 1);
        stage(0, setA);
        for (int k = 0; k < NCH; k += 2) {
            if (k + 1 < NCH) stage(k + 1, setB); else { lbar(); lbar(); }
            if (k + 2 < NCH) stage(k + 2, setA); else { lbar(); lbar(); }
        }
        lbar(); lbar();
        flush(NCH - 2); flush(NCH - 1);
    }
}

__device__ __forceinline__ void gdn_job(const PP& p, int l, int job, float* sm) {
    char* cb = (char*)sm;
    float* sSC = (float*)(cb + ck::SW0);
    float* cst = (float*)(cb + ck::CST0);
    const int half = job & 1, dir = (job >> 1) & 1, bh = job >> 2, b = bh / 6, h = bh - b * 6;
    const int tid = tid_of(p.wv), w = tid >> 6, lane = tid & 63;
    const bf16_t* Z = (const bf16_t*)(p.ws + OFF_Z);
    bf16_t* Y = (bf16_t*)(p.ws + OFF_YO) + (size_t)(2 + dir) * MROWS * 384;
    for (int i = tid; i < 576; i += 512) { const int a = i >> 6, cc = i & 63; cst[i] = p.in[I_CONV][(size_t)l * 3 * 1152 + (a / 3) * 1152 + (a % 3) * 384 + h * 64 + cc]; }
    lbar();
    if (w < 2) ck::prep_role<1>(cb, w, lane);
    else if (w == 4 || w == 5) ck::seq_role<1>(cb, w - 4, lane, [](int) {});
    else {
        const int ew = (w & 1) + ((w >> 2) << 1);
        const int stid = ew * 64 + lane, es = stid >> 3, c8 = stid & 7, ec = h * 64 + 8 * c8, c = es >> 4, t = es & 15;
        const float aexp = __expf(p.in[I_ALOG][((size_t)l * 2 + dir) * 6 + h]), dtb = p.in[I_DTB][((size_t)l * 2 + dir) * 6 + h];
        struct PF { u32x4 x[3][3]; bf16_t be, ai; };
        PF setA, setB;
        auto prefetch = [&](PF& s, int blk) {
            if (blk < NCH) {
                const int j = seqpos(dir, blk * 32 + es);
                const bool hp = (j != 0) && (j != CTX), hn = (j != CTX - 1) && (j != TT - 1);
                const bf16_t* zp = Z + (size_t)(b * TT + j) * ZLD + 1408 + ec;
#pragma unroll
                for (int a = 0; a < 3; ++a) {
                    s.x[a][1] = *(const u32x4*)(zp + a * 384);
                    s.x[a][0] = hp ? *(const u32x4*)(zp + a * 384 - ZLD) : (u32x4){0u, 0u, 0u, 0u};
                    s.x[a][2] = hn ? *(const u32x4*)(zp + a * 384 + ZLD) : (u32x4){0u, 0u, 0u, 0u};
                }
                s.be = zp[1152 - ec + dir * 6 + h]; s.ai = zp[1164 - ec + dir * 6 + h];
            }
        };
        auto flush = [&](int blk) {
            const float* sYb = (const float*)(cb + ck::SY0 + (blk & 1) * 4096);
            const int s = stid >> 3, v4 = (stid & 7) * 4, j = seqpos(dir, blk * 32 + s);
            *(u32x2*)(Y + (size_t)(b * TT + j) * 384 + h * 64 + half * 32 + v4) = pk4(*(const f32x4*)(sYb + s * 32 + v4));
        };
        auto stage = [&](int blk, PF& ps) {
            f32x4 o[3][2];
#pragma unroll
            for (int a = 0; a < 3; ++a) {
                f32x4 p0, p1, c0, c1, n0, n1; ck::unpk8(ps.x[a][0], p0, p1); ck::unpk8(ps.x[a][1], c0, c1); ck::unpk8(ps.x[a][2], n0, n1);
                o[a][0] = p0 * *(const f32x4*)(cst + (0 * 3 + a) * 64 + 8 * c8) + c0 * *(const f32x4*)(cst + (1 * 3 + a) * 64 + 8 * c8) + n0 * *(const f32x4*)(cst + (2 * 3 + a) * 64 + 8 * c8);
                o[a][1] = p1 * *(const f32x4*)(cst + (0 * 3 + a) * 64 + 8 * c8 + 4) + c1 * *(const f32x4*)(cst + (1 * 3 + a) * 64 + 8 * c8 + 4) + n1 * *(const f32x4*)(cst + (2 * 3 + a) * 64 + 8 * c8 + 4);
#pragma unroll
                for (int e = 0; e < 4; ++e) { o[a][0][e] = siluf_(o[a][0][e]); o[a][1][e] = siluf_(o[a][1][e]); }
            }
            float sq = 0.f, sk = 0.f;
#pragma unroll
            for (int e = 0; e < 4; ++e) { sq += o[0][0][e] * o[0][0][e] + o[0][1][e] * o[0][1][e]; sk += o[1][0][e] * o[1][0][e] + o[1][1][e] * o[1][1][e]; }
            sq = ck::red8(sq); sk = ck::red8(sk);
            const float qn = __builtin_amdgcn_rsqf(sq + 1e-6f) * 0.125f, kn = __builtin_amdgcn_rsqf(sk + 1e-6f);
            const f32x4 q0 = o[0][0] * qn, q1 = o[0][1] * qn, k0 = o[1][0] * kn, k1 = o[1][1] * kn;
            const float beta = sigmoidf_(bf2f(ps.be));
            const float xg = bf2f(ps.ai) + dtb; const float gl = -aexp * (xg > 20.f ? xg : __logf(1.f + __expf(xg)));
            if (c8 == 0) { sSC[es * 4] = beta; sSC[es * 4 + 1] = gl; }
            lbar();
            prefetch(ps, blk + 2);
            if (blk > 1) flush(blk - 2);
            char* pc = cb + (blk & 1) * ck::PCB_BYTES + c * ck::PC_STRIDE;
            float g = 0.f, gm1 = 0.f, gt = 0.f;
#pragma unroll
            for (int i = 0; i < 16; ++i) { const float lg = sSC[(16 * c + i) * 4 + 1]; gt += lg; if (i <= t) g += lg; if (i < t) gm1 += lg; }
            const float ac = -__expf(gl) * beta;
            const u32x4 ga = ck::pk8(k0 * ac, k1 * ac), kb = ck::pk8(k0, k1);
            *(u32x4*)(pc + (t * 72 + 8 * c8) * 2) = ga;
            *(u32x4*)(pc + 2304 + (t * 72 + 8 * c8) * 2) = ck::pk8(q0, q1);
            *(u32x4*)(pc + 4608 + (t * 72 + 8 * c8) * 2) = kb;
            ck::st8T((bf16_t*)(pc + 9216), 8 * c8, t, ga); ck::st8T((bf16_t*)(pc + 11264), 8 * c8, t, kb);
            const float us = __expf(gt - g);
            if (t == 15) { const float pv = __expf(gt); const f32x4 pv4 = (f32x4){pv, pv, pv, pv}; *(f32x4*)(pc + 17664 + 32 * c8) = pv4; *(f32x4*)(pc + 17664 + 32 * c8 + 16) = pv4; }
            if (c8 == 0) { float* sc4 = (float*)(pc + 17408); sc4[t] = g; sc4[16 + t] = __expf(g); sc4[32 + t] = __expf(gm1); sc4[48 + t] = us; }
            if ((c8 >> 2) == half) {
                const f32x4 v0 = o[2][0] * beta, v1 = o[2][1] * beta;
                ck::st8T((bf16_t*)(pc + 15360), 8 * c8 - 32 * half, t, ck::pk8(v0, v1)); ck::st8T((bf16_t*)(pc + 16384), 8 * c8 - 32 * half, t, ck::pk8(v0 * us, v1 * us));
            }
            lbar();
        };
        prefetch(setA, 0); prefetch(setB, 1);
        stage(0, setA);
        for (int k = 0; k < NCH; k += 2) {
            if (k + 1 < NCH) stage(k + 1, setB); else { lbar(); lbar(); }
            if (k + 2 < NCH) stage(k + 2, setA); else { lbar(); lbar(); }
        }
        lbar(); lbar();
        flush(NCH - 2); flush(NCH - 1);
    }
}

__device__ __forceinline__ void s5_job(const PP& p, int it, LAS uchar* lds) {
    const int g = it >> 1, dir = it & 1, tid = tid_of(p.wv), w = tid >> 6, q = tid & 63;
    bf16_t* A2 = (bf16_t*)(p.ws + OFF_A2) + (size_t)it * GROWS * 640;
    if (w < 4) {
        const float* HL = (const float*)(p.ws + OFF_HL) + (size_t)g * GROWS * 256 + dir * 128 + 2 * q;
        const float* DP = (const float*)(p.ws + OFF_DP) + (it * 64 + q) * 2;
        const float dr = DP[0], di = DP[1]; float hr = 0.f, hi = 0.f;
        for (int i0 = 0; i0 < NCH; i0 += 8) {
            f32x2 hl[8]; int Rr[8];
#pragma unroll
            for (int e = 0; e < 8; ++e) { const int i = i0 + e; const int c = dir == 0 ? i : (i < 8 ? 7 - i : NCH - 1 - (i - 8)); Rr[e] = w * NCH + c; hl[e] = *(const f32x2*)(HL + (size_t)Rr[e] * 256); }
#pragma unroll
            for (int e = 0; e < 8; ++e) {
                *(unsigned*)(A2 + (size_t)Rr[e] * 640 + 512 + 2 * q) = pk2(hr, hi);
                const float nr = dr * hr - di * hi + hl[e].x, ni = dr * hi + di * hr + hl[e].y; hr = nr; hi = ni;
            }
        }
    }
    __builtin_amdgcn_fence(__ATOMIC_RELEASE, "agent");
    asm volatile("s_waitcnt vmcnt(0)" ::: "memory");
    __syncthreads();
    __builtin_amdgcn_fence(__ATOMIC_ACQUIRE, "agent");
    asm volatile("s_waitcnt vmcnt(0)" ::: "memory");
    __syncthreads();
    pg8::Gemm gm; gm.A = (const bf16_t*)(p.ws + OFF_A2); gm.Bt = (const bf16_t*)(p.ws + OFF_TF); gm.K = 640; gm.lda = 640; gm.ldb = 640;
    pg8::Sched S; S.mode = 1; S.nM = 5; S.nN = 2; S.nwg = (it + 1) * 10; S.G = 1; S.c = it * 10;
    S.gA = (size_t)GROWS * 640 * 2; S.gB = (size_t)512 * 640 * 2; S.tA = (size_t)256 * 640 * 2; S.tB = (size_t)256 * 640 * 2;
    EpiY5 E; E.Y5 = (bf16_t*)(p.ws + OFF_Y5);
    pg8::gemm_phase(lds, gm, S, E, p.wv);
}


constexpr int GRW_SPLIT = 27000;
__device__ __forceinline__ bf16_t* grw_row(char* ws, int row) {
    return row < GRW_SPLIT ? (bf16_t*)(ws + OFF_TF) + (size_t)row * 384 : (bf16_t*)(ws + OFF_HL) + (size_t)(row - GRW_SPLIT) * 384;
}
__device__ __forceinline__ void phase_gaterw(const PP& p, int l, int gw, int nw) {
    int lane = lane_id(); asm volatile("" : "+v"(lane));
    const int fr = lane & 15, fq = lane >> 4;
    const bf16_t* Z = (const bf16_t*)(p.ws + OFF_Z); const bf16_t* GUP = (const bf16_t*)(p.ws + OFF_GUP);
    const float* mu = p.in[I_MU] + l * 1408;
    for (int item = gw; item < MROWS / 16; item += nw) {
        const int row = item * 16 + fr, b = row / TT, j = row - b * TT;
        const bool hp = (j != 0) && (j != CTX), hn = (j != CTX - 1) && (j != TT - 1);
        bf16x8 gfrag[4];
#pragma unroll
        for (int ks = 0; ks < 4; ++ks) {
            const int c0 = 1280 + ks * 32 + fq * 8;
            const Nb3 a = ld3(Z, row, hp, hn, c0), bq = ld3(Z, row, hp, hn, c0 + 4);
            f32x4 x0 = shiftmix(a, mu + c0), x1 = shiftmix(bq, mu + c0 + 4);
#pragma unroll
            for (int i = 0; i < 4; ++i) { x0[i] = sigmoidf_(x0[i]); x1[i] = sigmoidf_(x1[i]); }
            const u32x2 lo = pk4(x0), hi2 = pk4(x1); u32x4 t; t.x = lo.x; t.y = lo.y; t.z = hi2.x; t.w = hi2.y; gfrag[ks] = __builtin_bit_cast(bf16x8, t);
        }
        bf16_t* gr = grw_row(p.ws, row);
#pragma unroll 4
        for (int n24 = 0; n24 < 24; ++n24) {
            f32x4 ga = (f32x4){0.f, 0.f, 0.f, 0.f};
            const bf16_t* wp = GUP + (size_t)(n24 * 16 + fr) * 128 + fq * 8;
#pragma unroll
            for (int ks = 0; ks < 4; ++ks) ga = __builtin_amdgcn_mfma_f32_16x16x32_bf16(*(const bf16x8*)(wp + ks * 32), gfrag[ks], ga, 0, 0, 0);
            *(u32x2*)(gr + n24 * 16 + fq * 4) = pk4(ga);
        }
    }
}
__device__ __forceinline__ void phase_s5post(const PP& p, int l, int gw, int nw) {
    int lane = lane_id(); asm volatile("" : "+v"(lane));
    const int fr = lane & 15, fq = lane >> 4;
    const bf16_t* A2 = (const bf16_t*)(p.ws + OFF_A2); const bf16_t* Y5 = (const bf16_t*)(p.ws + OFF_Y5); bf16_t* Y5w = (bf16_t*)(p.ws + OFF_Y5);
    const bf16_t* GLU = (const bf16_t*)(p.ws + OFF_GLU);
    for (int item = gw; item < MROWS / 16; item += nw) {
        const int row = item * 16 + fr, b = row / TT, j = row - b * TT;
        {
            const int n = s5pos(j), R = b * NCH + (n >> 5), t = n & 31;
            const size_t GS5 = (size_t)GROWS * 512;
            bf16x8 yf[8];
#pragma unroll
            for (int ks = 0; ks < 8; ++ks) {
                const int ch = ks * 32 + fq * 8, g = ch >> 4, hh = ch & 15;
                const u32x4 y0 = *(const u32x4*)(Y5 + (size_t)(g * 2) * GS5 + (size_t)R * 512 + t * 16 + hh), y1 = *(const u32x4*)(Y5 + (size_t)(g * 2 + 1) * GS5 + (size_t)R * 512 + t * 16 + hh);
                const u32x4 uu = *(const u32x4*)(A2 + ((size_t)(g * 2) * GROWS + R) * 640 + t * 16 + hh);
                const float* dv = p.in[I_S5D] + l * 256 + ch;
                float v[8];
#pragma unroll
                for (int e = 0; e < 4; ++e) {
                    v[2 * e] = gelu_tanh(bflo(y0[e]) + bflo(y1[e]) + dv[2 * e] * bflo(uu[e]));
                    v[2 * e + 1] = gelu_tanh(bfhi(y0[e]) + bfhi(y1[e]) + dv[2 * e + 1] * bfhi(uu[e]));
                }
                u32x4 tq; tq.x = pk2(v[0], v[1]); tq.y = pk2(v[2], v[3]); tq.z = pk2(v[4], v[5]); tq.w = pk2(v[6], v[7]); yf[ks] = __builtin_bit_cast(bf16x8, tq);
                asm volatile("" ::: "memory");
            }
#pragma unroll 1
            for (int nt = 0; nt < 16; ++nt) {
                f32x4 a = (f32x4){0.f, 0.f, 0.f, 0.f};
                const bf16_t* wp = GLU + (size_t)(nt * 16 + fr) * 256 + fq * 8;
#pragma unroll
                for (int ks = 0; ks < 8; ++ks) a = __builtin_amdgcn_mfma_f32_16x16x32_bf16(*(const bf16x8*)(wp + ks * 32), yf[ks], a, 0, 0, 0);
                const int ch = nt * 16 + fq * 4, hh = ch & 15;
                const u32x2 y0 = *(const u32x2*)(Y5 + (size_t)(nt * 2) * GS5 + (size_t)R * 512 + t * 16 + hh), y1 = *(const u32x2*)(Y5 + (size_t)(nt * 2 + 1) * GS5 + (size_t)R * 512 + t * 16 + hh);
                const u32x2 uu = *(const u32x2*)(A2 + ((size_t)(nt * 2) * GROWS + R) * 640 + t * 16 + hh);
                const f32x4 dv = *(const f32x4*)(p.in[I_S5D] + l * 256 + ch), gb = *(const f32x4*)(p.in[I_GLUB] + l * 256 + ch);
                const f32x4 ys = unpk4(y0) + unpk4(y1) + dv * unpk4(uu);
                f32x4 o;
#pragma unroll
                for (int i = 0; i < 4; ++i) { const float yy = gelu_tanh(ys[i]); o[i] = yy * sigmoidf_(a[i] + gb[i]); }
                *(u32x2*)(Y5w + (size_t)(nt * 2) * GS5 + (size_t)R * 512 + t * 16 + hh) = pk4(o);
                asm volatile("" ::: "memory");
            }
        }
    }
}

__device__ __forceinline__ void phase_post(const PP& p, int l) {
    const int lane = tid_of(p.wv) & 63, gw = bidx() * 8 + (tid_of(p.wv) >> 6), nw = gridDim.x * 8, tk = lane >> 4, c4 = lane & 15;
    const bf16_t* Z = (const bf16_t*)(p.ws + OFF_Z);
    const bf16_t* YO = (const bf16_t*)(p.ws + OFF_YO);
    const float* BC = (const float*)(p.ws + OFF_BC);
    const bf16_t* Y5 = (const bf16_t*)(p.ws + OFF_Y5);
    bf16_t* MIX = (bf16_t*)(p.ws + OFF_H);
    const float* mu = p.in[I_MU] + l * 1408;
    const size_t YS = (size_t)MROWS * 384;
    for (int it3 = gw; it3 < 2 * (MROWS / 16); it3 += nw) {
      const int item = it3 >> 1, part = 1 + (((it3 / nw) + it3) & 1);
      if (part == 1) {
#pragma unroll 1
        for (int tg = 0; tg < 4; ++tg) {
            const int row = item * 16 + tg * 4 + tk, b = row / TT, j = row - b * TT;
            const bool hp = (j != 0) && (j != CTX), hn = (j != CTX - 1) && (j != TT - 1);
            const bf16_t* gr = grw_row(p.ws, row);
#pragma unroll 2
            for (int h = 0; h < 6; ++h) {
                const int c = h * 64 + 4 * c4;
                f32x4 y = unpk4(*(const u32x2*)(YO + (size_t)row * 384 + c)) + unpk4(*(const u32x2*)(YO + YS + (size_t)row * 384 + c));
                const float mean = red16(y[0] + y[1] + y[2] + y[3]) * (1.f / 64.f);
                y = y - mean;
                const float rstd = __builtin_amdgcn_rsqf(red16(y[0] * y[0] + y[1] * y[1] + y[2] * y[2] + y[3] * y[3]) * (1.f / 64.f) + 64e-5f);
                const float bon = BC[(size_t)row * 6 + h] + BC[(size_t)MROWS * 6 + (size_t)row * 6 + h];
                const f32x4 lg = *(const f32x4*)(p.in[I_LNG] + l * 384 + c), lb = *(const f32x4*)(p.in[I_LNB] + l * 384 + c);
                const f32x4 vs = shiftmix(ld3(Z, row, hp, hn, 768 + c), mu + 768 + c);
                const f32x4 ga = unpk4(*(const u32x2*)(gr + c));
                *(u32x2*)(MIX + (size_t)row * DM + c) = pk4((y * rstd * lg + lb + vs * bon) * ga);
            }
        }
      } else {
#pragma unroll 1
        for (int tg = 0; tg < 4; ++tg) {
            const int row = item * 16 + tg * 4 + tk, b = row / TT, j = row - b * TT;
            const f32x4 gn = *(const f32x4*)(p.in[I_GNG] + l * 64 + 4 * c4);
#pragma unroll 3
            for (int h = 0; h < 6; ++h) {
                const int c = h * 64 + 4 * c4;
                const f32x4 o = unpk4(*(const u32x2*)(YO + 2 * YS + (size_t)row * 384 + c)) + unpk4(*(const u32x2*)(YO + 3 * YS + (size_t)row * 384 + c));
                const float rs = __builtin_amdgcn_rsqf(red16(o[0] * o[0] + o[1] * o[1] + o[2] * o[2] + o[3] * o[3]) * (1.f / 64.f) + 1e-6f);
                f32x4 gt = unpk4(*(const u32x2*)(Z + (size_t)row * ZLD + 2584 + c));
#pragma unroll
                for (int i = 0; i < 4; ++i) gt[i] = siluf_(gt[i]);
                *(u32x2*)(MIX + (size_t)row * DM + 384 + c) = pk4(o * rs * gn * gt);
            }
            const int n = s5pos(j), R = b * NCH + (n >> 5), t = n & 31;
            const size_t GS5 = (size_t)GROWS * 512;
#pragma unroll
            for (int e = 0; e < 4; ++e) {
                const int ch = e * 64 + 4 * c4, nt = ch >> 4, hh = ch & 15;
                *(u32x2*)(MIX + (size_t)row * DM + 768 + ch) = *(const u32x2*)(Y5 + (size_t)(nt * 2) * GS5 + (size_t)R * 512 + t * 16 + hh);
            }
        }
      }
    }
}

__global__ void __launch_bounds__(512) fwd_mega(P kp) {
    extern __shared__ __attribute__((aligned(16))) uchar shm[];
    cg::grid_group grid = cg::this_grid();
    float* sm = (float*)shm;
    LAS uchar* lds = (LAS uchar*)shm;
    const int nblk = gridDim.x;
    if (threadIdx.x == 0) {
        unsigned long long* tab = (unsigned long long*)(shm + TAB_OFF);
#pragma unroll
        for (int i = 0; i < N_IN; ++i) tab[i] = (unsigned long long)kp.in[i];
        tab[N_IN] = (unsigned long long)kp.out; tab[N_IN + 1] = (unsigned long long)kp.ws;
    }
    if (threadIdx.x == 0) { volatile LAS unsigned* st0 = (volatile LAS unsigned*)(lds + TAB_OFF + 384); st0[0] = 0u; st0[1] = 0u; st0[2] = 0u; st0[3] = 0u; }
    __syncthreads();
    const PP p = mkp(__builtin_amdgcn_readfirstlane((int)(threadIdx.x >> 6)));
    const XcdBarrier xb = xcd_barrier_post((unsigned*)(p.ws + OFF_BAR), (volatile LAS unsigned*)(lds + TAB_OFF + 384), p.wv);

    phase_mod(p, sm);
    __syncthreads();
    phase_s5coef(p, 0, sm);
    phase_convw(p, 0, sm, 0, nblk - n_coef_blocks(), 0);
    {
        float* cr = (float*)(p.ws + OFF_CTXR);
        for (size_t i = (size_t)bidx() * 512 + tid_of(p.wv); i < (size_t)NB * CTX * DM / 4; i += (size_t)nblk * 512) ((f32x4*)cr)[i] = ((const f32x4*)p.in[I_CTX])[i];
    }
    grid.sync();

    for (int l = 0; l < DEPTH; ++l) {
        const float* xsrc = l == 0 ? p.in[I_X] : p.out;
        float* ctxr = (float*)(p.ws + OFF_CTXR);
        const float* modl = (const float*)(p.ws + OFF_MOD) + (size_t)l * 5 * 6144;
        phase_norm(p, l, 0, xsrc, ctxr, 0);
        xcd_barrier(xb);
        {
            pg8::Gemm gm; gm.A = (const bf16_t*)(p.ws + OFF_H); gm.Bt = (const bf16_t*)(p.ws + OFF_WIN); gm.K = 1024; gm.lda = 1024; gm.ldb = 1024;
            EpiZ E; E.Z = (bf16_t*)(p.ws + OFF_Z); E.A2 = (bf16_t*)(p.ws + OFF_A2);
            pg8::gemm_phase(lds, gm, sched_static(MROWS, 3328, 1024, 1024), E, p.wv);
        }
        xcd_barrier(xb);
        {
            pg8::Gemm gm; gm.A = (const bf16_t*)(p.ws + OFF_A2); gm.Bt = (const bf16_t*)(p.ws + OFF_E2); gm.K = 512; gm.lda = 640; gm.ldb = 512;
            pg8::Sched S; S.mode = 1; S.nM = 5; S.nN = 1; S.nwg = 80; S.G = nblk; S.c = bidx();
            S.gA = (size_t)2 * GROWS * 640 * 2; S.gB = (size_t)256 * 512 * 2; S.tA = (size_t)256 * 640 * 2; S.tB = 0;
            EpiHL E; E.HL = (float*)(p.ws + OFF_HL);
            pg8::gemm_phase(lds, gm, S, E, p.wv);
        }
        phase_rwprep(p, l);
        xcd_barrier(xb);
        for (int job = bidx(); job < 224; job += nblk) {
            if (job < 96) rwkv_job(p, l, job, sm);
            else if (job < 192) gdn_job(p, l, job - 96, sm);
            else {
                s5_job(p, job - 192, lds);
                asm volatile("s_waitcnt vmcnt(0)" ::: "memory");
                __syncthreads();
                if (tid_of(p.wv) == 0) { __builtin_amdgcn_fence(__ATOMIC_RELEASE, "agent"); asm volatile("s_waitcnt vmcnt(0)" ::: "memory");
                    __hip_atomic_fetch_add((unsigned*)(p.ws + OFF_BAR) + 3600 + l, 1u, __ATOMIC_RELAXED, __HIP_MEMORY_SCOPE_AGENT); }
            }
            __syncthreads();
        }
        const bool s5_helpers = nblk >= 224;
        const int hb0 = s5_helpers ? 192 : 0;
        if (bidx() >= hb0) {
            const int tid = tid_of(p.wv);
            if (tid == 0) {
                while (__hip_atomic_load((unsigned*)(p.ws + OFF_BAR) + 3600 + l, __ATOMIC_RELAXED, __HIP_MEMORY_SCOPE_AGENT) < 32u) __builtin_amdgcn_s_sleep(8);
                __builtin_amdgcn_fence(__ATOMIC_ACQUIRE, "agent");
                asm volatile("s_waitcnt vmcnt(0)" ::: "memory");
            }
            __syncthreads();
            phase_s5post(p, l, (bidx() - hb0) * 8 + (tid >> 6), (nblk - hb0) * 8);
            phase_gaterw(p, l, (bidx() - hb0) * 8 + (tid >> 6), (nblk - hb0) * 8);
            __syncthreads();
            phase_convw(p, l, sm, hb0, nblk - hb0, 1);
        }
        xcd_barrier(xb);
        phase_post(p, l);
        xcd_barrier(xb);
        {
            pg8::Gemm gm; gm.A = (const bf16_t*)(p.ws + OFF_H); gm.Bt = (const bf16_t*)(p.ws + OFF_WOUT); gm.K = 1024; gm.lda = 1024; gm.ldb = 1024;
            EpiResid E; E.xin = xsrc; E.xout = p.out; E.cin = l == 0 ? p.in[I_CTX] : ctxr; E.cout = ctxr; E.mod = modl; E.gidx = 2;
            pg8::gemm_phase(lds, gm, sched_static(MROWS, 1024, 1024, 1024), E, p.wv);
        }
        xcd_barrier(xb);
        phase_norm(p, l, 1, p.out, ctxr, 0);
        xcd_barrier(xb);
        {
            pg8::Gemm gm; gm.A = (const bf16_t*)(p.ws + OFF_H); gm.Bt = (const bf16_t*)(p.ws + OFF_WGU); gm.K = 1024; gm.lda = 1024; gm.ldb = 1024;
            EpiSwiGLU E; E.HID = (bf16_t*)(p.ws + OFF_Z);
            pg8::gemm_phase(lds, gm, sched_static(MROWS, 5632, 1024, 1024), E, p.wv);
        }
        xcd_barrier(xb);
        {
            pg8::Gemm gm; gm.A = (const bf16_t*)(p.ws + OFF_Z); gm.Bt = (const bf16_t*)(p.ws + OFF_WDN); gm.K = FFN; gm.lda = FFN; gm.ldb = FFN;
            EpiResid E; E.xin = p.out; E.xout = p.out; E.cin = ctxr; E.cout = ctxr; E.mod = modl; E.gidx = 5;
            pg8::gemm_phase(lds, gm, sched_static(MROWS, 1024, FFN, FFN), E, p.wv);
        }
        if (l + 1 < DEPTH) {
            const int nx = (528 % nblk);
            __syncthreads();
            phase_s5coef(p, l + 1, sm);
            const int ncb = n_coef_blocks();
            const bool wide = nblk - nx - ncb >= 64;
            phase_convw(p, l + 1, sm, wide ? nx : 0, wide ? nblk - nx - ncb : nblk, 0);
        }
        xcd_barrier(xb);
    }
    phase_final(p);
}

extern "C" void kernel_launch(void* const* d_in, const int* in_sizes, int n_in, void* d_out, int out_size, void* d_ws, size_t ws_size, hipStream_t stream) {
    static int grid_blocks = 0;
    if (!grid_blocks) {
        int dev = 0, cus = 0, per_cu = 0;
        hipGetDevice(&dev);
        hipDeviceGetAttribute(&cus, hipDeviceAttributeMultiprocessorCount, dev);
        if (hipFuncSetAttribute((const void*)fwd_mega, hipFuncAttributeMaxDynamicSharedMemorySize, LDS_TOTAL) != hipSuccess) fprintf(stderr, "hipFuncSetAttribute failed\n");
        hipOccupancyMaxActiveBlocksPerMultiprocessor(&per_cu, (const void*)fwd_mega, 512, LDS_TOTAL);
        if (per_cu < 1) per_cu = 1;
        if (per_cu > 1) per_cu = 1;
        grid_blocks = cus * per_cu;
    }
    if (ws_size < WS_NEED) fprintf(stderr, "workspace too small: %zu < %zu\n", ws_size, (size_t)WS_NEED);
    P p{};
    for (int i = 0; i < N_IN; ++i) p.in[i] = (const float*)d_in[i];
    p.out = (float*)d_out; p.ws = (char*)d_ws;
    (void)hipMemsetAsync((char*)d_ws + OFF_BAR, 0, 16384, stream);
    void* args[] = {&p};
    hipError_t e = hipLaunchCooperativeKernel((void*)fwd_mega, dim3(grid_blocks), dim3(512), args, LDS_TOTAL, stream);
    if (e != hipSuccess) fprintf(stderr, "cooperative launch failed: %s (grid %d)\n", hipGetErrorString(e), grid_blocks);
}
```

```cpp
#include <hip/hip_runtime.h>
#include <hip/hip_cooperative_groups.h>
#include <cstdio>
namespace cg = cooperative_groups;

#define LAS __attribute__((address_space(3)))
typedef unsigned short bf16_t;
typedef unsigned char uchar;
typedef short bf16x8 __attribute__((ext_vector_type(8)));
typedef float f32x4 __attribute__((ext_vector_type(4)));
typedef float f32x2 __attribute__((ext_vector_type(2)));
typedef unsigned u32x4 __attribute__((ext_vector_type(4)));
typedef unsigned u32x2 __attribute__((ext_vector_type(2)));

constexpr int DM = 1024, NB = 4, SEQ = 8192, CTX = 256, TT = 8448, MROWS = 33792, DEPTH = 4;
constexpr int FFN = 2816, ZLD = 2968, NCH = 264  , GROWS = 1056  ;
constexpr int LDSB = 131072;
constexpr int LDS_TOTAL = 163840, TAB_OFF = 162816;

enum { I_X = 0, I_C, I_CTX, I_CCTX, I_N1G, I_N2G, I_FG, I_ADAW, I_ADAB, I_WIN, I_WOUT, I_MU, I_W0, I_WUP, I_A0, I_AUP, I_GUP, I_KK, I_KA, I_RK,
       I_LNG, I_LNB, I_CONV, I_ALOG, I_DTB, I_GNG, I_LRE, I_LIM, I_LDT, I_BRE, I_BIM, I_CRE, I_CIM, I_S5D, I_GLUW, I_GLUB, I_FG8, I_FU, I_FD, N_IN };

constexpr size_t OFF_WIN = 0;
constexpr size_t OFF_WOUT = OFF_WIN + 6815744;
constexpr size_t OFF_WGU = OFF_WOUT + 2097152;
constexpr size_t OFF_WDN = OFF_WGU + 11534336;
constexpr size_t OFF_WUP = OFF_WDN + 5767168;
constexpr size_t OFF_AUP = OFF_WUP + 98304;
constexpr size_t OFF_GUP = OFF_AUP + 98304;
constexpr size_t OFF_GLU = OFF_GUP + 98304;
constexpr size_t OFF_TF = OFF_GLU + 131072;
constexpr size_t OFF_E2 = OFF_TF + 20971520;
constexpr size_t OFF_DP = OFF_E2 + 4194304;
constexpr size_t OFF_MOD = OFF_DP + 16384;
constexpr size_t OFF_CTXR = OFF_MOD + 491520;
constexpr size_t OFF_BC = OFF_CTXR + 4194304;
constexpr size_t OFF_H = OFF_BC + 1622016;
constexpr size_t OFF_Z = OFF_H + 69206016;
constexpr size_t OFF_YO = OFF_Z + 200589312;
constexpr size_t OFF_A2 = OFF_YO + 103809024;
constexpr size_t OFF_Y5 = OFF_A2 + 43581440;
constexpr size_t OFF_HL = OFF_Y5 + 34603008;
constexpr size_t OFF_BAR = OFF_HL + 17301504;
constexpr size_t WS_NEED = OFF_BAR + 16384;

struct P { const float* in[N_IN]; float* out; char* ws; };
__device__ __forceinline__ char* ldp(int i) {
    extern __shared__ __attribute__((aligned(16))) unsigned char shm_[];
    const unsigned long long v = ((const unsigned long long*)(shm_ + TAB_OFF))[i];
    const unsigned lo = __builtin_amdgcn_readfirstlane((unsigned)v), hi = __builtin_amdgcn_readfirstlane((unsigned)(v >> 32));
    return (char*)(__attribute__((address_space(1))) char*)(((unsigned long long)hi << 32) | lo);
}
struct PIn { __device__ __forceinline__ const float* operator[](int i) const { return (const float*)ldp(i); } };
struct PP { PIn in; float* out; char* ws; int wv; };
__device__ __forceinline__ PP mkp(int wv) { PP q; q.out = (float*)ldp(N_IN); q.ws = ldp(N_IN + 1); q.wv = wv; return q; }

__device__ __forceinline__ int lane_id() { return (int)__builtin_amdgcn_mbcnt_hi(~0u, __builtin_amdgcn_mbcnt_lo(~0u, 0u)); }
__device__ __forceinline__ int tid_of(int wv) { int t = wv * 64 + lane_id(); asm volatile("" : "+v"(t)); return t; }
__device__ __forceinline__ int bidx() { int t = blockIdx.x; asm volatile("" : "+s"(t)); return t; }
__device__ __forceinline__ bf16_t f2bf(float f) { unsigned u = __float_as_uint(f); u += 0x7FFFu + ((u >> 16) & 1u); return (bf16_t)(u >> 16); }
typedef __bf16 bf16v2_t __attribute__((ext_vector_type(2)));
__device__ __forceinline__ unsigned pk2(float lo, float hi) { f32x2 f; f.x = lo; f.y = hi; return __builtin_bit_cast(unsigned, __builtin_convertvector(f, bf16v2_t)); }
__device__ __forceinline__ float bflo(unsigned u) { return __uint_as_float(u << 16); }
__device__ __forceinline__ float bfhi(unsigned u) { return __uint_as_float(u & 0xFFFF0000u); }
__device__ __forceinline__ float bf2f(bf16_t b) { return __uint_as_float(((unsigned)b) << 16); }
__device__ __forceinline__ f32x4 unpk4(u32x2 v) { return (f32x4){bflo(v.x), bfhi(v.x), bflo(v.y), bfhi(v.y)}; }
__device__ __forceinline__ u32x2 pk4(f32x4 v) { u32x2 r; r.x = pk2(v[0], v[1]); r.y = pk2(v[2], v[3]); return r; }
__device__ __forceinline__ float rcpf_(float x) { return __builtin_amdgcn_rcpf(x); }
__device__ __forceinline__ float sigmoidf_(float x) { return rcpf_(1.f + __expf(-x)); }
__device__ __forceinline__ float siluf_(float x) { return x * rcpf_(1.f + __expf(-x)); }
__device__ __forceinline__ float softplusf_(float x) { return x > 20.f ? x : log1pf(__expf(x)); }
__device__ __forceinline__ float gelu_tanh(float x) { const float u = 1.5957691216057308f * (x + 0.044715f * x * x * x); return x * rcpf_(1.f + __expf(-u)); }
__device__ __forceinline__ float tanhf_(float x) { return 1.f - 2.f * rcpf_(1.f + __expf(2.f * x)); }
template <int CTRL> __device__ __forceinline__ float dppf(float x) { return __builtin_bit_cast(float, __builtin_amdgcn_mov_dpp(__builtin_bit_cast(int, x), CTRL, 0xf, 0xf, true)); }
__device__ __forceinline__ float red16(float x) {
    x += dppf<0xB1>(x); x += dppf<0x4E>(x); x += dppf<0x141>(x); x += dppf<0x128>(x); return x;
}
__device__ __forceinline__ void red16x2(float& x, float& y) {
    x += dppf<0xB1>(x); y += dppf<0xB1>(y); x += dppf<0x4E>(x); y += dppf<0x4E>(y);
    x += dppf<0x141>(x); y += dppf<0x141>(y); x += dppf<0x128>(x); y += dppf<0x128>(y);
}
__device__ __forceinline__ float dot4(const f32x4& a, const f32x4& b) { return (a[0] * b[0] + a[2] * b[2]) + (a[1] * b[1] + a[3] * b[3]); }
__device__ __forceinline__ float red64(float x) {
#pragma unroll
    for (int o = 32; o > 0; o >>= 1) x += __shfl_xor(x, o);
    return x;
}
__device__ __forceinline__ void lbar() { asm volatile("s_waitcnt lgkmcnt(0)" ::: "memory"); __builtin_amdgcn_s_barrier(); asm volatile("" ::: "memory"); }
__device__ __forceinline__ int seqpos(int dir, int n) { return dir == 0 ? n : (n < CTX ? (CTX - 1 - n) : (TT - 1 - (n - CTX))); }
__device__ __forceinline__ int s5pos(int j) { if (j < CTX) return j; const int tok = j - CTX; return CTX + (tok & 63) * 128 + (tok >> 6); }

#define XB_TMO      128
#define XB_XCNT(j)  (256  + 64 * (j))
#define XB_XSUB(j)  (1280 + 64 * (j))
#define XB_XGEN(j)  (2304 + 64 * (j))
#define XB_TOP      3328
#define XB_TOPGEN   3392
#define XCD_BAR_WORDS 3456
#define XB_SPIN_CAP (1u << 18)

__device__ __forceinline__ unsigned xb_ld(unsigned* p)              { return __hip_atomic_load(p, __ATOMIC_RELAXED, __HIP_MEMORY_SCOPE_AGENT); }
__device__ __forceinline__ unsigned xb_add(unsigned* p, unsigned v) { return __hip_atomic_fetch_add(p, v, __ATOMIC_RELAXED, __HIP_MEMORY_SCOPE_AGENT); }
__device__ __forceinline__ unsigned xb_xcc_id() { return (unsigned)__builtin_amdgcn_s_getreg((3 << 11) | 20) & 0xFu; }
#define XB_SPIN(cond, bar) do { unsigned _sp = 0; while (cond) { __builtin_amdgcn_s_sleep(1); \
    if ((++_sp & 255u) == 0u) { if (xb_ld(&(bar)[XB_TMO])) break; if (_sp > XB_SPIN_CAP) { atomicAdd(&(bar)[XB_TMO], 1u); break; } } } } while (0)

struct XcdBarrier {
    int wv;
    unsigned* bar; unsigned x;
    volatile LAS unsigned* st;
};

__device__ __forceinline__ XcdBarrier xcd_barrier_post(unsigned* bar, volatile LAS unsigned* st, int wv) {
    XcdBarrier b; b.bar = bar; b.x = xb_xcc_id(); b.st = st; b.wv = wv;
    if (wv == 0 && lane_id() == 0) (void)xb_add(&bar[XB_XCNT(b.x)], 1u);
    return b;
}
__device__ __forceinline__ void xcd_barrier_complete(unsigned* bar, unsigned x, unsigned& nloc, unsigned& nx) {
    const unsigned G = gridDim.x * gridDim.y * gridDim.z;
    unsigned sum, cnt, mine, sp = 0u;
    for (;;) {
        sum = 0u; cnt = 0u; mine = 0u;
#pragma unroll
        for (unsigned j = 0; j < 16; ++j) { const unsigned c = xb_ld(&bar[XB_XCNT(j)]); sum += c; cnt += (c > 0u) ? 1u : 0u; mine = (j == x) ? c : mine; }
        if (sum == G) break;
        __builtin_amdgcn_s_sleep(1);
        if ((++sp & 255u) == 0u) { if (xb_ld(&bar[XB_TMO])) break; if (sp > XB_SPIN_CAP) { atomicAdd(&bar[XB_TMO], 1u); break; } }
    }
    nloc = mine > 0u ? mine : 1u; nx = cnt > 0u ? cnt : 1u;
}

__device__ __forceinline__ void xcd_barrier(const XcdBarrier& b) {
    asm volatile("s_waitcnt vmcnt(0)" ::: "memory");
    __syncthreads();
    if (b.wv == 0 && lane_id() == 0) {
        unsigned* bar = b.bar;
        __builtin_amdgcn_s_waitcnt(0);
        unsigned nloc = b.st[0], nx = b.st[1];
        if (nloc == 0u) { xcd_barrier_complete(bar, b.x, nloc, nx); b.st[0] = nloc; b.st[1] = nx; }
        const unsigned old = xb_add(&bar[XB_XSUB(b.x)], 1u);
        const unsigned gen = old / nloc;
        if (old + 1u == (gen + 1u) * nloc) {
            __builtin_amdgcn_fence(__ATOMIC_RELEASE, "agent");
            asm volatile("s_waitcnt vmcnt(0)" ::: "memory");
            const unsigned og = xb_add(&bar[XB_TOP], 1u);
            const unsigned tg = og / nx;
            if (og + 1u == (tg + 1u) * nx) xb_add(&bar[XB_TOPGEN], 1u);
            else XB_SPIN(xb_ld(&bar[XB_TOPGEN]) == tg, bar);
            __builtin_amdgcn_fence(__ATOMIC_ACQUIRE, "agent");
            xb_add(&bar[XB_XGEN(b.x)], 1u);
            asm volatile("s_waitcnt vmcnt(0)" ::: "memory");
        } else {
            XB_SPIN(xb_ld(&bar[XB_XGEN(b.x)]) == gen, bar);
            __builtin_amdgcn_fence(__ATOMIC_ACQUIRE, "agent");
            asm volatile("s_waitcnt vmcnt(0)" ::: "memory");
        }
    }
    __syncthreads();
}


namespace pg8 {
constexpr int BM = 256, BK = 64, HALF = 128, HTB = HALF * BK * 2, NXCD = 8, WGM = 8;
__device__ __forceinline__ int lds_byte(int r, int c) { const int st = (r >> 4) * 2 + (c >> 5), rr = r & 15, cc = c & 31, ob = rr * 64 + cc * 2; return st * 1024 + (ob ^ (((ob >> 9) & 1) << 5)); }
__device__ __forceinline__ void stage_rc(int b, int& R, int& C) { const int st = b / 1024, sb = b % 1024, swz = sb ^ (((sb >> 9) & 1) << 5); R = (st >> 1) * 16 + swz / 64; C = (st & 1) * 32 + (swz % 64) / 2; }
__device__ __forceinline__ int perm32(int rho) { const int n = rho >> 4, i = rho & 15; return 8 * (i >> 2) + 4 * n + (i & 3); }
struct Unit { int pm, pn, grp; size_t aoff, boff; };
struct Gemm { const bf16_t* A; const bf16_t* Bt; int K, lda, ldb; };
struct Sched {
    int mode, nM, nN, nwg, G, c; size_t gA, gB, tA, tB;
    __device__ bool next(int i, Unit& u) const {
        const long L = (long)i * G + c; if (L >= nwg) return false;
        if (mode == 0) {
            int wgid = (int)L; { const int q = nwg / NXCD, r = nwg % NXCD, xcd = wgid % NXCD, off = wgid / NXCD; wgid = (xcd < r ? xcd * (q + 1) : r * (q + 1) + (xcd - r) * q) + off; }
            const int nig = WGM * nN, gid = wgid / nig, fm = gid * WGM, gsz = (nM - fm) < WGM ? (nM - fm) : WGM;
            u.pm = fm + ((wgid % nig) % gsz); u.pn = (wgid % nig) / gsz; u.grp = 0;
        } else {
            const int upg = nM * nN; u.grp = (int)L / upg; const int rem = (int)L % upg; u.pm = rem % nM; u.pn = rem / nM;
        }
        u.aoff = (size_t)u.grp * gA + (size_t)u.pm * tA; u.boff = (size_t)u.grp * gB + (size_t)u.pn * tB; return true;
    }
};

template <class Epi>
__device__ __forceinline__ void gemm_phase(LAS uchar* lds, const Gemm g, const Sched& S, const Epi& E, int wv) {
    const int tid = tid_of(wv), wid = __builtin_amdgcn_readfirstlane(tid >> 6), lane = tid & 63, wr = wid >> 2, wc = wid & 3, fr = lane & 15, fq = lane >> 4;
    const int K = g.K, nt = K / BK;
    unsigned voffA[2], voffB[2];
#pragma unroll
    for (int i = 0; i < 2; ++i) { int R, C; stage_rc(tid * 16 + i * 8192, R, C); const int Rb = Epi::PERM ? ((R & ~31) + perm32(R & 31)) : R;
        voffA[i] = (unsigned)(R * g.lda + C) * 2u; voffB[i] = (unsigned)(Rb * g.ldb + C) * 2u; }
    const size_t kstep = (size_t)(BK * 2);
    const size_t hstepA = (size_t)HALF * g.lda * 2, hstepB = (size_t)HALF * g.ldb * 2;
    const unsigned ldsw = (unsigned)wid * 1024u;
    const int aoff = lds_byte(wr * 64 + fr, fq * 8), boff = lds_byte(wc * 32 + fr, fq * 8);
#define PG8_SA(b, h) (((b) * 2 + (h)) * HTB)
#define PG8_SB(b, h) ((4 + (b) * 2 + (h)) * HTB)
#define PG8_STAGE(bufoff, gbase, voff) do { _Pragma("unroll") for (int _i = 0; _i < 2; ++_i) \
        __builtin_amdgcn_global_load_lds((const unsigned*)((const char*)(gbase) + (voff)[_i]), (LAS unsigned*)(lds + (bufoff) + ldsw + _i * 8192), 16, 0, 0); } while (0)
#define PG8_LDA(dst, b, h) do { _Pragma("unroll") for (int m = 0; m < 4; ++m) _Pragma("unroll") for (int k = 0; k < 2; ++k) dst[m][k] = *(const LAS bf16x8*)(lds + PG8_SA(b, h) + aoff + m * 2048 + k * 1024); } while (0)
#define PG8_LDB(dst, b, h) do { _Pragma("unroll") for (int n = 0; n < 2; ++n) _Pragma("unroll") for (int k = 0; k < 2; ++k) dst[n][k] = *(const LAS bf16x8*)(lds + PG8_SB(b, h) + boff + n * 2048 + k * 1024); } while (0)
#define PG8_MMA(ai, bj, At, Bt) do { __builtin_amdgcn_s_setprio(1); _Pragma("unroll") for (int m = 0; m < 4; ++m) _Pragma("unroll") for (int n = 0; n < 2; ++n) _Pragma("unroll") for (int k = 0; k < 2; ++k) \
        acc[ai][bj][m][n] = __builtin_amdgcn_mfma_f32_16x16x32_bf16(Bt[n][k], At[m][k], acc[ai][bj][m][n], 0, 0, 0); __builtin_amdgcn_s_setprio(0); } while (0)
#define PG8_WAIT_V(n) asm volatile("s_waitcnt vmcnt(" #n ")" ::: "memory")
#define PG8_WAIT_L(n) asm volatile("s_waitcnt lgkmcnt(" #n ")" ::: "memory")
#define PG8_BAR __builtin_amdgcn_s_barrier()
#define PG8_SCHED __builtin_amdgcn_sched_barrier(0)
    Unit cur, nxt; int ui = 0;
    if (!S.next(0, cur)) return;
    f32x4 acc[2][2][4][2];
#pragma unroll
    for (int a = 0; a < 2; ++a)
#pragma unroll
        for (int b = 0; b < 2; ++b)
#pragma unroll
            for (int m = 0; m < 4; ++m)
#pragma unroll
                for (int n = 0; n < 2; ++n) acc[a][b][m][n] = (f32x4){0.f, 0.f, 0.f, 0.f};
    bf16x8 At[4][2], B0[2][2], B1[2][2];
    const char* cA = (const char*)g.A + cur.aoff; const char* cB = (const char*)g.Bt + cur.boff;
    PG8_STAGE(PG8_SB(0, 0), cB, voffB); PG8_STAGE(PG8_SA(0, 0), cA, voffA); PG8_STAGE(PG8_SB(0, 1), cB + hstepB, voffB); PG8_STAGE(PG8_SA(0, 1), cA + hstepA, voffA);
    if (wr == 1) PG8_BAR;
    PG8_WAIT_V(4); PG8_BAR;
    PG8_STAGE(PG8_SB(1, 0), cB + kstep, voffB); PG8_STAGE(PG8_SA(1, 0), cA + kstep, voffA); PG8_STAGE(PG8_SB(1, 1), cB + hstepB + kstep, voffB);
    PG8_WAIT_V(6); PG8_BAR;
    for (;;) {
        const bool has_next = S.next(ui + 1, nxt);
        const char* nA = has_next ? (const char*)g.A + nxt.aoff : cA; const char* nB = has_next ? (const char*)g.Bt + nxt.boff : cB;
        for (int t = 0; t < nt; t += 2) {
            const bool last = (t == nt - 2);
            const char* a1 = cA + (size_t)(t + 1) * kstep;
            const char* a2 = last ? nA : cA + (size_t)(t + 2) * kstep; const char* b2 = last ? nB : cB + (size_t)(t + 2) * kstep;
            const char* a3 = a2 + kstep; const char* b3 = b2 + kstep;
            PG8_LDB(B0, 0, 0); PG8_SCHED; PG8_LDA(At, 0, 0); PG8_STAGE(PG8_SA(1, 1), a1 + hstepA, voffA);
            PG8_WAIT_L(8); PG8_BAR; PG8_WAIT_L(0); PG8_MMA(0, 0, At, B0); PG8_BAR; PG8_SCHED;
            PG8_LDB(B1, 0, 1); PG8_STAGE(PG8_SB(0, 0), b2, voffB);
            PG8_BAR; PG8_WAIT_L(0); PG8_MMA(0, 1, At, B1); PG8_BAR;
            PG8_LDA(At, 0, 1); PG8_STAGE(PG8_SA(0, 0), a2, voffA);
            PG8_BAR; PG8_WAIT_L(0); PG8_MMA(1, 0, At, B0); PG8_BAR; PG8_SCHED;
            PG8_STAGE(PG8_SB(0, 1), b2 + hstepB, voffB);
            PG8_WAIT_V(6); PG8_BAR; PG8_MMA(1, 1, At, B1); PG8_BAR;
            PG8_LDB(B0, 1, 0); PG8_SCHED; PG8_LDA(At, 1, 0); PG8_STAGE(PG8_SA(0, 1), a2 + hstepA, voffA);
            PG8_WAIT_L(8); PG8_BAR; PG8_WAIT_L(0); PG8_MMA(0, 0, At, B0); PG8_BAR; PG8_SCHED;
            PG8_LDB(B1, 1, 1); PG8_STAGE(PG8_SB(1, 0), b3, voffB);
            PG8_BAR; PG8_WAIT_L(0); PG8_MMA(0, 1, At, B1); PG8_BAR;
            PG8_LDA(At, 1, 1); PG8_STAGE(PG8_SA(1, 0), a3, voffA);
            PG8_BAR; PG8_WAIT_L(0); PG8_MMA(1, 0, At, B0); PG8_BAR; PG8_SCHED;
            PG8_STAGE(PG8_SB(1, 1), b3 + hstepB, voffB);
            PG8_WAIT_V(6); PG8_BAR; PG8_MMA(1, 1, At, B1); PG8_BAR;
        }
        E(acc, cur, wr, wc, fr, fq);
        if (!has_next) break;
#pragma unroll
        for (int a = 0; a < 2; ++a)
#pragma unroll
            for (int b = 0; b < 2; ++b)
#pragma unroll
                for (int m = 0; m < 4; ++m)
#pragma unroll
                    for (int n = 0; n < 2; ++n) acc[a][b][m][n] = (f32x4){0.f, 0.f, 0.f, 0.f};
        cur = nxt; cA = nA; cB = nB; ++ui;
    }
    PG8_WAIT_V(0);
    if (wr == 0) PG8_BAR;
    PG8_BAR;
#undef PG8_SA
#undef PG8_SB
#undef PG8_STAGE
#undef PG8_LDA
#undef PG8_LDB
#undef PG8_MMA
#undef PG8_WAIT_V
#undef PG8_WAIT_L
#undef PG8_BAR
#undef PG8_SCHED
}
}
using pg8::Unit;

struct EpiZ {
    static constexpr bool PERM = true;
    bf16_t* Z; bf16_t* A2;
    __device__ __forceinline__ void operator()(const f32x4 (&acc)[2][2][4][2], const Unit& u, int wr, int wc, int fr, int fq) const {
#pragma unroll
        for (int ai = 0; ai < 2; ++ai)
#pragma unroll
            for (int m = 0; m < 4; ++m) {
                const int r = u.pm * 256 + ai * 128 + wr * 64 + m * 16 + fr;
#pragma unroll
                for (int bj = 0; bj < 2; ++bj) {
                    const int c = u.pn * 256 + bj * 128 + wc * 32 + 8 * fq;
                    u32x4 w; w.x = pk2(acc[ai][bj][m][0][0], acc[ai][bj][m][0][1]); w.y = pk2(acc[ai][bj][m][0][2], acc[ai][bj][m][0][3]);
                    w.z = pk2(acc[ai][bj][m][1][0], acc[ai][bj][m][1][1]); w.w = pk2(acc[ai][bj][m][1][2], acc[ai][bj][m][1][3]);
                    if (u.pn == 0) {
                        const int b = r / TT, j = r - b * TT, n = s5pos(j), R = b * NCH + (n >> 5), s = n & 31, g = c >> 4, h0 = c & 15;
                        bf16_t* d0 = A2 + ((size_t)((g * 2) * GROWS + R)) * 640 + s * 16 + h0;
                        *(u32x4*)d0 = w; *(u32x4*)(d0 + (size_t)GROWS * 640) = w;
                    } else {
                        const int zc = c - 256;
                        if (zc < ZLD) *(u32x4*)(Z + (size_t)r * ZLD + zc) = w;
                    }
                }
            }
    }
};
struct EpiResid {
    static constexpr bool PERM = false;
    const float* xin; float* xout; const float* cin; float* cout; const float* mod; int gidx;
    __device__ __forceinline__ void operator()(const f32x4 (&acc)[2][2][4][2], const Unit& u, int wr, int wc, int fr, int fq) const {
        const int b = u.pm / 33, tb = u.pm - b * 33;
        const bool isctx = (tb == 0);
        const float* gate = mod + (size_t)(isctx ? 4 : b) * 6144 + gidx * 1024;
        const size_t row0 = isctx ? (size_t)b * CTX : (size_t)b * SEQ + (size_t)(tb - 1) * 256;
        const float* src = isctx ? cin : xin; float* dst = isctx ? cout : xout;
        const int col0 = u.pn * 256 + wc * 32 + 4 * fq;
#pragma unroll
        for (int ai = 0; ai < 2; ++ai)
#pragma unroll
            for (int m = 0; m < 4; ++m) {
                const size_t ro = (row0 + ai * 128 + wr * 64 + m * 16 + fr) * DM;
#pragma unroll
                for (int bj = 0; bj < 2; ++bj)
#pragma unroll
                    for (int n = 0; n < 2; ++n) {
                        const int c = col0 + bj * 128 + n * 16;
                        const f32x4 gv = *(const f32x4*)(gate + c); const f32x4 xv = *(const f32x4*)(src + ro + c);
                        *(f32x4*)(dst + ro + c) = xv + gv * acc[ai][bj][m][n];
                    }
                asm volatile("" ::: "memory");
            }
    }
};
struct EpiSwiGLU {
    static constexpr bool PERM = false;
    bf16_t* HID;
    __device__ __forceinline__ void operator()(const f32x4 (&acc)[2][2][4][2], const Unit& u, int wr, int wc, int fr, int fq) const {
#pragma unroll
        for (int ai = 0; ai < 2; ++ai)
#pragma unroll
            for (int m = 0; m < 4; ++m) {
                const size_t r = (size_t)(u.pm * 256 + ai * 128 + wr * 64 + m * 16 + fr);
#pragma unroll
                for (int bj = 0; bj < 2; ++bj) {
                    const int hc = u.pn * 128 + bj * 64 + wc * 16 + 4 * fq;
                    f32x4 o;
#pragma unroll
                    for (int i = 0; i < 4; ++i) o[i] = siluf_(acc[ai][bj][m][0][i]) * acc[ai][bj][m][1][i];
                    *(u32x2*)(HID + r * FFN + hc) = pk4(o);
                }
                asm volatile("" ::: "memory");
            }
    }
};
struct EpiHL {
    static constexpr bool PERM = false;
    float* HL;
    __device__ __forceinline__ void operator()(const f32x4 (&acc)[2][2][4][2], const Unit& u, int wr, int wc, int fr, int fq) const {
#pragma unroll
        for (int ai = 0; ai < 2; ++ai)
#pragma unroll
            for (int m = 0; m < 4; ++m) {
                const int R = u.pm * 256 + ai * 128 + wr * 64 + m * 16 + fr;
                if (R < GROWS) {
                    float* rp = HL + ((size_t)u.grp * GROWS + R) * 256 + wc * 32 + 4 * fq;
#pragma unroll
                    for (int bj = 0; bj < 2; ++bj)
#pragma unroll
                        for (int n = 0; n < 2; ++n) *(f32x4*)(rp + bj * 128 + n * 16) = acc[ai][bj][m][n];
                }
                asm volatile("" ::: "memory");
            }
    }
};
struct EpiY5 {
    static constexpr bool PERM = true;
    bf16_t* Y5;
    __device__ __forceinline__ void operator()(const f32x4 (&acc)[2][2][4][2], const Unit& u, int wr, int wc, int fr, int fq) const {
#pragma unroll
        for (int ai = 0; ai < 2; ++ai)
#pragma unroll
            for (int m = 0; m < 4; ++m) {
                const int R = u.pm * 256 + ai * 128 + wr * 64 + m * 16 + fr;
                if (R < GROWS) {
                    bf16_t* rp = Y5 + ((size_t)u.grp * GROWS + R) * 512 + u.pn * 256 + wc * 32 + 8 * fq;
#pragma unroll
                    for (int bj = 0; bj < 2; ++bj) {
                        u32x4 w; w.x = pk2(acc[ai][bj][m][0][0], acc[ai][bj][m][0][1]); w.y = pk2(acc[ai][bj][m][0][2], acc[ai][bj][m][0][3]);
                        w.z = pk2(acc[ai][bj][m][1][0], acc[ai][bj][m][1][1]); w.w = pk2(acc[ai][bj][m][1][2], acc[ai][bj][m][1][3]);
                        *(u32x4*)(rp + bj * 128) = w;
                    }
                }
            }
    }
};

__device__ __forceinline__ pg8::Sched sched_static(int M, int N, int lda, int ldb) {
    pg8::Sched S; S.mode = 0; S.nM = M / 256; S.nN = N / 256; S.nwg = S.nM * S.nN; S.G = gridDim.x; S.c = bidx();
    S.gA = 0; S.gB = 0; S.tA = (size_t)256 * lda * 2; S.tB = (size_t)256 * ldb * 2; return S;
}

__device__ __forceinline__ void phase_mod(const PP& p, float* sm) {
    float* sv = sm;
    float* part = sm + 5 * 1024;
    const int tid = tid_of(p.wv), w = tid >> 6, lane = tid & 63;
    for (int i = tid; i < 5 * 1024; i += 512) { const int v = i >> 10, k = i & 1023; const float x = v < 4 ? p.in[I_C][v * 1024 + k] : p.in[I_CCTX][k]; sv[i] = siluf_(x); }
    __syncthreads();
    float* mod = (float*)(p.ws + OFF_MOD);
    for (int it = bidx(); it < DEPTH * 48; it += gridDim.x) {
        const int l = it / 48, cb = it - l * 48, col = cb * 128 + 2 * lane;
        const float* W = p.in[I_ADAW] + (size_t)l * 1024 * 6144 + col;
        f32x2 a[5];
#pragma unroll
        for (int i = 0; i < 5; ++i) a[i] = (f32x2){0.f, 0.f};
#pragma unroll 8
        for (int k = w * 128; k < w * 128 + 128; ++k) {
            const f32x2 wv = *(const f32x2*)(W + (size_t)k * 6144);
#pragma unroll
            for (int i = 0; i < 5; ++i) a[i] += sv[i * 1024 + k] * wv;
        }
#pragma unroll
        for (int i = 0; i < 5; ++i) { part[(w * 5 + i) * 128 + 2 * lane] = a[i].x; part[(w * 5 + i) * 128 + 2 * lane + 1] = a[i].y; }
        __syncthreads();
        for (int o = tid; o < 640; o += 512) { const int i = o >> 7, cc = o & 127; float s = 0.f;
#pragma unroll
            for (int ww = 0; ww < 8; ++ww) s += part[(ww * 5 + i) * 128 + cc];
            mod[((size_t)l * 5 + i) * 6144 + cb * 128 + cc] = s + p.in[I_ADAB][l * 6144 + cb * 128 + cc]; }
        __syncthreads();
    }
}

__device__ __forceinline__ int n_coef_blocks() { return gridDim.x >= 128 ? 64 : 0; }
__device__ __forceinline__ void convT_tile(const float* src, const float* src2, int ldn, bf16_t* dst, int K, int kind, int n0, int k0, float* sm, int wv) {
    const int tid = tid_of(wv);
    {
        const int nn = tid & 63, kq = tid >> 6;
        const int np = n0 + nn; const float* s = src; int col;
        if (kind == 0) col = np < 256 ? 2968 + np : (np < 3224 ? np - 256 : -1);
        else if (kind == 1) col = np;
        else { const int G = np >> 5, w = np & 31; col = 16 * G + (w & 15); if (w >= 16) s = src2; }
#pragma unroll
        for (int i = 0; i < 8; ++i) { const int kk = kq + 8 * i; sm[kk * 65 + nn] = col >= 0 ? s[(size_t)(k0 + kk) * ldn + col] : 0.f; }
    }
    __syncthreads();
    {
        const int n = tid >> 3, ks = (tid & 7) * 8;
        u32x4 w; w.x = pk2(sm[(ks + 0) * 65 + n], sm[(ks + 1) * 65 + n]); w.y = pk2(sm[(ks + 2) * 65 + n], sm[(ks + 3) * 65 + n]);
        w.z = pk2(sm[(ks + 4) * 65 + n], sm[(ks + 5) * 65 + n]); w.w = pk2(sm[(ks + 6) * 65 + n], sm[(ks + 7) * 65 + n]);
        *(u32x4*)(dst + (size_t)(n0 + n) * K + k0 + ks) = w;
    }
    __syncthreads();
}
__device__ __forceinline__ void phase_convw(const PP& p, int l, float* sm, int w0, int nwb, int ffn) {
    constexpr int T0 = 832, T1 = T0 + 256, T2 = T1 + 1408, T3 = T2 + 704, T4 = T3 + 12, T5 = T4 + 12, T6 = T5 + 12, T7 = T6 + 16;
    const int wb = bidx() - w0;
    if (wb < 0 || wb >= nwb) return;
    const int nt = ffn ? (T3 - T1) : (T7 - (T3 - T1));
    for (int tt = wb; tt < nt; tt += nwb) {
        const int t = ffn ? tt + T1 : (tt < T1 ? tt : tt + (T3 - T1));
        if (t < T0) { convT_tile(p.in[I_WIN] + (size_t)l * 1024 * 3224, nullptr, 3224, (bf16_t*)(p.ws + OFF_WIN), 1024, 0, (t >> 4) * 64, (t & 15) * 64, sm, p.wv); }
        else if (t < T1) { const int q = t - T0; convT_tile(p.in[I_WOUT] + (size_t)l * 1024 * 1024, nullptr, 1024, (bf16_t*)(p.ws + OFF_WOUT), 1024, 1, (q >> 4) * 64, (q & 15) * 64, sm, p.wv); }
        else if (t < T2) { const int q = t - T1; convT_tile(p.in[I_FG8] + (size_t)l * 1024 * FFN, p.in[I_FU] + (size_t)l * 1024 * FFN, FFN, (bf16_t*)(p.ws + OFF_WGU), 1024, 2, (q >> 4) * 64, (q & 15) * 64, sm, p.wv); }
        else if (t < T3) { const int q = t - T2; convT_tile(p.in[I_FD] + (size_t)l * FFN * 1024, nullptr, 1024, (bf16_t*)(p.ws + OFF_WDN), FFN, 1, (q / 44) * 64, (q % 44) * 64, sm, p.wv); }
        else if (t < T4) { const int q = t - T3, d = q / 6; convT_tile(p.in[I_WUP] + ((size_t)l * 2 + d) * 64 * 384, nullptr, 384, (bf16_t*)(p.ws + OFF_WUP) + d * 384 * 64, 64, 1, (q % 6) * 64, 0, sm, p.wv); }
        else if (t < T5) { const int q = t - T4, d = q / 6; convT_tile(p.in[I_AUP] + ((size_t)l * 2 + d) * 64 * 384, nullptr, 384, (bf16_t*)(p.ws + OFF_AUP) + d * 384 * 64, 64, 1, (q % 6) * 64, 0, sm, p.wv); }
        else if (t < T6) { const int q = t - T5; convT_tile(p.in[I_GUP] + (size_t)l * 128 * 384, nullptr, 384, (bf16_t*)(p.ws + OFF_GUP), 128, 1, (q >> 1) * 64, (q & 1) * 64, sm, p.wv); }
        else { const int q = t - T6; convT_tile(p.in[I_GLUW] + (size_t)l * 256 * 256, nullptr, 256, (bf16_t*)(p.ws + OFF_GLU), 256, 1, (q >> 2) * 64, (q & 3) * 64, sm, p.wv); }
    }
}

__device__ __forceinline__ void phase_s5coef(const PP& p, int l, float* sm) {
    float* pw = sm;
    float* bb = pw + 33 * 128;
    float* cc = bb + 2048;
    float* Kt = cc + 2048;
    const int tid = tid_of(p.wv);
    bf16_t* TF = (bf16_t*)(p.ws + OFF_TF); bf16_t* E2 = (bf16_t*)(p.ws + OFF_E2); float* DP = (float*)(p.ws + OFF_DP);
    for (int item = (int)gridDim.x - 1 - (int)bidx(); item < 64; item += gridDim.x) {
        const int it = item >> 1, part = item & 1, g = it >> 1, dir = it & 1;
        const size_t base = ((size_t)l * 2 + dir) * 16 + g;
        if (tid < 64) {
            const int q = tid;
            const float lre = p.in[I_LRE][base * 64 + q], lim = p.in[I_LIM][base * 64 + q], dt = __expf(p.in[I_LDT][base]);
            const float mag = __expf(lre * dt); float sn, cs; sincosf(lim * dt, &sn, &cs);
            const float are = mag * cs, aim = mag * sn, den = lre * lre + lim * lim;
            const float fre = ((are - 1.f) * lre + aim * lim) / den, fim = (aim * lre - (are - 1.f) * lim) / den;
            float pr = 1.f, pi = 0.f;
            for (int m = 0; m <= 32; ++m) { pw[(m * 64 + q) * 2] = pr; pw[(m * 64 + q) * 2 + 1] = pi; const float nr = pr * are - pi * aim, ni = pr * aim + pi * are; pr = nr; pi = ni; }
            for (int h = 0; h < 16; ++h) { const float br = p.in[I_BRE][(base * 64 + q) * 16 + h], bi = p.in[I_BIM][(base * 64 + q) * 16 + h];
                bb[(q * 16 + h) * 2] = fre * br - fim * bi; bb[(q * 16 + h) * 2 + 1] = fre * bi + fim * br; }
            if (part == 0) { DP[(it * 64 + q) * 2] = pw[(32 * 64 + q) * 2]; DP[(it * 64 + q) * 2 + 1] = pw[(32 * 64 + q) * 2 + 1]; }
        }
        for (int i = tid; i < 1024; i += 512) { const int h = i >> 6, q = i & 63; cc[i * 2] = p.in[I_CRE][(base * 16 + h) * 64 + q]; cc[i * 2 + 1] = p.in[I_CIM][(base * 16 + h) * 64 + q]; }
        __syncthreads();
        {
            const int lag = tid >> 4, hp = tid & 15;
            float s[16];
#pragma unroll
            for (int h = 0; h < 16; ++h) s[h] = 0.f;
            for (int q = 0; q < 64; ++q) {
                const f32x2 c2 = *(const f32x2*)(cc + (hp * 64 + q) * 2), w2 = *(const f32x2*)(pw + (lag * 64 + q) * 2);
                const float xr = c2.x * w2.x - c2.y * w2.y, xi = c2.x * w2.y + c2.y * w2.x;
#pragma unroll
                for (int h4 = 0; h4 < 8; ++h4) { const f32x4 b4 = *(const f32x4*)(bb + (q * 16 + 2 * h4) * 2); s[2 * h4] += xr * b4[0] - xi * b4[1]; s[2 * h4 + 1] += xr * b4[2] - xi * b4[3]; }
            }
#pragma unroll
            for (int h4 = 0; h4 < 4; ++h4) *(f32x4*)(Kt + lag * 256 + hp * 16 + 4 * h4) = (f32x4){s[4 * h4], s[4 * h4 + 1], s[4 * h4 + 2], s[4 * h4 + 3]};
        }
        __syncthreads();
        bf16_t* tf = TF + (size_t)it * 512 * 640;
        for (int o = part * 256 * 320 + tid; o < (part + 1) * 256 * 320; o += 512) {
            const int row = o / 320, c2 = (o - row * 320) * 2, t = row >> 4, hp = row & 15;
            float v[2];
            if (c2 < 512) {
#pragma unroll
                for (int e = 0; e < 2; ++e) { const int col = c2 + e, s = col >> 4, h = col & 15; const int lag = dir == 0 ? t - s : s - t; v[e] = lag >= 0 ? Kt[lag * 256 + hp * 16 + h] : 0.f; }
            } else {
                const int q = (c2 - 512) >> 1, m = dir == 0 ? t + 1 : 32 - t;
                const float cr = cc[(hp * 64 + q) * 2], ci = cc[(hp * 64 + q) * 2 + 1], wr_ = pw[(m * 64 + q) * 2], wi = pw[(m * 64 + q) * 2 + 1];
                v[0] = cr * wr_ - ci * wi; v[1] = -(cr * wi + ci * wr_);
            }
            *(unsigned*)(tf + (size_t)row * 640 + c2) = pk2(v[0], v[1]);
        }
        bf16_t* e2 = E2 + ((size_t)g * 256 + dir * 128) * 512;
        for (int o = part * 64 * 256 + tid; o < (part + 1) * 64 * 256; o += 512) {
            const int row = o >> 8, c2 = (o & 255) * 2, q = row >> 1, ri = row & 1; float v[2];
#pragma unroll
            for (int e = 0; e < 2; ++e) { const int col = c2 + e, s = col >> 4, h = col & 15, ex = dir == 0 ? 31 - s : s;
                const float wr_ = pw[(ex * 64 + q) * 2], wi = pw[(ex * 64 + q) * 2 + 1], br = bb[(q * 16 + h) * 2], bi = bb[(q * 16 + h) * 2 + 1];
                v[e] = ri == 0 ? (wr_ * br - wi * bi) : (wr_ * bi + wi * br); }
            *(unsigned*)(e2 + (size_t)row * 512 + c2) = pk2(v[0], v[1]);
        }
        __syncthreads();
    }
}

__device__ __forceinline__ void phase_norm(const PP& p, int l, int which, const float* xsrc, const float* csrc, int share) {
    const int nwb = (int)gridDim.x - (share ? n_coef_blocks() : 0);
    if (bidx() >= nwb) return;
    const int lane = tid_of(p.wv) & 63, gw = bidx() * 8 + (tid_of(p.wv) >> 6), nw = nwb * 8;
    const float* gain = p.in[which == 0 ? I_N1G : I_N2G] + l * 1024;
    const float* mod = (const float*)(p.ws + OFF_MOD) + (size_t)l * 5 * 6144;
    bf16_t* H = (bf16_t*)(p.ws + OFF_H);
    for (int r = gw; r < MROWS; r += nw) {
        const int b = r / TT, j = r - b * TT;
        const float* src = j < CTX ? csrc + ((size_t)b * CTX + j) * DM : xsrc + ((size_t)b * SEQ + (j - CTX)) * DM;
        const float* mv = mod + (size_t)(j < CTX ? 4 : b) * 6144 + (which == 0 ? 0 : 3072);
        f32x4 v[4]; float ss = 0.f;
#pragma unroll
        for (int i = 0; i < 4; ++i) { v[i] = *(const f32x4*)(src + i * 256 + lane * 4); ss += v[i][0] * v[i][0] + v[i][1] * v[i][1] + v[i][2] * v[i][2] + v[i][3] * v[i][3]; }
        ss = red64(ss);
        const float rs = __builtin_amdgcn_rsqf(ss * (1.f / 1024.f) + 1e-6f);
#pragma unroll
        for (int i = 0; i < 4; ++i) {
            const int c = i * 256 + lane * 4;
            const f32x4 gv = *(const f32x4*)(gain + c), sh = *(const f32x4*)(mv + c), sc = *(const f32x4*)(mv + 1024 + c);
            const f32x4 y = v[i] * rs * gv * (sc + 1.f) + sh;
            *(u32x2*)(H + (size_t)r * DM + c) = pk4(y);
        }
    }
}
__device__ __forceinline__ void phase_final(const PP& p) {
    const int lane = tid_of(p.wv) & 63, gw = bidx() * 8 + (tid_of(p.wv) >> 6), nw = gridDim.x * 8;
    const float* gain = p.in[I_FG];
    for (int r = gw; r < NB * SEQ; r += nw) {
        float* src = p.out + (size_t)r * DM;
        f32x4 v[4]; float ss = 0.f;
#pragma unroll
        for (int i = 0; i < 4; ++i) { v[i] = *(const f32x4*)(src + i * 256 + lane * 4); ss += v[i][0] * v[i][0] + v[i][1] * v[i][1] + v[i][2] * v[i][2] + v[i][3] * v[i][3]; }
        ss = red64(ss);
        const float rs = __builtin_amdgcn_rsqf(ss * (1.f / 1024.f) + 1e-6f);
#pragma unroll
        for (int i = 0; i < 4; ++i) { const int c = i * 256 + lane * 4; const f32x4 gv = *(const f32x4*)(gain + c); *(f32x4*)(src + c) = v[i] * rs * gv; }
    }
}

struct Nb3 { u32x2 pv, cu, nx; };
__device__ __forceinline__ Nb3 ld3(const bf16_t* Z, int row, bool hp, bool hn, int col) {
    Nb3 o; const bf16_t* q = Z + (size_t)row * ZLD + col;
    o.cu = *(const u32x2*)q;
    o.pv = hp ? *(const u32x2*)(q - ZLD) : (u32x2){0u, 0u};
    o.nx = hn ? *(const u32x2*)(q + ZLD) : (u32x2){0u, 0u};
    return o;
}
__device__ __forceinline__ f32x4 shiftmix(const Nb3& v, const float* mu) {
    const f32x4 c = unpk4(v.cu), a = unpk4(v.pv), n = unpk4(v.nx), m = *(const f32x4*)mu;
    return c + ((a + n) * 0.5f - c) * m;
}


constexpr int RWP_LD = 896;
__device__ __forceinline__ void phase_rwprep(const PP& p, int l) {
    const bf16_t* Z = (const bf16_t*)(p.ws + OFF_Z);
    bf16_t* RWP = (bf16_t*)(p.ws + OFF_H);
    const float* mu = p.in[I_MU] + l * 1408;
    const int nth = gridDim.x * 512;
    for (int idx = bidx() * 512 + tid_of(p.wv); idx < MROWS * 224; idx += nth) {
        const int row = idx / 224, qd = idx - row * 224, col0 = 4 * qd, zc = col0 < 768 ? col0 : col0 + 384;
        const int b = row / TT, j = row - b * TT;
        const bool hp = (j != 0) && (j != CTX), hn = (j != CTX - 1) && (j != TT - 1);
        f32x4 v = shiftmix(ld3(Z, row, hp, hn, zc), mu + zc);
        if (col0 >= 768 && col0 < 832) {
#pragma unroll
            for (int i = 0; i < 4; ++i) v[i] = tanhf_(v[i]);
        }
        *(u32x2*)(RWP + (size_t)row * RWP_LD + col0) = pk4(v);
    }
}

namespace ck {
constexpr int PC_STRIDE = 18432, PCB_BYTES = 36864, WKS0 = 73728, WKS_BYTES = 9216, WKP0 = 110592, WKP_BYTES = 3072, SW0 = 116736, SAA0 = 134144, SY0 = 151552, CST0 = 159744, SWLD = 68, SWBUF = 32 * 68;
__device__ __forceinline__ bf16x8 mk8(u32x2 lo, u32x2 hi) { u32x4 t; t.x = lo.x; t.y = lo.y; t.z = hi.x; t.w = hi.y; return __builtin_bit_cast(bf16x8, t); }
__device__ __forceinline__ bf16x8 pk8z(f32x4 v) { return mk8(pk4(v), (u32x2){0u, 0u}); }
#define CK_MFMA(a, b, c) __builtin_amdgcn_mfma_f32_16x16x32_bf16(a, b, c, 0, 0, 0)
__device__ __forceinline__ int krow(int k) { return (k & ~3) | ((k + (k >> 3)) & 3); }
template <int TYPE, bool MIDBAR>
__device__ __forceinline__ void prep_wave(const char* pc, char* wkp, char* wks, int lane) {
    const int row16 = lane & 15, q = lane >> 4;
    const u32x2 Z2 = (u32x2){0u, 0u};
    const f32x4 z4 = (f32x4){0.f, 0.f, 0.f, 0.f};
    float* AMak = (float*)wkp; float* AMrb = (float*)(wkp + 1024); float* AMrk = (float*)(wkp + 2048);
    bf16_t* W1row = (bf16_t*)wks; bf16_t* R2row = (bf16_t*)(wks + 2304);
    const bf16_t* GA = (const bf16_t*)pc; const bf16_t* GR = (const bf16_t*)(pc + 2304); const bf16_t* GB = (const bf16_t*)(pc + 4608);
    const bf16_t* GK = (const bf16_t*)(pc + (TYPE == 0 ? 6912 : 4608));
    const bf16_t* GAT = (const bf16_t*)(pc + 9216); const bf16_t* VT = (const bf16_t*)(pc + 15360);
    const float* gc = (const float*)(pc + 17408);
    f32x4 gab = z4, gabT = z4, gak = z4, grb = z4, grk = z4;
#pragma unroll
    for (int ks = 0; ks < 2; ++ks) {
        const int o = row16 * 72 + 8 * q + 32 * ks;
        const bf16x8 ra = *(const bf16x8*)(GA + o), rr = *(const bf16x8*)(GR + o), cbf = *(const bf16x8*)(GB + o), ckf = *(const bf16x8*)(GK + o);
        gab = CK_MFMA(ra, cbf, gab); gabT = CK_MFMA(cbf, ra, gabT); gak = CK_MFMA(ra, ckf, gak); grb = CK_MFMA(rr, cbf, grb); grk = CK_MFMA(rr, ckf, grk);
    }
#pragma unroll
    for (int r = 0; r < 4; ++r) {
        const int t = 4 * q + r, i = row16; const bool ks_ = i < t, kl = i <= t;
        float dS = 1.f, dL = 1.f, dT = 1.f;
        if (TYPE == 1) { const float gi = gc[i]; dS = __expf(ks_ ? gc[t > 0 ? t - 1 : 0] - gi : 0.f); dL = __expf(kl ? gc[t] - gi : 0.f);
                         const int t2 = row16, i2 = 4 * q + r; dT = __expf(i2 < t2 ? gc[t2 - 1] - gc[i2] : 0.f); }
        gab[r] = ks_ ? gab[r] * dS : 0.f; gak[r] = ks_ ? gak[r] * dS : 0.f; grb[r] = kl ? grb[r] * dL : 0.f; grk[r] = kl ? grk[r] * dL : 0.f;
        gabT[r] = (4 * q + r < row16) ? gabT[r] * dT : 0.f;
    }
    f32x4 A = gab, AT = gabT, MT;
#pragma unroll
    for (int r = 0; r < 4; ++r) MT[r] = AT[r] + ((4 * q + r == row16) ? 1.f : 0.f);
#pragma unroll
    for (int s = 0; s < 3; ++s) {
        const bf16x8 pa = pk8z(A), pat = pk8z(AT);
        const f32x4 A2 = CK_MFMA(pat, pa, z4);
        MT = CK_MFMA(pk8z(A2), pk8z(MT), MT);
        if (s < 2) { AT = CK_MFMA(pa, pat, z4); A = A2; }
    }
    if (MIDBAR) lbar();
    const bf16x8 mplain = pk8z(MT);
    bf16x8 mfA = mplain;
    if (TYPE == 1) mfA = pk8z(MT * *(const f32x4*)(gc + 32 + 4 * q));
#pragma unroll
    for (int r = 0; r < 4; ++r) { AMak[(4 * q + r) * 16 + row16] = gak[r]; AMrb[(4 * q + r) * 16 + row16] = grb[r]; AMrk[(4 * q + r) * 16 + row16] = grk[r]; }
    const f32x4 aak4 = *(const f32x4*)(AMak + row16 * 16 + 4 * q), arb4 = *(const f32x4*)(AMrb + row16 * 16 + 4 * q), ark4 = *(const f32x4*)(AMrk + row16 * 16 + 4 * q);
    const bf16x8 arbB = pk8z(arb4);
#pragma unroll
    for (int nt = 0; nt < 4; ++nt) {
        const bf16x8 gfB = mk8(*(const u32x2*)(GAT + krow(16 * nt + row16) * 16 + 4 * q), Z2);
        const f32x4 W1n = CK_MFMA(mfA, gfB, z4);
        const f32x4 W1T = CK_MFMA(gfB, mfA, z4);
        *(u32x2*)(W1row + row16 * 72 + 16 * nt + 4 * q) = pk4(W1T);
        f32x4 cin = unpk4(*(const u32x2*)(GR + row16 * 72 + 16 * nt + 4 * q));
        if (TYPE == 1) cin = cin * gc[16 + row16];
        const f32x4 R2T = CK_MFMA(pk8z(W1n), arbB, cin);
        *(u32x2*)(R2row + row16 * 72 + 16 * nt + 4 * q) = pk4(R2T);
    }
    const bf16x8 aakA = pk8z(aak4), arbk = mk8(pk4(arb4), pk4(ark4));
#pragma unroll
    for (int vt = 0; vt < 2; ++vt) {
        const u32x2 vtf = *(const u32x2*)(VT + krow(16 * vt + row16) * 16 + 4 * q);
        const f32x4 AV = CK_MFMA(aakA, mk8(vtf, Z2), z4);
        const f32x4 W2 = CK_MFMA(mplain, pk8z(AV), z4);
        const f32x4 Y3 = CK_MFMA(arbk, mk8(pk4(W2), vtf), z4);
        f32x4* C2 = (f32x4*)(wks + 4608 + vt * 2048);
        C2[lane] = W2; C2[64 + lane] = Y3;
    }
}
template <int TYPE>
__device__ __forceinline__ void seq_wave(const char* pc, const char* wks, float* sYc, int vt, int lane, f32x4 (&Sreg)[4]) {
    const int row16 = lane & 15, q = lane >> 4;
    const bf16_t* W1row = (const bf16_t*)wks; const bf16_t* R2row = (const bf16_t*)(wks + 2304); const f32x4* C2 = (const f32x4*)(wks + 4608 + vt * 2048);
    const bf16_t* GBT = (const bf16_t*)(pc + 11264); const bf16_t* GKT = (const bf16_t*)(pc + (TYPE == 0 ? 13312 : 11264)); const bf16_t* VST = (const bf16_t*)(pc + 16384);
    const float* gc = (const float*)(pc + 17408); const float* pC = (const float*)(pc + 17664);
    f32x4 U = C2[lane], Y = C2[64 + lane];
#pragma unroll
    for (int ks = 0; ks < 2; ++ks) {
        const bf16x8 sf = mk8(pk4(Sreg[2 * ks]), pk4(Sreg[2 * ks + 1]));
        const bf16x8 a1 = mk8(*(const u32x2*)(W1row + row16 * 72 + 32 * ks + 4 * q), *(const u32x2*)(W1row + row16 * 72 + 32 * ks + 16 + 4 * q));
        const bf16x8 a2 = mk8(*(const u32x2*)(R2row + row16 * 72 + 32 * ks + 4 * q), *(const u32x2*)(R2row + row16 * 72 + 32 * ks + 16 + 4 * q));
        U = CK_MFMA(a1, sf, U);
        Y = CK_MFMA(a2, sf, Y);
    }
#pragma unroll
    for (int r = 0; r < 4; ++r) sYc[(4 * q + r) * 32 + 16 * vt + row16] = Y[r];
    if (TYPE == 1) U = U * *(const f32x4*)(gc + 48 + 4 * q);
    const bf16x8 ub = mk8(pk4(U), *(const u32x2*)(VST + krow(16 * vt + row16) * 16 + 4 * q));
#pragma unroll
    for (int kt = 0; kt < 4; ++kt) {
        const bf16x8 ak = mk8(*(const u32x2*)(GBT + krow(16 * kt + row16) * 16 + 4 * q), *(const u32x2*)(GKT + krow(16 * kt + row16) * 16 + 4 * q));
        const f32x4 pc4 = *(const f32x4*)(pC + 16 * kt + 4 * q);
        if (TYPE == 0) Sreg[kt] = CK_MFMA(ak, ub, Sreg[kt]) * pc4;
        else Sreg[kt] = CK_MFMA(ak, ub, Sreg[kt] * pc4);
    }
}
template <int TYPE, class F>
__device__ __forceinline__ void seq_role(char* cb, int vt, int lane, F&& extra) {
    f32x4 Sreg[4];
#pragma unroll
    for (int i = 0; i < 4; ++i) Sreg[i] = (f32x4){0.f, 0.f, 0.f, 0.f};
    extra(0); lbar(); extra(1); lbar();
    for (int k = 0; k <= NCH; ++k) {
        if (k > 0) {
            const int kb = k - 1;
            seq_wave<TYPE>(cb + (kb & 1) * PCB_BYTES, cb + WKS0 + ((kb & 1) * 2 + 0) * WKS_BYTES, (float*)(cb + SY0 + (kb & 1) * 4096), vt, lane, Sreg);
            seq_wave<TYPE>(cb + (kb & 1) * PCB_BYTES + PC_STRIDE, cb + WKS0 + ((kb & 1) * 2 + 1) * WKS_BYTES, (float*)(cb + SY0 + (kb & 1) * 4096) + 16 * 32, vt, lane, Sreg);
        }
        lbar();
        extra(k + 2);
        lbar();
    }
}
template <int TYPE>
__device__ __forceinline__ void prep_role(char* cb, int c, int lane) {
    lbar(); lbar();
    for (int k = 0; k <= NCH; ++k) {
        if (k < NCH) prep_wave<TYPE, true>(cb + (k & 1) * PCB_BYTES + c * PC_STRIDE, cb + WKP0 + c * WKP_BYTES, cb + WKS0 + ((k & 1) * 2 + c) * WKS_BYTES, lane);
        else lbar();
        lbar();
    }
}
__device__ __forceinline__ float red8(float x) { x += dppf<0xB1>(x); x += dppf<0x4E>(x); x += dppf<0x141>(x); return x; }
__device__ __forceinline__ void st8T(bf16_t* base, int row0, int t, u32x4 v) {
    const int r = row0 >> 3;
    base[(row0 + 0 + ((0 + r) & 3)) * 16 + t] = (bf16_t)v.x; base[(row0 + 0 + ((1 + r) & 3)) * 16 + t] = (bf16_t)(v.x >> 16); base[(row0 + 0 + ((2 + r) & 3)) * 16 + t] = (bf16_t)v.y; base[(row0 + 0 + ((3 + r) & 3)) * 16 + t] = (bf16_t)(v.y >> 16);
    base[(row0 + 4 + ((0 + r) & 3)) * 16 + t] = (bf16_t)v.z; base[(row0 + 4 + ((1 + r) & 3)) * 16 + t] = (bf16_t)(v.z >> 16); base[(row0 + 4 + ((2 + r) & 3)) * 16 + t] = (bf16_t)v.w; base[(row0 + 4 + ((3 + r) & 3)) * 16 + t] = (bf16_t)(v.w >> 16);
}
__device__ __forceinline__ u32x4 pk8(const f32x4& a, const f32x4& b) { u32x4 r; r.x = pk2(a[0], a[1]); r.y = pk2(a[2], a[3]); r.z = pk2(b[0], b[1]); r.w = pk2(b[2], b[3]); return r; }
__device__ __forceinline__ void unpk8(u32x4 v, f32x4& a, f32x4& b) { a = (f32x4){bflo(v.x), bfhi(v.x), bflo(v.y), bfhi(v.y)}; b = (f32x4){bflo(v.z), bfhi(v.z), bflo(v.w), bfhi(v.w)}; }
}

__device__ __forceinline__ void rwkv_job(const PP& p, int l, int job, float* sm) {
    char* cb = (char*)sm;
    float* sW = (float*)(cb + ck::SW0); float* sAA = (float*)(cb + ck::SAA0); float* cst = (float*)(cb + ck::CST0);
    const int half = job & 1, dir = (job >> 1) & 1, bh = job >> 2, b = bh / 6, h = bh - b * 6;
    const int tid = tid_of(p.wv), w = tid >> 6, lane = tid & 63;
    const bf16_t* Z = (const bf16_t*)(p.ws + OFF_Z); const bf16_t* RWP = (const bf16_t*)(p.ws + OFF_H);
    bf16_t* Y = (bf16_t*)(p.ws + OFF_YO) + (size_t)dir * MROWS * 384;
    float* BC = (float*)(p.ws + OFF_BC) + (size_t)dir * MROWS * 6;
    if (tid < 64) { cst[tid] = p.in[I_KK][l * 384 + h * 64 + tid]; cst[64 + tid] = p.in[I_KA][l * 384 + h * 64 + tid]; cst[128 + tid] = p.in[I_RK][l * 384 + h * 64 + tid];
        cst[192 + tid] = p.in[I_MU][l * 1408 + 768 + h * 64 + tid];
        cst[256 + tid] = p.in[I_W0][((size_t)l * 2 + dir) * 384 + h * 64 + tid]; cst[320 + tid] = p.in[I_A0][((size_t)l * 2 + dir) * 384 + h * 64 + tid]; }
    lbar();
    if (w < 2) ck::prep_role<0>(cb, w, lane);
    else if (w == 4 || w == 5) {
        const int mt = w - 4, fr = lane & 15, fq = lane >> 4;
        bf16x8 wfw[4][2], wfa[4][2];
#pragma unroll
        for (int nt = 0; nt < 4; ++nt) {
            const bf16_t* wu = (const bf16_t*)(p.ws + OFF_WUP) + ((size_t)dir * 384 + h * 64 + nt * 16 + fr) * 64 + fq * 8;
            const bf16_t* au = (const bf16_t*)(p.ws + OFF_AUP) + ((size_t)dir * 384 + h * 64 + nt * 16 + fr) * 64 + fq * 8;
            wfw[nt][0] = *(const bf16x8*)wu; wfw[nt][1] = *(const bf16x8*)(wu + 32); wfa[nt][0] = *(const bf16x8*)au; wfa[nt][1] = *(const bf16x8*)(au + 32);
        }
        bf16x8 xw[2], xa[2];
        auto loadm = [&](int blk) {
            if (blk < NCH) {
                const int jm = seqpos(dir, blk * 32 + mt * 16 + fr);
                const bf16_t* mp = RWP + (size_t)(b * TT + jm) * RWP_LD + 768 + fq * 8;
                xw[0] = *(const bf16x8*)mp; xw[1] = *(const bf16x8*)(mp + 32); xa[0] = *(const bf16x8*)(mp + 64); xa[1] = *(const bf16x8*)(mp + 96);
            }
        };
        loadm(0);
        auto lora = [&](int blk) {
            if (blk >= NCH) return;
            float* sWb = sW + (blk & 1) * ck::SWBUF; float* sAb = sAA + (blk & 1) * ck::SWBUF;
#pragma unroll
            for (int nt = 0; nt < 4; ++nt) {
                f32x4 aw = (f32x4){0.f, 0.f, 0.f, 0.f}, aa = aw;
#pragma unroll
                for (int ks = 0; ks < 2; ++ks) { aw = CK_MFMA(xw[ks], wfw[nt][ks], aw); aa = CK_MFMA(xa[ks], wfa[nt][ks], aa); }
                const float w0s = cst[256 + nt * 16 + fr], a0s = cst[320 + nt * 16 + fr];
                f32x4 G = (f32x4){0.f, 0.f, 0.f, 0.f};
#pragma unroll
                for (int i = 0; i < 4; ++i) {
                    const float lw = -0.6065306597126334f * sigmoidf_(aw[i] + w0s);
                    G = __builtin_amdgcn_mfma_f32_16x16x4f32((4 * fq + i <= fr) ? 1.f : 0.f, lw, G, 0, 0, 0);
                }
#pragma unroll
                for (int i = 0; i < 4; ++i) {
                    sWb[(mt * 16 + 4 * fq + i) * ck::SWLD + nt * 16 + fr] = G[i];
                    sAb[(mt * 16 + 4 * fq + i) * ck::SWLD + nt * 16 + fr] = sigmoidf_(aa[i] + a0s);
                }
            }
            loadm(blk + 1);
        };
        ck::seq_role<0>(cb, w - 4, lane, lora);
    }

    else {
        const int ew = (w & 1) + ((w >> 2) << 1);
        const int stid = ew * 64 + lane, es = stid >> 3, c8 = stid & 7, ec = h * 64 + 8 * c8, c = es >> 4, t = es & 15;
        struct PF { u32x4 r, k, vp, vc, vn; int row; };
        PF setA, setB;
        const float* sW_ = sW; const float* sAA_ = sAA;
        auto prefetch = [&](PF& s, int blk) {
            if (blk < NCH) {
                const int j = seqpos(dir, blk * 32 + es);
                const bool hp = (j != 0) && (j != CTX), hn = (j != CTX - 1) && (j != TT - 1);
                s.row = b * TT + j;
                const bf16_t* rp = RWP + (size_t)s.row * RWP_LD;
                s.r = *(const u32x4*)(rp + ec); s.k = *(const u32x4*)(rp + 384 + ec);
                const bf16_t* zp = Z + (size_t)s.row * ZLD + 768 + ec;
                s.vc = *(const u32x4*)zp; s.vp = hp ? *(const u32x4*)(zp - ZLD) : (u32x4){0u, 0u, 0u, 0u}; s.vn = hn ? *(const u32x4*)(zp + ZLD) : (u32x4){0u, 0u, 0u, 0u};
            }
        };
        auto flush = [&](int blk) {
            const float* sYb = (const float*)(cb + ck::SY0 + (blk & 1) * 4096);
            const int s = stid >> 3, v4 = (stid & 7) * 4, j = seqpos(dir, blk * 32 + s);
            *(u32x2*)(Y + (size_t)(b * TT + j) * 384 + h * 64 + half * 32 + v4) = pk4(*(const f32x4*)(sYb + s * 32 + v4));
        };
        auto stage = [&](int blk, PF& ps) {
            f32x4 r0, r1, k0, k1, v0, v1;
            ck::unpk8(ps.r, r0, r1); ck::unpk8(ps.k, k0, k1);
            {
                f32x4 a0, a1, c0, c1, n0, n1; ck::unpk8(ps.vp, a0, a1); ck::unpk8(ps.vc, c0, c1); ck::unpk8(ps.vn, n0, n1);
                const f32x4 m0 = *(const f32x4*)(cst + 192 + 8 * c8), m1 = *(const f32x4*)(cst + 196 + 8 * c8);
                v0 = c0 + ((a0 + n0) * 0.5f - c0) * m0; v1 = c1 + ((a1 + n1) * 0.5f - c1) * m1;
            }
            const int myrow = ps.row;
            u32x4 ga, gr, gb, gk, vb; f32x4 x0, x1; float bon;
            auto comp = [&]() {
                const float* sW = sW_ + (blk & 1) * ck::SWBUF; const float* sAA = sAA_ + (blk & 1) * ck::SWBUF;
                const f32x4 a40 = *(const f32x4*)(sAA + es * ck::SWLD + 8 * c8), a41 = *(const f32x4*)(sAA + es * ck::SWLD + 8 * c8 + 4);
                const f32x4 kd0 = k0 * ((a40 - 1.f) * *(const f32x4*)(cst + 64 + 8 * c8) + 1.f), kd1 = k1 * ((a41 - 1.f) * *(const f32x4*)(cst + 68 + 8 * c8) + 1.f);
                const f32x4 kk0 = k0 * *(const f32x4*)(cst + 8 * c8), kk1 = k1 * *(const f32x4*)(cst + 4 + 8 * c8);
                const float ssq = ck::red8(kk0[0] * kk0[0] + kk0[1] * kk0[1] + kk0[2] * kk0[2] + kk0[3] * kk0[3] + kk1[0] * kk1[0] + kk1[1] * kk1[1] + kk1[2] * kk1[2] + kk1[3] * kk1[3]);
                const float rn = __builtin_amdgcn_rsqf(ssq + 1e-6f);
                const f32x4 kn0 = kk0 * rn, kn1 = kk1 * rn;
                const f32x4 tb0 = r0 * kd0 * *(const f32x4*)(cst + 128 + 8 * c8), tb1 = r1 * kd1 * *(const f32x4*)(cst + 132 + 8 * c8);
                bon = ck::red8(tb0[0] + tb0[1] + tb0[2] + tb0[3] + tb1[0] + tb1[1] + tb1[2] + tb1[3]);
                const f32x4 G0 = *(const f32x4*)(sW + es * ck::SWLD + 8 * c8), G1 = *(const f32x4*)(sW + es * ck::SWLD + 8 * c8 + 4);
                const f32x4 T0 = *(const f32x4*)(sW + (16 * c + 15) * ck::SWLD + 8 * c8), T1 = *(const f32x4*)(sW + (16 * c + 15) * ck::SWLD + 8 * c8 + 4);
                f32x4 L0 = (f32x4){0.f, 0.f, 0.f, 0.f}, L1 = L0;
                if (t > 0) { L0 = *(const f32x4*)(sW + (es - 1) * ck::SWLD + 8 * c8); L1 = *(const f32x4*)(sW + (es - 1) * ck::SWLD + 8 * c8 + 4); }
                f32x4 P0, P1, Q0, Q1, I0, I1;
#pragma unroll
                for (int e = 0; e < 4; ++e) { P0[e] = __expf(G0[e]); P1[e] = __expf(G1[e]); Q0[e] = __expf(L0[e]); Q1[e] = __expf(L1[e]); I0[e] = __expf(-G0[e]); I1[e] = __expf(-G1[e]); x0[e] = __expf(T0[e]); x1[e] = __expf(T1[e]); }
                ga = ck::pk8(-kn0 * Q0, -kn1 * Q1); gb = ck::pk8(kn0 * a40 * I0, kn1 * a41 * I1); gk = ck::pk8(kd0 * I0, kd1 * I1); gr = ck::pk8(r0 * P0, r1 * P1);
                vb = ck::pk8(v0, v1);
            };
            if (blk > 0) comp();
            lbar();
            if (blk == 0) comp();
            prefetch(ps, blk + 2);
            if (blk > 1) flush(blk - 2);
            char* pc = cb + (blk & 1) * ck::PCB_BYTES + c * ck::PC_STRIDE;
            if (c8 == 0 && half == 0) BC[(size_t)myrow * 6 + h] = bon;
            *(u32x4*)(pc + (t * 72 + 8 * c8) * 2) = ga;
            *(u32x4*)(pc + 2304 + (t * 72 + 8 * c8) * 2) = gr;
            *(u32x4*)(pc + 4608 + (t * 72 + 8 * c8) * 2) = gb;
            *(u32x4*)(pc + 6912 + (t * 72 + 8 * c8) * 2) = gk;
            ck::st8T((bf16_t*)(pc + 9216), 8 * c8, t, ga); ck::st8T((bf16_t*)(pc + 11264), 8 * c8, t, gb); ck::st8T((bf16_t*)(pc + 13312), 8 * c8, t, gk);
            if (t == 15) { *(f32x4*)(pc + 17664 + 32 * c8) = x0; *(f32x4*)(pc + 17664 + 32 * c8 + 16) = x1; }
            if ((c8 >> 2) == half) { ck::st8T((bf16_t*)(pc + 15360), 8 * c8 - 32 * half, t, vb); ck::st8T((bf16_t*)(pc + 16384), 8 * c8 - 32 * half, t, vb); }
            lbar();
        };
        prefetch(setA, 0); prefetch(setB, 1);
        stage(0, setA);
        for (int k = 0; k < NCH; k += 2) {
            if (k + 1 < NCH) stage(k + 1, setB); else { lbar(); lbar(); }
            if (k + 2 < NCH) stage(k + 2, setA); else { lbar(); lbar(); }
        }
        lbar(); lbar();
        flush(NCH - 2); flush(NCH - 1);
    }
}

__device__ __forceinline__ void gdn_job(const PP& p, int l, int job, float* sm) {
    char* cb = (char*)sm;
    float* sSC = (float*)(cb + ck::SW0);
    float* cst = (float*)(cb + ck::CST0);
    const int half = job & 1, dir = (job >> 1) & 1, bh = job >> 2, b = bh / 6, h = bh - b * 6;
    const int tid = tid_of(p.wv), w = tid >> 6, lane = tid & 63;
    const bf16_t* Z = (const bf16_t*)(p.ws + OFF_Z);
    bf16_t* Y = (bf16_t*)(p.ws + OFF_YO) + (size_t)(2 + dir) * MROWS * 384;
    for (int i = tid; i < 576; i += 512) { const int a = i >> 6, cc = i & 63; cst[i] = p.in[I_CONV][(size_t)l * 3 * 1152 + (a / 3) * 1152 + (a % 3) * 384 + h * 64 + cc]; }
    lbar();
    if (w < 2) ck::prep_role<1>(cb, w, lane);
    else if (w == 2 || w == 3) ck::seq_role<1>(cb, w - 2, lane, [](int) {});
    else {
        const int ew = w - 4;
        const int stid = ew * 64 + lane, es = stid >> 3, c8 = stid & 7, ec = h * 64 + 8 * c8, c = es >> 4, t = es & 15;
        const float aexp = __expf(p.in[I_ALOG][((size_t)l * 2 + dir) * 6 + h]), dtb = p.in[I_DTB][((size_t)l * 2 + dir) * 6 + h];
        struct PF { u32x4 x[3][3]; bf16_t be, ai; };
        PF setA, setB;
        auto prefetch = [&](PF& s, int blk) {
            if (blk < NCH) {
                const int j = seqpos(dir, blk * 32 + es);
                const bool hp = (j != 0) && (j != CTX), hn = (j != CTX - 1) && (j != TT - 1);
                const bf16_t* zp = Z + (size_t)(b * TT + j) * ZLD + 1408 + ec;
#pragma unroll
                for (int a = 0; a < 3; ++a) {
                    s.x[a][1] = *(const u32x4*)(zp + a * 384);
                    s.x[a][0] = hp ? *(const u32x4*)(zp + a * 384 - ZLD) : (u32x4){0u, 0u, 0u, 0u};
                    s.x[a][2] = hn ? *(const u32x4*)(zp + a * 384 + ZLD) : (u32x4){0u, 0u, 0u, 0u};
                }
                s.be = zp[1152 - ec + dir * 6 + h]; s.ai = zp[1164 - ec + dir * 6 + h];
            }
        };
        auto flush = [&](int blk) {
            const float* sYb = (const float*)(cb + ck::SY0 + (blk & 1) * 4096);
            const int s = stid >> 3, v4 = (stid & 7) * 4, j = seqpos(dir, blk * 32 + s);
            *(u32x2*)(Y + (size_t)(b * TT + j) * 384 + h * 64 + half * 32 + v4) = pk4(*(const f32x4*)(sYb + s * 32 + v4));
        };
        auto stage = [&](int blk, PF& ps) {
            f32x4 o[3][2];
#pragma unroll
            for (int a = 0; a < 3; ++a) {
                f32x4 p0, p1, c0, c1, n0, n1; ck::unpk8(ps.x[a][0], p0, p1); ck::unpk8(ps.x[a][1], c0, c1); ck::unpk8(ps.x[a][2], n0, n1);
                o[a][0] = p0 * *(const f32x4*)(cst + (0 * 3 + a) * 64 + 8 * c8) + c0 * *(const f32x4*)(cst + (1 * 3 + a) * 64 + 8 * c8) + n0 * *(const f32x4*)(cst + (2 * 3 + a) * 64 + 8 * c8);
                o[a][1] = p1 * *(const f32x4*)(cst + (0 * 3 + a) * 64 + 8 * c8 + 4) + c1 * *(const f32x4*)(cst + (1 * 3 + a) * 64 + 8 * c8 + 4) + n1 * *(const f32x4*)(cst + (2 * 3 + a) * 64 + 8 * c8 + 4);
#pragma unroll
                for (int e = 0; e < 4; ++e) { o[a][0][e] = siluf_(o[a][0][e]); o[a][1][e] = siluf_(o[a][1][e]); }
            }
            float sq = 0.f, sk = 0.f;
#pragma unroll
            for (int e = 0; e < 4; ++e) { sq += o[0][0][e] * o[0][0][e] + o[0][1][e] * o[0][1][e]; sk += o[1][0][e] * o[1][0][e] + o[1][1][e] * o[1][1][e]; }
            sq = ck::red8(sq); sk = ck::red8(sk);
            const float qn = __builtin_amdgcn_rsqf(sq + 1e-6f) * 0.125f, kn = __builtin_amdgcn_rsqf(sk + 1e-6f);
            const f32x4 q0 = o[0][0] * qn, q1 = o[0][1] * qn, k0 = o[1][0] * kn, k1 = o[1][1] * kn;
            const float beta = sigmoidf_(bf2f(ps.be));
            const float xg = bf2f(ps.ai) + dtb; const float gl = -aexp * (xg > 20.f ? xg : __logf(1.f + __expf(xg)));
            if (c8 == 0) { sSC[es * 4] = beta; sSC[es * 4 + 1] = gl; }
            lbar();
            prefetch(ps, blk + 2);
            if (blk > 1) flush(blk - 2);
            char* pc = cb + (blk & 1) * ck::PCB_BYTES + c * ck::PC_STRIDE;
            float g = 0.f, gm1 = 0.f, gt = 0.f;
#pragma unroll
            for (int i = 0; i < 16; ++i) { const float lg = sSC[(16 * c + i) * 4 + 1]; gt += lg; if (i <= t) g += lg; if (i < t) gm1 += lg; }
            const float ac = -__expf(gl) * beta;
            const u32x4 ga = ck::pk8(k0 * ac, k1 * ac), kb = ck::pk8(k0, k1);
            *(u32x4*)(pc + (t * 72 + 8 * c8) * 2) = ga;
            *(u32x4*)(pc + 2304 + (t * 72 + 8 * c8) * 2) = ck::pk8(q0, q1);
            *(u32x4*)(pc + 4608 + (t * 72 + 8 * c8) * 2) = kb;
            ck::st8T((bf16_t*)(pc + 9216), 8 * c8, t, ga); ck::st8T((bf16_t*)(pc + 11264), 8 * c8, t, kb);
            const float us = __expf(gt - g);
            if (t == 15) { const float pv = __expf(gt); const f32x4 pv4 = (f32x4){pv, pv, pv, pv}; *(f32x4*)(pc + 17664 + 32 * c8) = pv4; *(f32x4*)(pc + 17664 + 32 * c8 + 16) = pv4; }
            if (c8 == 0) { float* sc4 = (float*)(pc + 17408); sc4[t] = g; sc4[16 + t] = __expf(g); sc4[32 + t] = __expf(gm1); sc4[48 + t] = us; }
            if ((c8 >> 2) == half) {
                const f32x4 v0 = o[2][0] * beta, v1 = o[2][1] * beta;
                ck::st8T((bf16_t*)(pc + 15360), 8 * c8 - 32 * half, t, ck::pk8(v0, v1)); ck::st8T((bf16_t*)(pc + 16384), 8 * c8 - 32 * half, t, ck::pk8(v0 * us, v1 * us));
            }
            lbar();
        };
        prefetch(setA, 0); prefetch(setB, 1);
        stage(0, setA);
        for (int k = 0; k < NCH; k += 2) {
            if (k + 1 < NCH) stage(k + 1, setB); else { lbar(); lbar(); }
            if (k + 2 < NCH) stage(k + 2, setA); else { lbar(); lbar(); }
        }
        lbar(); lbar();
        flush(NCH - 2); flush(NCH - 1);
    }
}

__device__ __forceinline__ void s5_job(const PP& p, int it, LAS uchar* lds) {
    const int g = it >> 1, dir = it & 1, tid = tid_of(p.wv), w = tid >> 6, q = tid & 63;
    bf16_t* A2 = (bf16_t*)(p.ws + OFF_A2) + (size_t)it * GROWS * 640;
    if (w < 4) {
        const float* HL = (const float*)(p.ws + OFF_HL) + (size_t)g * GROWS * 256 + dir * 128 + 2 * q;
        const float* DP = (const float*)(p.ws + OFF_DP) + (it * 64 + q) * 2;
        const float dr = DP[0], di = DP[1]; float hr = 0.f, hi = 0.f;
        for (int i0 = 0; i0 < NCH; i0 += 8) {
            f32x2 hl[8]; int Rr[8];
#pragma unroll
            for (int e = 0; e < 8; ++e) { const int i = i0 + e; const int c = dir == 0 ? i : (i < 8 ? 7 - i : NCH - 1 - (i - 8)); Rr[e] = w * NCH + c; hl[e] = *(const f32x2*)(HL + (size_t)Rr[e] * 256); }
#pragma unroll
            for (int e = 0; e < 8; ++e) {
                *(unsigned*)(A2 + (size_t)Rr[e] * 640 + 512 + 2 * q) = pk2(hr, hi);
                const float nr = dr * hr - di * hi + hl[e].x, ni = dr * hi + di * hr + hl[e].y; hr = nr; hi = ni;
            }
        }
    }
    __builtin_amdgcn_fence(__ATOMIC_RELEASE, "agent");
    asm volatile("s_waitcnt vmcnt(0)" ::: "memory");
    __syncthreads();
    __builtin_amdgcn_fence(__ATOMIC_ACQUIRE, "agent");
    asm volatile("s_waitcnt vmcnt(0)" ::: "memory");
    __syncthreads();
    pg8::Gemm gm; gm.A = (const bf16_t*)(p.ws + OFF_A2); gm.Bt = (const bf16_t*)(p.ws + OFF_TF); gm.K = 640; gm.lda = 640; gm.ldb = 640;
    pg8::Sched S; S.mode = 1; S.nM = 5; S.nN = 2; S.nwg = (it + 1) * 10; S.G = 1; S.c = it * 10;
    S.gA = (size_t)GROWS * 640 * 2; S.gB = (size_t)512 * 640 * 2; S.tA = (size_t)256 * 640 * 2; S.tB = (size_t)256 * 640 * 2;
    EpiY5 E; E.Y5 = (bf16_t*)(p.ws + OFF_Y5);
    pg8::gemm_phase(lds, gm, S, E, p.wv);
}


constexpr int GRW_SPLIT = 27000;
__device__ __forceinline__ bf16_t* grw_row(char* ws, int row) {
    return row < GRW_SPLIT ? (bf16_t*)(ws + OFF_TF) + (size_t)row * 384 : (bf16_t*)(ws + OFF_HL) + (size_t)(row - GRW_SPLIT) * 384;
}
__device__ __forceinline__ void phase_gaterw(const PP& p, int l, int gw, int nw) {
    int lane = lane_id(); asm volatile("" : "+v"(lane));
    const int fr = lane & 15, fq = lane >> 4;
    const bf16_t* Z = (const bf16_t*)(p.ws + OFF_Z); const bf16_t* GUP = (const bf16_t*)(p.ws + OFF_GUP);
    const float* mu = p.in[I_MU] + l * 1408;
    for (int item = gw; item < MROWS / 16; item += nw) {
        const int row = item * 16 + fr, b = row / TT, j = row - b * TT;
        const bool hp = (j != 0) && (j != CTX), hn = (j != CTX - 1) && (j != TT - 1);
        bf16x8 gfrag[4];
#pragma unroll
        for (int ks = 0; ks < 4; ++ks) {
            const int c0 = 1280 + ks * 32 + fq * 8;
            const Nb3 a = ld3(Z, row, hp, hn, c0), bq = ld3(Z, row, hp, hn, c0 + 4);
            f32x4 x0 = shiftmix(a, mu + c0), x1 = shiftmix(bq, mu + c0 + 4);
#pragma unroll
            for (int i = 0; i < 4; ++i) { x0[i] = sigmoidf_(x0[i]); x1[i] = sigmoidf_(x1[i]); }
            const u32x2 lo = pk4(x0), hi2 = pk4(x1); u32x4 t; t.x = lo.x; t.y = lo.y; t.z = hi2.x; t.w = hi2.y; gfrag[ks] = __builtin_bit_cast(bf16x8, t);
        }
        bf16_t* gr = grw_row(p.ws, row);
#pragma unroll 4
        for (int n24 = 0; n24 < 24; ++n24) {
            f32x4 ga = (f32x4){0.f, 0.f, 0.f, 0.f};
            const bf16_t* wp = GUP + (size_t)(n24 * 16 + fr) * 128 + fq * 8;
#pragma unroll
            for (int ks = 0; ks < 4; ++ks) ga = __builtin_amdgcn_mfma_f32_16x16x32_bf16(*(const bf16x8*)(wp + ks * 32), gfrag[ks], ga, 0, 0, 0);
            *(u32x2*)(gr + n24 * 16 + fq * 4) = pk4(ga);
        }
    }
}
__device__ __forceinline__ void phase_s5post(const PP& p, int l, int gw, int nw) {
    int lane = lane_id(); asm volatile("" : "+v"(lane));
    const int fr = lane & 15, fq = lane >> 4;
    const bf16_t* A2 = (const bf16_t*)(p.ws + OFF_A2); const bf16_t* Y5 = (const bf16_t*)(p.ws + OFF_Y5); bf16_t* Y5w = (bf16_t*)(p.ws + OFF_Y5);
    const bf16_t* GLU = (const bf16_t*)(p.ws + OFF_GLU);
    for (int item = gw; item < MROWS / 16; item += nw) {
        const int row = item * 16 + fr, b = row / TT, j = row - b * TT;
        {
            const int n = s5pos(j), R = b * NCH + (n >> 5), t = n & 31;
            const size_t GS5 = (size_t)GROWS * 512;
            bf16x8 yf[8];
#pragma unroll
            for (int ks = 0; ks < 8; ++ks) {
                const int ch = ks * 32 + fq * 8, g = ch >> 4, hh = ch & 15;
                const u32x4 y0 = *(const u32x4*)(Y5 + (size_t)(g * 2) * GS5 + (size_t)R * 512 + t * 16 + hh), y1 = *(const u32x4*)(Y5 + (size_t)(g * 2 + 1) * GS5 + (size_t)R * 512 + t * 16 + hh);
                const u32x4 uu = *(const u32x4*)(A2 + ((size_t)(g * 2) * GROWS + R) * 640 + t * 16 + hh);
                const float* dv = p.in[I_S5D] + l * 256 + ch;
                float v[8];
#pragma unroll
                for (int e = 0; e < 4; ++e) {
                    v[2 * e] = gelu_tanh(bflo(y0[e]) + bflo(y1[e]) + dv[2 * e] * bflo(uu[e]));
                    v[2 * e + 1] = gelu_tanh(bfhi(y0[e]) + bfhi(y1[e]) + dv[2 * e + 1] * bfhi(uu[e]));
                }
                u32x4 tq; tq.x = pk2(v[0], v[1]); tq.y = pk2(v[2], v[3]); tq.z = pk2(v[4], v[5]); tq.w = pk2(v[6], v[7]); yf[ks] = __builtin_bit_cast(bf16x8, tq);
                asm volatile("" ::: "memory");
            }
#pragma unroll 1
            for (int nt = 0; nt < 16; ++nt) {
                f32x4 a = (f32x4){0.f, 0.f, 0.f, 0.f};
                const bf16_t* wp = GLU + (size_t)(nt * 16 + fr) * 256 + fq * 8;
#pragma unroll
                for (int ks = 0; ks < 8; ++ks) a = __builtin_amdgcn_mfma_f32_16x16x32_bf16(*(const bf16x8*)(wp + ks * 32), yf[ks], a, 0, 0, 0);
                const int ch = nt * 16 + fq * 4, hh = ch & 15;
                const u32x2 y0 = *(const u32x2*)(Y5 + (size_t)(nt * 2) * GS5 + (size_t)R * 512 + t * 16 + hh), y1 = *(const u32x2*)(Y5 + (size_t)(nt * 2 + 1) * GS5 + (size_t)R * 512 + t * 16 + hh);
                const u32x2 uu = *(const u32x2*)(A2 + ((size_t)(nt * 2) * GROWS + R) * 640 + t * 16 + hh);
                const f32x4 dv = *(const f32x4*)(p.in[I_S5D] + l * 256 + ch), gb = *(const f32x4*)(p.in[I_GLUB] + l * 256 + ch);
                const f32x4 ys = unpk4(y0) + unpk4(y1) + dv * unpk4(uu);
                f32x4 o;
#pragma unroll
                for (int i = 0; i < 4; ++i) { const float yy = gelu_tanh(ys[i]); o[i] = yy * sigmoidf_(a[i] + gb[i]); }
                *(u32x2*)(Y5w + (size_t)(nt * 2) * GS5 + (size_t)R * 512 + t * 16 + hh) = pk4(o);
                asm volatile("" ::: "memory");
            }
        }
    }
}

__device__ __forceinline__ void phase_post(const PP& p, int l) {
    const int lane = tid_of(p.wv) & 63, gw = bidx() * 8 + (tid_of(p.wv) >> 6), nw = gridDim.x * 8, tk = lane >> 4, c4 = lane & 15;
    const bf16_t* Z = (const bf16_t*)(p.ws + OFF_Z);
    const bf16_t* YO = (const bf16_t*)(p.ws + OFF_YO);
    const float* BC = (const float*)(p.ws + OFF_BC);
    const bf16_t* Y5 = (const bf16_t*)(p.ws + OFF_Y5);
    bf16_t* MIX = (bf16_t*)(p.ws + OFF_H);
    const float* mu = p.in[I_MU] + l * 1408;
    const size_t YS = (size_t)MROWS * 384;
    for (int it3 = gw; it3 < 2 * (MROWS / 16); it3 += nw) {
      const int item = it3 >> 1, part = 1 + (((it3 / nw) + it3) & 1);
      if (part == 1) {
#pragma unroll 1
        for (int tg = 0; tg < 4; ++tg) {
            const int row = item * 16 + tg * 4 + tk, b = row / TT, j = row - b * TT;
            const bool hp = (j != 0) && (j != CTX), hn = (j != CTX - 1) && (j != TT - 1);
            const bf16_t* gr = grw_row(p.ws, row);
#pragma unroll 2
            for (int h = 0; h < 6; ++h) {
                const int c = h * 64 + 4 * c4;
                f32x4 y = unpk4(*(const u32x2*)(YO + (size_t)row * 384 + c)) + unpk4(*(const u32x2*)(YO + YS + (size_t)row * 384 + c));
                const float mean = red16(y[0] + y[1] + y[2] + y[3]) * (1.f / 64.f);
                y = y - mean;
                const float rstd = __builtin_amdgcn_rsqf(red16(y[0] * y[0] + y[1] * y[1] + y[2] * y[2] + y[3] * y[3]) * (1.f / 64.f) + 64e-5f);
                const float bon = BC[(size_t)row * 6 + h] + BC[(size_t)MROWS * 6 + (size_t)row * 6 + h];
                const f32x4 lg = *(const f32x4*)(p.in[I_LNG] + l * 384 + c), lb = *(const f32x4*)(p.in[I_LNB] + l * 384 + c);
                const f32x4 vs = shiftmix(ld3(Z, row, hp, hn, 768 + c), mu + 768 + c);
                const f32x4 ga = unpk4(*(const u32x2*)(gr + c));
                *(u32x2*)(MIX + (size_t)row * DM + c) = pk4((y * rstd * lg + lb + vs * bon) * ga);
            }
        }
      } else {
#pragma unroll 1
        for (int tg = 0; tg < 4; ++tg) {
            const int row = item * 16 + tg * 4 + tk, b = row / TT, j = row - b * TT;
            const f32x4 gn = *(const f32x4*)(p.in[I_GNG] + l * 64 + 4 * c4);
#pragma unroll 3
            for (int h = 0; h < 6; ++h) {
                const int c = h * 64 + 4 * c4;
                const f32x4 o = unpk4(*(const u32x2*)(YO + 2 * YS + (size_t)row * 384 + c)) + unpk4(*(const u32x2*)(YO + 3 * YS + (size_t)row * 384 + c));
                const float rs = __builtin_amdgcn_rsqf(red16(o[0] * o[0] + o[1] * o[1] + o[2] * o[2] + o[3] * o[3]) * (1.f / 64.f) + 1e-6f);
                f32x4 gt = unpk4(*(const u32x2*)(Z + (size_t)row * ZLD + 2584 + c));
#pragma unroll
                for (int i = 0; i < 4; ++i) gt[i] = siluf_(gt[i]);
                *(u32x2*)(MIX + (size_t)row * DM + 384 + c) = pk4(o * rs * gn * gt);
            }
            const int n = s5pos(j), R = b * NCH + (n >> 5), t = n & 31;
            const size_t GS5 = (size_t)GROWS * 512;
#pragma unroll
            for (int e = 0; e < 4; ++e) {
                const int ch = e * 64 + 4 * c4, nt = ch >> 4, hh = ch & 15;
                *(u32x2*)(MIX + (size_t)row * DM + 768 + ch) = *(const u32x2*)(Y5 + (size_t)(nt * 2) * GS5 + (size_t)R * 512 + t * 16 + hh);
            }
        }
      }
    }
}

__global__ void __launch_bounds__(512) fwd_mega(P kp) {
    extern __shared__ __attribute__((aligned(16))) uchar shm[];
    cg::grid_group grid = cg::this_grid();
    float* sm = (float*)shm;
    LAS uchar* lds = (LAS uchar*)shm;
    const int nblk = gridDim.x;
    if (threadIdx.x == 0) {
        unsigned long long* tab = (unsigned long long*)(shm + TAB_OFF);
#pragma unroll
        for (int i = 0; i < N_IN; ++i) tab[i] = (unsigned long long)kp.in[i];
        tab[N_IN] = (unsigned long long)kp.out; tab[N_IN + 1] = (unsigned long long)kp.ws;
    }
    if (threadIdx.x == 0) { volatile LAS unsigned* st0 = (volatile LAS unsigned*)(lds + TAB_OFF + 384); st0[0] = 0u; st0[1] = 0u; st0[2] = 0u; st0[3] = 0u; }
    __syncthreads();
    const PP p = mkp(__builtin_amdgcn_readfirstlane((int)(threadIdx.x >> 6)));
    const XcdBarrier xb = xcd_barrier_post((unsigned*)(p.ws + OFF_BAR), (volatile LAS unsigned*)(lds + TAB_OFF + 384), p.wv);

    phase_mod(p, sm);
    __syncthreads();
    phase_s5coef(p, 0, sm);
    phase_convw(p, 0, sm, 0, nblk - n_coef_blocks(), 0);
    {
        float* cr = (float*)(p.ws + OFF_CTXR);
        for (size_t i = (size_t)bidx() * 512 + tid_of(p.wv); i < (size_t)NB * CTX * DM / 4; i += (size_t)nblk * 512) ((f32x4*)cr)[i] = ((const f32x4*)p.in[I_CTX])[i];
    }
    grid.sync();

    for (int l = 0; l < DEPTH; ++l) {
        const float* xsrc = l == 0 ? p.in[I_X] : p.out;
        float* ctxr = (float*)(p.ws + OFF_CTXR);
        const float* modl = (const float*)(p.ws + OFF_MOD) + (size_t)l * 5 * 6144;
        phase_norm(p, l, 0, xsrc, ctxr, 0);
        xcd_barrier(xb);
        {
            pg8::Gemm gm; gm.A = (const bf16_t*)(p.ws + OFF_H); gm.Bt = (const bf16_t*)(p.ws + OFF_WIN); gm.K = 1024; gm.lda = 1024; gm.ldb = 1024;
            EpiZ E; E.Z = (bf16_t*)(p.ws + OFF_Z); E.A2 = (bf16_t*)(p.ws + OFF_A2);
            pg8::gemm_phase(lds, gm, sched_static(MROWS, 3328, 1024, 1024), E, p.wv);
        }
        xcd_barrier(xb);
        {
            pg8::Gemm gm; gm.A = (const bf16_t*)(p.ws + OFF_A2); gm.Bt = (const bf16_t*)(p.ws + OFF_E2); gm.K = 512; gm.lda = 640; gm.ldb = 512;
            pg8::Sched S; S.mode = 1; S.nM = 5; S.nN = 1; S.nwg = 80; S.G = nblk; S.c = bidx();
            S.gA = (size_t)2 * GROWS * 640 * 2; S.gB = (size_t)256 * 512 * 2; S.tA = (size_t)256 * 640 * 2; S.tB = 0;
            EpiHL E; E.HL = (float*)(p.ws + OFF_HL);
            pg8::gemm_phase(lds, gm, S, E, p.wv);
        }
        phase_rwprep(p, l);
        xcd_barrier(xb);
        for (int job = bidx(); job < 224; job += nblk) {
            if (job < 96) rwkv_job(p, l, job, sm);
            else if (job < 192) gdn_job(p, l, job - 96, sm);
            else {
                s5_job(p, job - 192, lds);
                asm volatile("s_waitcnt vmcnt(0)" ::: "memory");
                __syncthreads();
                if (tid_of(p.wv) == 0) { __builtin_amdgcn_fence(__ATOMIC_RELEASE, "agent"); asm volatile("s_waitcnt vmcnt(0)" ::: "memory");
                    __hip_atomic_fetch_add((unsigned*)(p.ws + OFF_BAR) + 3600 + l, 1u, __ATOMIC_RELAXED, __HIP_MEMORY_SCOPE_AGENT); }
            }
            __syncthreads();
        }
        const bool s5_helpers = nblk >= 224;
        const int hb0 = s5_helpers ? 192 : 0;
        if (bidx() >= hb0) {
            const int tid = tid_of(p.wv);
            if (tid == 0) {
                while (__hip_atomic_load((unsigned*)(p.ws + OFF_BAR) + 3600 + l, __ATOMIC_RELAXED, __HIP_MEMORY_SCOPE_AGENT) < 32u) __builtin_amdgcn_s_sleep(8);
                __builtin_amdgcn_fence(__ATOMIC_ACQUIRE, "agent");
                asm volatile("s_waitcnt vmcnt(0)" ::: "memory");
            }
            __syncthreads();
            phase_s5post(p, l, (bidx() - hb0) * 8 + (tid >> 6), (nblk - hb0) * 8);
            phase_gaterw(p, l, (bidx() - hb0) * 8 + (tid >> 6), (nblk - hb0) * 8);
            __syncthreads();
            phase_convw(p, l, sm, hb0, nblk - hb0, 1);
        }
        xcd_barrier(xb);
        phase_post(p, l);
        xcd_barrier(xb);
        {
            pg8::Gemm gm; gm.A = (const bf16_t*)(p.ws + OFF_H); gm.Bt = (const bf16_t*)(p.ws + OFF_WOUT); gm.K = 1024; gm.lda = 1024; gm.ldb = 1024;
            EpiResid E; E.xin = xsrc; E.xout = p.out; E.cin = l == 0 ? p.in[I_CTX] : ctxr; E.cout = ctxr; E.mod = modl; E.gidx = 2;
            pg8::gemm_phase(lds, gm, sched_static(MROWS, 1024, 1024, 1024), E, p.wv);
        }
        xcd_barrier(xb);
        phase_norm(p, l, 1, p.out, ctxr, 0);
        xcd_barrier(xb);
        {
            pg8::Gemm gm; gm.A = (const bf16_t*)(p.ws + OFF_H); gm.Bt = (const bf16_t*)(p.ws + OFF_WGU); gm.K = 1024; gm.lda = 1024; gm.ldb = 1024;
            EpiSwiGLU E; E.HID = (bf16_t*)(p.ws + OFF_Z);
            pg8::gemm_phase(lds, gm, sched_static(MROWS, 5632, 1024, 1024), E, p.wv);
        }
        xcd_barrier(xb);
        {
            pg8::Gemm gm; gm.A = (const bf16_t*)(p.ws + OFF_Z); gm.Bt = (const bf16_t*)(p.ws + OFF_WDN); gm.K = FFN; gm.lda = FFN; gm.ldb = FFN;
            EpiResid E; E.xin = p.out; E.xout = p.out; E.cin = ctxr; E.cout = ctxr; E.mod = modl; E.gidx = 5;
            pg8::gemm_phase(lds, gm, sched_static(MROWS, 1024, FFN, FFN), E, p.wv);
        }
        if (l + 1 < DEPTH) {
            const int nx = (528 % nblk);
            __syncthreads();
            phase_s5coef(p, l + 1, sm);
            const int ncb = n_coef_blocks();
            const bool wide = nblk - nx - ncb >= 64;
            phase_convw(p, l + 1, sm, wide ? nx : 0, wide ? nblk - nx - ncb : nblk, 0);
        }
        xcd_barrier(xb);
    }
    phase_final(p);
}

extern "C" void kernel_launch(void* const* d_in, const int* in_sizes, int n_in, void* d_out, int out_size, void* d_ws, size_t ws_size, hipStream_t stream) {
    static int grid_blocks = 0;
    if (!grid_blocks) {
        int dev = 0, cus = 0, per_cu = 0;
        hipGetDevice(&dev);
        hipDeviceGetAttribute(&cus, hipDeviceAttributeMultiprocessorCount, dev);
        if (hipFuncSetAttribute((const void*)fwd_mega, hipFuncAttributeMaxDynamicSharedMemorySize, LDS_TOTAL) != hipSuccess) fprintf(stderr, "hipFuncSetAttribute failed\n");
        hipOccupancyMaxActiveBlocksPerMultiprocessor(&per_cu, (const void*)fwd_mega, 512, LDS_TOTAL);
        if (per_cu < 1) per_cu = 1;
        if (per_cu > 1) per_cu = 1;
        grid_blocks = cus * per_cu;
    }
    if (ws_size < WS_NEED) fprintf(stderr, "workspace too small: %zu < %zu\n", ws_size, (size_t)WS_NEED);
    P p{};
    for (int i = 0; i < N_IN; ++i) p.in[i] = (const float*)d_in[i];
    p.out = (float*)d_out; p.ws = (char*)d_ws;
    (void)hipMemsetAsync((char*)d_ws + OFF_BAR, 0, 16384, stream);
    void* args[] = {&p};
    hipError_t e = hipLaunchCooperativeKernel((void*)fwd_mega, dim3(grid_blocks), dim3(512), args, LDS_TOTAL, stream);
    if (e != hipSuccess) fprintf(stderr, "cooperative launch failed: %s (grid %d)\n", hipGetErrorString(e), grid_blocks);
}
```

```cpp
#include <hip/hip_runtime.h>
#include <hip/hip_cooperative_groups.h>
#include <cstdio>
namespace cg = cooperative_groups;

#define LAS __attribute__((address_space(3)))
typedef unsigned short bf16_t;
typedef unsigned char uchar;
typedef short bf16x8 __attribute__((ext_vector_type(8)));
typedef float f32x4 __attribute__((ext_vector_type(4)));
typedef float f32x2 __attribute__((ext_vector_type(2)));
typedef unsigned u32x4 __attribute__((ext_vector_type(4)));
typedef unsigned u32x2 __attribute__((ext_vector_type(2)));

constexpr int DM = 1024, NB = 4, SEQ = 8192, CTX = 256, TT = 8448, MROWS = 33792, DEPTH = 4;
constexpr int FFN = 2816, ZLD = 2968, NCH = 264  , GROWS = 1056  ;
constexpr int LDSB = 131072;
constexpr int LDS_TOTAL = 163840, TAB_OFF = 162816;

enum { I_X = 0, I_C, I_CTX, I_CCTX, I_N1G, I_N2G, I_FG, I_ADAW, I_ADAB, I_WIN, I_WOUT, I_MU, I_W0, I_WUP, I_A0, I_AUP, I_GUP, I_KK, I_KA, I_RK,
       I_LNG, I_LNB, I_CONV, I_ALOG, I_DTB, I_GNG, I_LRE, I_LIM, I_LDT, I_BRE, I_BIM, I_CRE, I_CIM, I_S5D, I_GLUW, I_GLUB, I_FG8, I_FU, I_FD, N_IN };

constexpr size_t OFF_WIN = 0;
constexpr size_t OFF_WOUT = OFF_WIN + 6815744;
constexpr size_t OFF_WGU = OFF_WOUT + 2097152;
constexpr size_t OFF_WDN = OFF_WGU + 11534336;
constexpr size_t OFF_WUP = OFF_WDN + 5767168;
constexpr size_t OFF_AUP = OFF_WUP + 98304;
constexpr size_t OFF_GUP = OFF_AUP + 98304;
constexpr size_t OFF_GLU = OFF_GUP + 98304;
constexpr size_t OFF_TF = OFF_GLU + 131072;
constexpr size_t OFF_E2 = OFF_TF + 20971520;
constexpr size_t OFF_DP = OFF_E2 + 4194304;
constexpr size_t OFF_MOD = OFF_DP + 16384;
constexpr size_t OFF_CTXR = OFF_MOD + 491520;
constexpr size_t OFF_BC = OFF_CTXR + 4194304;
constexpr size_t OFF_H = OFF_BC + 1622016;
constexpr size_t OFF_Z = OFF_H + 69206016;
constexpr size_t OFF_YO = OFF_Z + 200589312;
constexpr size_t OFF_A2 = OFF_YO + 103809024;
constexpr size_t OFF_Y5 = OFF_A2 + 43581440;
constexpr size_t OFF_HL = OFF_Y5 + 34603008;
constexpr size_t OFF_BAR = OFF_HL + 17301504;
constexpr size_t WS_NEED = OFF_BAR + 16384;

struct P { const float* in[N_IN]; float* out; char* ws; };
__device__ __forceinline__ char* ldp(int i) {
    extern __shared__ __attribute__((aligned(16))) unsigned char shm_[];
    const unsigned long long v = ((const unsigned long long*)(shm_ + TAB_OFF))[i];
    const unsigned lo = __builtin_amdgcn_readfirstlane((unsigned)v), hi = __builtin_amdgcn_readfirstlane((unsigned)(v >> 32));
    return (char*)(__attribute__((address_space(1))) char*)(((unsigned long long)hi << 32) | lo);
}
struct PIn { __device__ __forceinline__ const float* operator[](int i) const { return (const float*)ldp(i); } };
struct PP { PIn in; float* out; char* ws; int wv; };
__device__ __forceinline__ PP mkp(int wv) { PP q; q.out = (float*)ldp(N_IN); q.ws = ldp(N_IN + 1); q.wv = wv; return q; }

__device__ __forceinline__ int lane_id() { return (int)__builtin_amdgcn_mbcnt_hi(~0u, __builtin_amdgcn_mbcnt_lo(~0u, 0u)); }
__device__ __forceinline__ int tid_of(int wv) { int t = wv * 64 + lane_id(); asm volatile("" : "+v"(t)); return t; }
__device__ __forceinline__ int bidx() { int t = blockIdx.x; asm volatile("" : "+s"(t)); return t; }
__device__ __forceinline__ bf16_t f2bf(float f) { unsigned u = __float_as_uint(f); u += 0x7FFFu + ((u >> 16) & 1u); return (bf16_t)(u >> 16); }
typedef __bf16 bf16v2_t __attribute__((ext_vector_type(2)));
__device__ __forceinline__ unsigned pk2(float lo, float hi) { f32x2 f; f.x = lo; f.y = hi; return __builtin_bit_cast(unsigned, __builtin_convertvector(f, bf16v2_t)); }
__device__ __forceinline__ float bflo(unsigned u) { return __uint_as_float(u << 16); }
__device__ __forceinline__ float bfhi(unsigned u) { return __uint_as_float(u & 0xFFFF0000u); }
__device__ __forceinline__ float bf2f(bf16_t b) { return __uint_as_float(((unsigned)b) << 16); }
__device__ __forceinline__ f32x4 unpk4(u32x2 v) { return (f32x4){bflo(v.x), bfhi(v.x), bflo(v.y), bfhi(v.y)}; }
__device__ __forceinline__ u32x2 pk4(f32x4 v) { u32x2 r; r.x = pk2(v[0], v[1]); r.y = pk2(v[2], v[3]); return r; }
__device__ __forceinline__ float rcpf_(float x) { return __builtin_amdgcn_rcpf(x); }
__device__ __forceinline__ float sigmoidf_(float x) { return rcpf_(1.f + __expf(-x)); }
__device__ __forceinline__ float siluf_(float x) { return x * rcpf_(1.f + __expf(-x)); }
__device__ __forceinline__ float softplusf_(float x) { return x > 20.f ? x : log1pf(__expf(x)); }
__device__ __forceinline__ float gelu_tanh(float x) { const float u = 1.5957691216057308f * (x + 0.044715f * x * x * x); return x * rcpf_(1.f + __expf(-u)); }
__device__ __forceinline__ float tanhf_(float x) { return 1.f - 2.f * rcpf_(1.f + __expf(2.f * x)); }
template <int CTRL> __device__ __forceinline__ float dppf(float x) { return __builtin_bit_cast(float, __builtin_amdgcn_mov_dpp(__builtin_bit_cast(int, x), CTRL, 0xf, 0xf, true)); }
__device__ __forceinline__ float red16(float x) {
    x += dppf<0xB1>(x); x += dppf<0x4E>(x); x += dppf<0x141>(x); x += dppf<0x128>(x); return x;
}
__device__ __forceinline__ void red16x2(float& x, float& y) {
    x += dppf<0xB1>(x); y += dppf<0xB1>(y); x += dppf<0x4E>(x); y += dppf<0x4E>(y);
    x += dppf<0x141>(x); y += dppf<0x141>(y); x += dppf<0x128>(x); y += dppf<0x128>(y);
}
__device__ __forceinline__ float dot4(const f32x4& a, const f32x4& b) { return (a[0] * b[0] + a[2] * b[2]) + (a[1] * b[1] + a[3] * b[3]); }
__device__ __forceinline__ float red64(float x) {
#pragma unroll
    for (int o = 32; o > 0; o >>= 1) x += __shfl_xor(x, o);
    return x;
}
__device__ __forceinline__ void lbar() { asm volatile("s_waitcnt lgkmcnt(0)" ::: "memory"); __builtin_amdgcn_s_barrier(); asm volatile("" ::: "memory"); }
__device__ __forceinline__ int seqpos(int dir, int n) { return dir == 0 ? n : (n < CTX ? (CTX - 1 - n) : (TT - 1 - (n - CTX))); }
__device__ __forceinline__ int s5pos(int j) { if (j < CTX) return j; const int tok = j - CTX; return CTX + (tok & 63) * 128 + (tok >> 6); }

#define XB_TMO      128
#define XB_XCNT(j)  (256  + 64 * (j))
#define XB_XSUB(j)  (1280 + 64 * (j))
#define XB_XGEN(j)  (2304 + 64 * (j))
#define XB_TOP      3328
#define XB_TOPGEN   3392
#define XCD_BAR_WORDS 3456
#define XB_SPIN_CAP (1u << 18)

__device__ __forceinline__ unsigned xb_ld(unsigned* p)              { return __hip_atomic_load(p, __ATOMIC_RELAXED, __HIP_MEMORY_SCOPE_AGENT); }
__device__ __forceinline__ unsigned xb_add(unsigned* p, unsigned v) { return __hip_atomic_fetch_add(p, v, __ATOMIC_RELAXED, __HIP_MEMORY_SCOPE_AGENT); }
__device__ __forceinline__ unsigned xb_xcc_id() { return (unsigned)__builtin_amdgcn_s_getreg((3 << 11) | 20) & 0xFu; }
#define XB_SPIN(cond, bar) do { unsigned _sp = 0; while (cond) { __builtin_amdgcn_s_sleep(1); \
    if ((++_sp & 255u) == 0u) { if (xb_ld(&(bar)[XB_TMO])) break; if (_sp > XB_SPIN_CAP) { atomicAdd(&(bar)[XB_TMO], 1u); break; } } } } while (0)

struct XcdBarrier {
    int wv;
    unsigned* bar; unsigned x;
    volatile LAS unsigned* st;
};

__device__ __forceinline__ XcdBarrier xcd_barrier_post(unsigned* bar, volatile LAS unsigned* st, int wv) {
    XcdBarrier b; b.bar = bar; b.x = xb_xcc_id(); b.st = st; b.wv = wv;
    if (wv == 0 && lane_id() == 0) (void)xb_add(&bar[XB_XCNT(b.x)], 1u);
    return b;
}
__device__ __forceinline__ void xcd_barrier_complete(unsigned* bar, unsigned x, unsigned& nloc, unsigned& nx) {
    const unsigned G = gridDim.x * gridDim.y * gridDim.z;
    unsigned sum, cnt, mine, sp = 0u;
    for (;;) {
        sum = 0u; cnt = 0u; mine = 0u;
#pragma unroll
        for (unsigned j = 0; j < 16; ++j) { const unsigned c = xb_ld(&bar[XB_XCNT(j)]); sum += c; cnt += (c > 0u) ? 1u : 0u; mine = (j == x) ? c : mine; }
        if (sum == G) break;
        __builtin_amdgcn_s_sleep(1);
        if ((++sp & 255u) == 0u) { if (xb_ld(&bar[XB_TMO])) break; if (sp > XB_SPIN_CAP) { atomicAdd(&bar[XB_TMO], 1u); break; } }
    }
    nloc = mine > 0u ? mine : 1u; nx = cnt > 0u ? cnt : 1u;
}

__device__ __forceinline__ void xcd_barrier(const XcdBarrier& b) {
    asm volatile("s_waitcnt vmcnt(0)" ::: "memory");
    __syncthreads();
    if (b.wv == 0 && lane_id() == 0) {
        unsigned* bar = b.bar;
        __builtin_amdgcn_s_waitcnt(0);
        unsigned nloc = b.st[0], nx = b.st[1];
        if (nloc == 0u) { xcd_barrier_complete(bar, b.x, nloc, nx); b.st[0] = nloc; b.st[1] = nx; }
        const unsigned old = xb_add(&bar[XB_XSUB(b.x)], 1u);
        const unsigned gen = old / nloc;
        if (old + 1u == (gen + 1u) * nloc) {
            __builtin_amdgcn_fence(__ATOMIC_RELEASE, "agent");
            asm volatile("s_waitcnt vmcnt(0)" ::: "memory");
            const unsigned og = xb_add(&bar[XB_TOP], 1u);
            const unsigned tg = og / nx;
            if (og + 1u == (tg + 1u) * nx) xb_add(&bar[XB_TOPGEN], 1u);
            else XB_SPIN(xb_ld(&bar[XB_TOPGEN]) == tg, bar);
            __builtin_amdgcn_fence(__ATOMIC_ACQUIRE, "agent");
            xb_add(&bar[XB_XGEN(b.x)], 1u);
            asm volatile("s_waitcnt vmcnt(0)" ::: "memory");
        } else {
            XB_SPIN(xb_ld(&bar[XB_XGEN(b.x)]) == gen, bar);
            __builtin_amdgcn_fence(__ATOMIC_ACQUIRE, "agent");
            asm volatile("s_waitcnt vmcnt(0)" ::: "memory");
        }
    }
    __syncthreads();
}


namespace pg8 {
constexpr int BM = 256, BK = 64, HALF = 128, HTB = HALF * BK * 2, NXCD = 8, WGM = 8;
__device__ __forceinline__ int lds_byte(int r, int c) { const int st = (r >> 4) * 2 + (c >> 5), rr = r & 15, cc = c & 31, ob = rr * 64 + cc * 2; return st * 1024 + (ob ^ (((ob >> 9) & 1) << 5)); }
__device__ __forceinline__ void stage_rc(int b, int& R, int& C) { const int st = b / 1024, sb = b % 1024, swz = sb ^ (((sb >> 9) & 1) << 5); R = (st >> 1) * 16 + swz / 64; C = (st & 1) * 32 + (swz % 64) / 2; }
__device__ __forceinline__ int perm32(int rho) { const int n = rho >> 4, i = rho & 15; return 8 * (i >> 2) + 4 * n + (i & 3); }
struct Unit { int pm, pn, grp; size_t aoff, boff; };
struct Gemm { const bf16_t* A; const bf16_t* Bt; int K, lda, ldb; };
struct Sched {
    int mode, nM, nN, nwg, G, c; size_t gA, gB, tA, tB;
    __device__ bool next(int i, Unit& u) const {
        const long L = (long)i * G + c; if (L >= nwg) return false;
        if (mode == 0) {
            int wgid = (int)L; { const int q = nwg / NXCD, r = nwg % NXCD, xcd = wgid % NXCD, off = wgid / NXCD; wgid = (xcd < r ? xcd * (q + 1) : r * (q + 1) + (xcd - r) * q) + off; }
            const int nig = WGM * nN, gid = wgid / nig, fm = gid * WGM, gsz = (nM - fm) < WGM ? (nM - fm) : WGM;
            u.pm = fm + ((wgid % nig) % gsz); u.pn = (wgid % nig) / gsz; u.grp = 0;
        } else {
            const int upg = nM * nN; u.grp = (int)L / upg; const int rem = (int)L % upg; u.pm = rem % nM; u.pn = rem / nM;
        }
        u.aoff = (size_t)u.grp * gA + (size_t)u.pm * tA; u.boff = (size_t)u.grp * gB + (size_t)u.pn * tB; return true;
    }
};

template <class Epi>
__device__ __forceinline__ void gemm_phase(LAS uchar* lds, const Gemm g, const Sched& S, const Epi& E, int wv) {
    const int tid = tid_of(wv), wid = __builtin_amdgcn_readfirstlane(tid >> 6), lane = tid & 63, wr = wid >> 2, wc = wid & 3, fr = lane & 15, fq = lane >> 4;
    const int K = g.K, nt = K / BK;
    unsigned voffA[2], voffB[2];
#pragma unroll
    for (int i = 0; i < 2; ++i) { int R, C; stage_rc(tid * 16 + i * 8192, R, C); const int Rb = Epi::PERM ? ((R & ~31) + perm32(R & 31)) : R;
        voffA[i] = (unsigned)(R * g.lda + C) * 2u; voffB[i] = (unsigned)(Rb * g.ldb + C) * 2u; }
    const size_t kstep = (size_t)(BK * 2);
    const size_t hstepA = (size_t)HALF * g.lda * 2, hstepB = (size_t)HALF * g.ldb * 2;
    const unsigned ldsw = (unsigned)wid * 1024u;
    const int aoff = lds_byte(wr * 64 + fr, fq * 8), boff = lds_byte(wc * 32 + fr, fq * 8);
#define PG8_SA(b, h) (((b) * 2 + (h)) * HTB)
#define PG8_SB(b, h) ((4 + (b) * 2 + (h)) * HTB)
#define PG8_STAGE(bufoff, gbase, voff) do { _Pragma("unroll") for (int _i = 0; _i < 2; ++_i) \
        __builtin_amdgcn_global_load_lds((const unsigned*)((const char*)(gbase) + (voff)[_i]), (LAS unsigned*)(lds + (bufoff) + ldsw + _i * 8192), 16, 0, 0); } while (0)
#define PG8_LDA(dst, b, h) do { _Pragma("unroll") for (int m = 0; m < 4; ++m) _Pragma("unroll") for (int k = 0; k < 2; ++k) dst[m][k] = *(const LAS bf16x8*)(lds + PG8_SA(b, h) + aoff + m * 2048 + k * 1024); } while (0)
#define PG8_LDB(dst, b, h) do { _Pragma("unroll") for (int n = 0; n < 2; ++n) _Pragma("unroll") for (int k = 0; k < 2; ++k) dst[n][k] = *(const LAS bf16x8*)(lds + PG8_SB(b, h) + boff + n * 2048 + k * 1024); } while (0)
#define PG8_MMA(ai, bj, At, Bt) do { __builtin_amdgcn_s_setprio(1); _Pragma("unroll") for (int m = 0; m < 4; ++m) _Pragma("unroll") for (int n = 0; n < 2; ++n) _Pragma("unroll") for (int k = 0; k < 2; ++k) \
        acc[ai][bj][m][n] = __builtin_amdgcn_mfma_f32_16x16x32_bf16(Bt[n][k], At[m][k], acc[ai][bj][m][n], 0, 0, 0); __builtin_amdgcn_s_setprio(0); } while (0)
#define PG8_WAIT_V(n) asm volatile("s_waitcnt vmcnt(" #n ")" ::: "memory")
#define PG8_WAIT_L(n) asm volatile("s_waitcnt lgkmcnt(" #n ")" ::: "memory")
#define PG8_BAR __builtin_amdgcn_s_barrier()
#define PG8_SCHED __builtin_amdgcn_sched_barrier(0)
    Unit cur, nxt; int ui = 0;
    if (!S.next(0, cur)) return;
    f32x4 acc[2][2][4][2];
#pragma unroll
    for (int a = 0; a < 2; ++a)
#pragma unroll
        for (int b = 0; b < 2; ++b)
#pragma unroll
            for (int m = 0; m < 4; ++m)
#pragma unroll
                for (int n = 0; n < 2; ++n) acc[a][b][m][n] = (f32x4){0.f, 0.f, 0.f, 0.f};
    bf16x8 At[4][2], B0[2][2], B1[2][2];
    const char* cA = (const char*)g.A + cur.aoff; const char* cB = (const char*)g.Bt + cur.boff;
    PG8_STAGE(PG8_SB(0, 0), cB, voffB); PG8_STAGE(PG8_SA(0, 0), cA, voffA); PG8_STAGE(PG8_SB(0, 1), cB + hstepB, voffB); PG8_STAGE(PG8_SA(0, 1), cA + hstepA, voffA);
    if (wr == 1) PG8_BAR;
    PG8_WAIT_V(4); PG8_BAR;
    PG8_STAGE(PG8_SB(1, 0), cB + kstep, voffB); PG8_STAGE(PG8_SA(1, 0), cA + kstep, voffA); PG8_STAGE(PG8_SB(1, 1), cB + hstepB + kstep, voffB);
    PG8_WAIT_V(6); PG8_BAR;
    for (;;) {
        const bool has_next = S.next(ui + 1, nxt);
        const char* nA = has_next ? (const char*)g.A + nxt.aoff : cA; const char* nB = has_next ? (const char*)g.Bt + nxt.boff : cB;
        for (int t = 0; t < nt; t += 2) {
            const bool last = (t == nt - 2);
            const char* a1 = cA + (size_t)(t + 1) * kstep;
            const char* a2 = last ? nA : cA + (size_t)(t + 2) * kstep; const char* b2 = last ? nB : cB + (size_t)(t + 2) * kstep;
            const char* a3 = a2 + kstep; const char* b3 = b2 + kstep;
            PG8_LDB(B0, 0, 0); PG8_SCHED; PG8_LDA(At, 0, 0); PG8_STAGE(PG8_SA(1, 1), a1 + hstepA, voffA);
            PG8_WAIT_L(8); PG8_BAR; PG8_WAIT_L(0); PG8_MMA(0, 0, At, B0); PG8_BAR; PG8_SCHED;
            PG8_LDB(B1, 0, 1); PG8_STAGE(PG8_SB(0, 0), b2, voffB);
            PG8_BAR; PG8_WAIT_L(0); PG8_MMA(0, 1, At, B1); PG8_BAR;
            PG8_LDA(At, 0, 1); PG8_STAGE(PG8_SA(0, 0), a2, voffA);
            PG8_BAR; PG8_WAIT_L(0); PG8_MMA(1, 0, At, B0); PG8_BAR; PG8_SCHED;
            PG8_STAGE(PG8_SB(0, 1), b2 + hstepB, voffB);
            PG8_WAIT_V(6); PG8_BAR; PG8_MMA(1, 1, At, B1); PG8_BAR;
            PG8_LDB(B0, 1, 0); PG8_SCHED; PG8_LDA(At, 1, 0); PG8_STAGE(PG8_SA(0, 1), a2 + hstepA, voffA);
            PG8_WAIT_L(8); PG8_BAR; PG8_WAIT_L(0); PG8_MMA(0, 0, At, B0); PG8_BAR; PG8_SCHED;
            PG8_LDB(B1, 1, 1); PG8_STAGE(PG8_SB(1, 0), b3, voffB);
            PG8_BAR; PG8_WAIT_L(0); PG8_MMA(0, 1, At, B1); PG8_BAR;
            PG8_LDA(At, 1, 1); PG8_STAGE(PG8_SA(1, 0), a3, voffA);
            PG8_BAR; PG8_WAIT_L(0); PG8_MMA(1, 0, At, B0); PG8_BAR; PG8_SCHED;
            PG8_STAGE(PG8_SB(1, 1), b3 + hstepB, voffB);
            PG8_WAIT_V(6); PG8_BAR; PG8_MMA(1, 1, At, B1); PG8_BAR;
        }
        E(acc, cur, wr, wc, fr, fq);
        if (!has_next) break;
#pragma unroll
        for (int a = 0; a < 2; ++a)
#pragma unroll
            for (int b = 0; b < 2; ++b)
#pragma unroll
                for (int m = 0; m < 4; ++m)
#pragma unroll
                    for (int n = 0; n < 2; ++n) acc[a][b][m][n] = (f32x4){0.f, 0.f, 0.f, 0.f};
        cur = nxt; cA = nA; cB = nB; ++ui;
    }
    PG8_WAIT_V(0);
    if (wr == 0) PG8_BAR;
    PG8_BAR;
#undef PG8_SA
#undef PG8_SB
#undef PG8_STAGE
#undef PG8_LDA
#undef PG8_LDB
#undef PG8_MMA
#undef PG8_WAIT_V
#undef PG8_WAIT_L
#undef PG8_BAR
#undef PG8_SCHED
}
}
using pg8::Unit;

struct EpiZ {
    static constexpr bool PERM = true;
    bf16_t* Z; bf16_t* A2;
    __device__ __forceinline__ void operator()(const f32x4 (&acc)[2][2][4][2], const Unit& u, int wr, int wc, int fr, int fq) const {
#pragma unroll
        for (int ai = 0; ai < 2; ++ai)
#pragma unroll
            for (int m = 0; m < 4; ++m) {
                const int r = u.pm * 256 + ai * 128 + wr * 64 + m * 16 + fr;
#pragma unroll
                for (int bj = 0; bj < 2; ++bj) {
                    const int c = u.pn * 256 + bj * 128 + wc * 32 + 8 * fq;
                    u32x4 w; w.x = pk2(acc[ai][bj][m][0][0], acc[ai][bj][m][0][1]); w.y = pk2(acc[ai][bj][m][0][2], acc[ai][bj][m][0][3]);
                    w.z = pk2(acc[ai][bj][m][1][0], acc[ai][bj][m][1][1]); w.w = pk2(acc[ai][bj][m][1][2], acc[ai][bj][m][1][3]);
                    if (u.pn == 0) {
                        const int b = r / TT, j = r - b * TT, n = s5pos(j), R = b * NCH + (n >> 5), s = n & 31, g = c >> 4, h0 = c & 15;
                        bf16_t* d0 = A2 + ((size_t)((g * 2) * GROWS + R)) * 640 + s * 16 + h0;
                        *(u32x4*)d0 = w; *(u32x4*)(d0 + (size_t)GROWS * 640) = w;
                    } else {
                        const int zc = c - 256;
                        if (zc < ZLD) *(u32x4*)(Z + (size_t)r * ZLD + zc) = w;
                    }
                }
            }
    }
};
struct EpiResid {
    static constexpr bool PERM = false;
    const float* xin; float* xout; const float* cin; float* cout; const float* mod; int gidx;
    __device__ __forceinline__ void operator()(const f32x4 (&acc)[2][2][4][2], const Unit& u, int wr, int wc, int fr, int fq) const {
        const int b = u.pm / 33, tb = u.pm - b * 33;
        const bool isctx = (tb == 0);
        const float* gate = mod + (size_t)(isctx ? 4 : b) * 6144 + gidx * 1024;
        const size_t row0 = isctx ? (size_t)b * CTX : (size_t)b * SEQ + (size_t)(tb - 1) * 256;
        const float* src = isctx ? cin : xin; float* dst = isctx ? cout : xout;
        const int col0 = u.pn * 256 + wc * 32 + 4 * fq;
#pragma unroll
        for (int ai = 0; ai < 2; ++ai)
#pragma unroll
            for (int m = 0; m < 4; ++m) {
                const size_t ro = (row0 + ai * 128 + wr * 64 + m * 16 + fr) * DM;
#pragma unroll
                for (int bj = 0; bj < 2; ++bj)
#pragma unroll
                    for (int n = 0; n < 2; ++n) {
                        const int c = col0 + bj * 128 + n * 16;
                        const f32x4 gv = *(const f32x4*)(gate + c); const f32x4 xv = *(const f32x4*)(src + ro + c);
                        *(f32x4*)(dst + ro + c) = xv + gv * acc[ai][bj][m][n];
                    }
                asm volatile("" ::: "memory");
            }
    }
};
struct EpiSwiGLU {
    static constexpr bool PERM = false;
    bf16_t* HID;
    __device__ __forceinline__ void operator()(const f32x4 (&acc)[2][2][4][2], const Unit& u, int wr, int wc, int fr, int fq) const {
#pragma unroll
        for (int ai = 0; ai < 2; ++ai)
#pragma unroll
            for (int m = 0; m < 4; ++m) {
                const size_t r = (size_t)(u.pm * 256 + ai * 128 + wr * 64 + m * 16 + fr);
#pragma unroll
                for (int bj = 0; bj < 2; ++bj) {
                    const int hc = u.pn * 128 + bj * 64 + wc * 16 + 4 * fq;
                    f32x4 o;
#pragma unroll
                    for (int i = 0; i < 4; ++i) o[i] = siluf_(acc[ai][bj][m][0][i]) * acc[ai][bj][m][1][i];
                    *(u32x2*)(HID + r * FFN + hc) = pk4(o);
                }
                asm volatile("" ::: "memory");
            }
    }
};
struct EpiHL {
    static constexpr bool PERM = false;
    float* HL;
    __device__ __forceinline__ void operator()(const f32x4 (&acc)[2][2][4][2], const Unit& u, int wr, int wc, int fr, int fq) const {
#pragma unroll
        for (int ai = 0; ai < 2; ++ai)
#pragma unroll
            for (int m = 0; m < 4; ++m) {
                const int R = u.pm * 256 + ai * 128 + wr * 64 + m * 16 + fr;
                if (R < GROWS) {
                    float* rp = HL + ((size_t)u.grp * GROWS + R) * 256 + wc * 32 + 4 * fq;
#pragma unroll
                    for (int bj = 0; bj < 2; ++bj)
#pragma unroll
                        for (int n = 0; n < 2; ++n) *(f32x4*)(rp + bj * 128 + n * 16) = acc[ai][bj][m][n];
                }
                asm volatile("" ::: "memory");
            }
    }
};
struct EpiY5 {
    static constexpr bool PERM = true;
    bf16_t* Y5;
    __device__ __forceinline__ void operator()(const f32x4 (&acc)[2][2][4][2], const Unit& u, int wr, int wc, int fr, int fq) const {
#pragma unroll
        for (int ai = 0; ai < 2; ++ai)
#pragma unroll
            for (int m = 0; m < 4; ++m) {
                const int R = u.pm * 256 + ai * 128 + wr * 64 + m * 16 + fr;
                if (R < GROWS) {
                    bf16_t* rp = Y5 + ((size_t)u.grp * GROWS + R) * 512 + u.pn * 256 + wc * 32 + 8 * fq;
#pragma unroll
                    for (int bj = 0; bj < 2; ++bj) {
                        u32x4 w; w.x = pk2(acc[ai][bj][m][0][0], acc[ai][bj][m][0][1]); w.y = pk2(acc[ai][bj][m][0][2], acc[ai][bj][m][0][3]);
                        w.z = pk2(acc[ai][bj][m][1][0], acc[ai][bj][m][1][1]); w.w = pk2(acc[ai][bj][m][1][2], acc[ai][bj][m][1][3]);
                        *(u32x4*)(rp + bj * 128) = w;
                    }
                }
            }
    }
};

__device__ __forceinline__ pg8::Sched sched_static(int M, int N, int lda, int ldb) {
    pg8::Sched S; S.mode = 0; S.nM = M / 256; S.nN = N / 256; S.nwg = S.nM * S.nN; S.G = gridDim.x; S.c = bidx();
    S.gA = 0; S.gB = 0; S.tA = (size_t)256 * lda * 2; S.tB = (size_t)256 * ldb * 2; return S;
}

__device__ __forceinline__ void phase_mod(const PP& p, float* sm) {
    float* sv = sm;
    float* part = sm + 5 * 1024;
    const int tid = tid_of(p.wv), w = tid >> 6, lane = tid & 63;
    for (int i = tid; i < 5 * 1024; i += 512) { const int v = i >> 10, k = i & 1023; const float x = v < 4 ? p.in[I_C][v * 1024 + k] : p.in[I_CCTX][k]; sv[i] = siluf_(x); }
    __syncthreads();
    float* mod = (float*)(p.ws + OFF_MOD);
    for (int it = bidx(); it < DEPTH * 48; it += gridDim.x) {
        const int l = it / 48, cb = it - l * 48, col = cb * 128 + 2 * lane;
        const float* W = p.in[I_ADAW] + (size_t)l * 1024 * 6144 + col;
        f32x2 a[5];
#pragma unroll
        for (int i = 0; i < 5; ++i) a[i] = (f32x2){0.f, 0.f};
#pragma unroll 8
        for (int k = w * 128; k < w * 128 + 128; ++k) {
            const f32x2 wv = *(const f32x2*)(W + (size_t)k * 6144);
#pragma unroll
            for (int i = 0; i < 5; ++i) a[i] += sv[i * 1024 + k] * wv;
        }
#pragma unroll
        for (int i = 0; i < 5; ++i) { part[(w * 5 + i) * 128 + 2 * lane] = a[i].x; part[(w * 5 + i) * 128 + 2 * lane + 1] = a[i].y; }
        __syncthreads();
        for (int o = tid; o < 640; o += 512) { const int i = o >> 7, cc = o & 127; float s = 0.f;
#pragma unroll
            for (int ww = 0; ww < 8; ++ww) s += part[(ww * 5 + i) * 128 + cc];
            mod[((size_t)l * 5 + i) * 6144 + cb * 128 + cc] = s + p.in[I_ADAB][l * 6144 + cb * 128 + cc]; }
        __syncthreads();
    }
}

__device__ __forceinline__ int n_coef_blocks() { return gridDim.x >= 128 ? 64 : 0; }
__device__ __forceinline__ void convT_tile(const float* src, const float* src2, int ldn, bf16_t* dst, int K, int kind, int n0, int k0, float* sm, int wv) {
    const int tid = tid_of(wv);
    {
        const int nn = tid & 63, kq = tid >> 6;
        const int np = n0 + nn; const float* s = src; int col;
        if (kind == 0) col = np < 256 ? 2968 + np : (np < 3224 ? np - 256 : -1);
        else if (kind == 1) col = np;
        else { const int G = np >> 5, w = np & 31; col = 16 * G + (w & 15); if (w >= 16) s = src2; }
#pragma unroll
        for (int i = 0; i < 8; ++i) { const int kk = kq + 8 * i; sm[kk * 65 + nn] = col >= 0 ? s[(size_t)(k0 + kk) * ldn + col] : 0.f; }
    }
    __syncthreads();
    {
        const int n = tid >> 3, ks = (tid & 7) * 8;
        u32x4 w; w.x = pk2(sm[(ks + 0) * 65 + n], sm[(ks + 1) * 65 + n]); w.y = pk2(sm[(ks + 2) * 65 + n], sm[(ks + 3) * 65 + n]);
        w.z = pk2(sm[(ks + 4) * 65 + n], sm[(ks + 5) * 65 + n]); w.w = pk2(sm[(ks + 6) * 65 + n], sm[(ks + 7) * 65 + n]);
        *(u32x4*)(dst + (size_t)(n0 + n) * K + k0 + ks) = w;
    }
    __syncthreads();
}
__device__ __forceinline__ void phase_convw(const PP& p, int l, float* sm, int w0, int nwb, int ffn) {
    constexpr int T0 = 832, T1 = T0 + 256, T2 = T1 + 1408, T3 = T2 + 704, T4 = T3 + 12, T5 = T4 + 12, T6 = T5 + 12, T7 = T6 + 16;
    const int wb = bidx() - w0;
    if (wb < 0 || wb >= nwb) return;
    const int nt = ffn ? (T3 - T1) : (T7 - (T3 - T1));
    for (int tt = wb; tt < nt; tt += nwb) {
        const int t = ffn ? tt + T1 : (tt < T1 ? tt : tt + (T3 - T1));
        if (t < T0) { convT_tile(p.in[I_WIN] + (size_t)l * 1024 * 3224, nullptr, 3224, (bf16_t*)(p.ws + OFF_WIN), 1024, 0, (t >> 4) * 64, (t & 15) * 64, sm, p.wv); }
        else if (t < T1) { const int q = t - T0; convT_tile(p.in[I_WOUT] + (size_t)l * 1024 * 1024, nullptr, 1024, (bf16_t*)(p.ws + OFF_WOUT), 1024, 1, (q >> 4) * 64, (q & 15) * 64, sm, p.wv); }
        else if (t < T2) { const int q = t - T1; convT_tile(p.in[I_FG8] + (size_t)l * 1024 * FFN, p.in[I_FU] + (size_t)l * 1024 * FFN, FFN, (bf16_t*)(p.ws + OFF_WGU), 1024, 2, (q >> 4) * 64, (q & 15) * 64, sm, p.wv); }
        else if (t < T3) { const int q = t - T2; convT_tile(p.in[I_FD] + (size_t)l * FFN * 1024, nullptr, 1024, (bf16_t*)(p.ws + OFF_WDN), FFN, 1, (q / 44) * 64, (q % 44) * 64, sm, p.wv); }
        else if (t < T4) { const int q = t - T3, d = q / 6; convT_tile(p.in[I_WUP] + ((size_t)l * 2 + d) * 64 * 384, nullptr, 384, (bf16_t*)(p.ws + OFF_WUP) + d * 384 * 64, 64, 1, (q % 6) * 64, 0, sm, p.wv); }
        else if (t < T5) { const int q = t - T4, d = q / 6; convT_tile(p.in[I_AUP] + ((size_t)l * 2 + d) * 64 * 384, nullptr, 384, (bf16_t*)(p.ws + OFF_AUP) + d * 384 * 64, 64, 1, (q % 6) * 64, 0, sm, p.wv); }
        else if (t < T6) { const int q = t - T5; convT_tile(p.in[I_GUP] + (size_t)l * 128 * 384, nullptr, 384, (bf16_t*)(p.ws + OFF_GUP), 128, 1, (q >> 1) * 64, (q & 1) * 64, sm, p.wv); }
        else { const int q = t - T6; convT_tile(p.in[I_GLUW] + (size_t)l * 256 * 256, nullptr, 256, (bf16_t*)(p.ws + OFF_GLU), 256, 1, (q >> 2) * 64, (q & 3) * 64, sm, p.wv); }
    }
}

__device__ __forceinline__ void phase_s5coef(const PP& p, int l, float* sm) {
    float* pw = sm;
    float* bb = pw + 33 * 128;
    float* cc = bb + 2048;
    float* Kt = cc + 2048;
    const int tid = tid_of(p.wv);
    bf16_t* TF = (bf16_t*)(p.ws + OFF_TF); bf16_t* E2 = (bf16_t*)(p.ws + OFF_E2); float* DP = (float*)(p.ws + OFF_DP);
    for (int item = (int)gridDim.x - 1 - (int)bidx(); item < 64; item += gridDim.x) {
        const int it = item >> 1, part = item & 1, g = it >> 1, dir = it & 1;
        const size_t base = ((size_t)l * 2 + dir) * 16 + g;
        if (tid < 64) {
            const int q = tid;
            const float lre = p.in[I_LRE][base * 64 + q], lim = p.in[I_LIM][base * 64 + q], dt = __expf(p.in[I_LDT][base]);
            const float mag = __expf(lre * dt); float sn, cs; sincosf(lim * dt, &sn, &cs);
            const float are = mag * cs, aim = mag * sn, den = lre * lre + lim * lim;
            const float fre = ((are - 1.f) * lre + aim * lim) / den, fim = (aim * lre - (are - 1.f) * lim) / den;
            float pr = 1.f, pi = 0.f;
            for (int m = 0; m <= 32; ++m) { pw[(m * 64 + q) * 2] = pr; pw[(m * 64 + q) * 2 + 1] = pi; const float nr = pr * are - pi * aim, ni = pr * aim + pi * are; pr = nr; pi = ni; }
            for (int h = 0; h < 16; ++h) { const float br = p.in[I_BRE][(base * 64 + q) * 16 + h], bi = p.in[I_BIM][(base * 64 + q) * 16 + h];
                bb[(q * 16 + h) * 2] = fre * br - fim * bi; bb[(q * 16 + h) * 2 + 1] = fre * bi + fim * br; }
            if (part == 0) { DP[(it * 64 + q) * 2] = pw[(32 * 64 + q) * 2]; DP[(it * 64 + q) * 2 + 1] = pw[(32 * 64 + q) * 2 + 1]; }
        }
        for (int i = tid; i < 1024; i += 512) { const int h = i >> 6, q = i & 63; cc[i * 2] = p.in[I_CRE][(base * 16 + h) * 64 + q]; cc[i * 2 + 1] = p.in[I_CIM][(base * 16 + h) * 64 + q]; }
        __syncthreads();
        {
            const int lag = tid >> 4, hp = tid & 15;
            float s[16];
#pragma unroll
            for (int h = 0; h < 16; ++h) s[h] = 0.f;
            for (int q = 0; q < 64; ++q) {
                const f32x2 c2 = *(const f32x2*)(cc + (hp * 64 + q) * 2), w2 = *(const f32x2*)(pw + (lag * 64 + q) * 2);
                const float xr = c2.x * w2.x - c2.y * w2.y, xi = c2.x * w2.y + c2.y * w2.x;
#pragma unroll
                for (int h4 = 0; h4 < 8; ++h4) { const f32x4 b4 = *(const f32x4*)(bb + (q * 16 + 2 * h4) * 2); s[2 * h4] += xr * b4[0] - xi * b4[1]; s[2 * h4 + 1] += xr * b4[2] - xi * b4[3]; }
            }
#pragma unroll
            for (int h4 = 0; h4 < 4; ++h4) *(f32x4*)(Kt + lag * 256 + hp * 16 + 4 * h4) = (f32x4){s[4 * h4], s[4 * h4 + 1], s[4 * h4 + 2], s[4 * h4 + 3]};
        }
        __syncthreads();
        bf16_t* tf = TF + (size_t)it * 512 * 640;
        for (int o = part * 256 * 320 + tid; o < (part + 1) * 256 * 320; o += 512) {
            const int row = o / 320, c2 = (o - row * 320) * 2, t = row >> 4, hp = row & 15;
            float v[2];
            if (c2 < 512) {
#pragma unroll
                for (int e = 0; e < 2; ++e) { const int col = c2 + e, s = col >> 4, h = col & 15; const int lag = dir == 0 ? t - s : s - t; v[e] = lag >= 0 ? Kt[lag * 256 + hp * 16 + h] : 0.f; }
            } else {
                const int q = (c2 - 512) >> 1, m = dir == 0 ? t + 1 : 32 - t;
                const float cr = cc[(hp * 64 + q) * 2], ci = cc[(hp * 64 + q) * 2 + 1], wr_ = pw[(m * 64 + q) * 2], wi = pw[(m * 64 + q) * 2 + 1];
                v[0] = cr * wr_ - ci * wi; v[1] = -(cr * wi + ci * wr_);
            }
            *(unsigned*)(tf + (size_t)row * 640 + c2) = pk2(v[0], v[1]);
        }
        bf16_t* e2 = E2 + ((size_t)g * 256 + dir * 128) * 512;
        for (int o = part * 64 * 256 + tid; o < (part + 1) * 64 * 256; o += 512) {
            const int row = o >> 8, c2 = (o & 255) * 2, q = row >> 1, ri = row & 1; float v[2];
#pragma unroll
            for (int e = 0; e < 2; ++e) { const int col = c2 + e, s = col >> 4, h = col & 15, ex = dir == 0 ? 31 - s : s;
                const float wr_ = pw[(ex * 64 + q) * 2], wi = pw[(ex * 64 + q) * 2 + 1], br = bb[(q * 16 + h) * 2], bi = bb[(q * 16 + h) * 2 + 1];
                v[e] = ri == 0 ? (wr_ * br - wi * bi) : (wr_ * bi + wi * br); }
            *(unsigned*)(e2 + (size_t)row * 512 + c2) = pk2(v[0], v[1]);
        }
        __syncthreads();
    }
}

__device__ __forceinline__ void phase_norm(const PP& p, int l, int which, const float* xsrc, const float* csrc, int share) {
    const int nwb = (int)gridDim.x - (share ? n_coef_blocks() : 0);
    if (bidx() >= nwb) return;
    const int lane = tid_of(p.wv) & 63, gw = bidx() * 8 + (tid_of(p.wv) >> 6), nw = nwb * 8;
    const float* gain = p.in[which == 0 ? I_N1G : I_N2G] + l * 1024;
    const float* mod = (const float*)(p.ws + OFF_MOD) + (size_t)l * 5 * 6144;
    bf16_t* H = (bf16_t*)(p.ws + OFF_H);
    for (int r = gw; r < MROWS; r += nw) {
        const int b = r / TT, j = r - b * TT;
        const float* src = j < CTX ? csrc + ((size_t)b * CTX + j) * DM : xsrc + ((size_t)b * SEQ + (j - CTX)) * DM;
        const float* mv = mod + (size_t)(j < CTX ? 4 : b) * 6144 + (which == 0 ? 0 : 3072);
        f32x4 v[4]; float ss = 0.f;
#pragma unroll
        for (int i = 0; i < 4; ++i) { v[i] = *(const f32x4*)(src + i * 256 + lane * 4); ss += v[i][0] * v[i][0] + v[i][1] * v[i][1] + v[i][2] * v[i][2] + v[i][3] * v[i][3]; }
        ss = red64(ss);
        const float rs = __builtin_amdgcn_rsqf(ss * (1.f / 1024.f) + 1e-6f);
#pragma unroll
        for (int i = 0; i < 4; ++i) {
            const int c = i * 256 + lane * 4;
            const f32x4 gv = *(const f32x4*)(gain + c), sh = *(const f32x4*)(mv + c), sc = *(const f32x4*)(mv + 1024 + c);
            const f32x4 y = v[i] * rs * gv * (sc + 1.f) + sh;
            *(u32x2*)(H + (size_t)r * DM + c) = pk4(y);
        }
    }
}
__device__ __forceinline__ void phase_final(const PP& p) {
    const int lane = tid_of(p.wv) & 63, gw = bidx() * 8 + (tid_of(p.wv) >> 6), nw = gridDim.x * 8;
    const float* gain = p.in[I_FG];
    for (int r = gw; r < NB * SEQ; r += nw) {
        float* src = p.out + (size_t)r * DM;
        f32x4 v[4]; float ss = 0.f;
#pragma unroll
        for (int i = 0; i < 4; ++i) { v[i] = *(const f32x4*)(src + i * 256 + lane * 4); ss += v[i][0] * v[i][0] + v[i][1] * v[i][1] + v[i][2] * v[i][2] + v[i][3] * v[i][3]; }
        ss = red64(ss);
        const float rs = __builtin_amdgcn_rsqf(ss * (1.f / 1024.f) + 1e-6f);
#pragma unroll
        for (int i = 0; i < 4; ++i) { const int c = i * 256 + lane * 4; const f32x4 gv = *(const f32x4*)(gain + c); *(f32x4*)(src + c) = v[i] * rs * gv; }
    }
}

struct Nb3 { u32x2 pv, cu, nx; };
__device__ __forceinline__ Nb3 ld3(const bf16_t* Z, int row, bool hp, bool hn, int col) {
    Nb3 o; const bf16_t* q = Z + (size_t)row * ZLD + col;
    o.cu = *(const u32x2*)q;
    o.pv = hp ? *(const u32x2*)(q - ZLD) : (u32x2){0u, 0u};
    o.nx = hn ? *(const u32x2*)(q + ZLD) : (u32x2){0u, 0u};
    return o;
}
__device__ __forceinline__ f32x4 shiftmix(const Nb3& v, const float* mu) {
    const f32x4 c = unpk4(v.cu), a = unpk4(v.pv), n = unpk4(v.nx), m = *(const f32x4*)mu;
    return c + ((a + n) * 0.5f - c) * m;
}


constexpr int RWP_LD = 896;
__device__ __forceinline__ void phase_rwprep(const PP& p, int l) {
    const bf16_t* Z = (const bf16_t*)(p.ws + OFF_Z);
    bf16_t* RWP = (bf16_t*)(p.ws + OFF_H);
    const float* mu = p.in[I_MU] + l * 1408;
    const int nth = gridDim.x * 512;
    for (int idx = bidx() * 512 + tid_of(p.wv); idx < MROWS * 112; idx += nth) {
        const int row = idx / 112, qd = idx - row * 112, col0 = 8 * qd, zc = col0 < 768 ? col0 : col0 + 384;
        const int b = row / TT, j = row - b * TT;
        const bool hp = (j != 0) && (j != CTX), hn = (j != CTX - 1) && (j != TT - 1);
        const bf16_t* q = Z + (size_t)row * ZLD + zc;
        const u32x4 cu = *(const u32x4*)q;
        const u32x4 pv = hp ? *(const u32x4*)(q - ZLD) : (u32x4){0u, 0u, 0u, 0u};
        const u32x4 nx = hn ? *(const u32x4*)(q + ZLD) : (u32x4){0u, 0u, 0u, 0u};
        const f32x4 m0 = *(const f32x4*)(mu + zc), m1 = *(const f32x4*)(mu + zc + 4);
        const f32x4 c0 = (f32x4){bflo(cu.x), bfhi(cu.x), bflo(cu.y), bfhi(cu.y)}, c1 = (f32x4){bflo(cu.z), bfhi(cu.z), bflo(cu.w), bfhi(cu.w)};
        const f32x4 a0 = (f32x4){bflo(pv.x), bfhi(pv.x), bflo(pv.y), bfhi(pv.y)}, a1 = (f32x4){bflo(pv.z), bfhi(pv.z), bflo(pv.w), bfhi(pv.w)};
        const f32x4 n0 = (f32x4){bflo(nx.x), bfhi(nx.x), bflo(nx.y), bfhi(nx.y)}, n1 = (f32x4){bflo(nx.z), bfhi(nx.z), bflo(nx.w), bfhi(nx.w)};
        f32x4 v0 = c0 + ((a0 + n0) * 0.5f - c0) * m0, v1 = c1 + ((a1 + n1) * 0.5f - c1) * m1;
        if (col0 >= 768 && col0 < 832) {
#pragma unroll
            for (int i = 0; i < 4; ++i) { v0[i] = tanhf_(v0[i]); v1[i] = tanhf_(v1[i]); }
        }
        u32x4 o; o.x = pk2(v0[0], v0[1]); o.y = pk2(v0[2], v0[3]); o.z = pk2(v1[0], v1[1]); o.w = pk2(v1[2], v1[3]);
        *(u32x4*)(RWP + (size_t)row * RWP_LD + col0) = o;
    }
}

namespace ck {
constexpr int PC_STRIDE = 18432, PCB_BYTES = 36864, WKS0 = 73728, WKS_BYTES = 9216, WKP0 = 110592, WKP_BYTES = 3072, SW0 = 116736, SAA0 = 134144, SY0 = 151552, CST0 = 159744, SWLD = 68, SWBUF = 32 * 68;
__device__ __forceinline__ bf16x8 mk8(u32x2 lo, u32x2 hi) { u32x4 t; t.x = lo.x; t.y = lo.y; t.z = hi.x; t.w = hi.y; return __builtin_bit_cast(bf16x8, t); }
__device__ __forceinline__ bf16x8 pk8z(f32x4 v) { return mk8(pk4(v), (u32x2){0u, 0u}); }
#define CK_MFMA(a, b, c) __builtin_amdgcn_mfma_f32_16x16x32_bf16(a, b, c, 0, 0, 0)
__device__ __forceinline__ int krow(int k) { return (k & ~3) | ((k + (k >> 3)) & 3); }
template <int TYPE, bool MIDBAR>
__device__ __forceinline__ void prep_wave(const char* pc, char* wkp, char* wks, int lane) {
    const int row16 = lane & 15, q = lane >> 4;
    const u32x2 Z2 = (u32x2){0u, 0u};
    const f32x4 z4 = (f32x4){0.f, 0.f, 0.f, 0.f};
    float* AMak = (float*)wkp; float* AMrb = (float*)(wkp + 1024); float* AMrk = (float*)(wkp + 2048);
    bf16_t* W1row = (bf16_t*)wks; bf16_t* R2row = (bf16_t*)(wks + 2304);
    const bf16_t* GA = (const bf16_t*)pc; const bf16_t* GR = (const bf16_t*)(pc + 2304); const bf16_t* GB = (const bf16_t*)(pc + 4608);
    const bf16_t* GK = (const bf16_t*)(pc + (TYPE == 0 ? 6912 : 4608));
    const bf16_t* GAT = (const bf16_t*)(pc + 9216); const bf16_t* VT = (const bf16_t*)(pc + 15360);
    const float* gc = (const float*)(pc + 17408);
    f32x4 gab = z4, gabT = z4, gak = z4, grb = z4, grk = z4;
#pragma unroll
    for (int ks = 0; ks < 2; ++ks) {
        const int o = row16 * 72 + 8 * q + 32 * ks;
        const bf16x8 ra = *(const bf16x8*)(GA + o), rr = *(const bf16x8*)(GR + o), cbf = *(const bf16x8*)(GB + o), ckf = *(const bf16x8*)(GK + o);
        gab = CK_MFMA(ra, cbf, gab); gabT = CK_MFMA(cbf, ra, gabT); gak = CK_MFMA(ra, ckf, gak); grb = CK_MFMA(rr, cbf, grb); grk = CK_MFMA(rr, ckf, grk);
    }
#pragma unroll
    for (int r = 0; r < 4; ++r) {
        const int t = 4 * q + r, i = row16; const bool ks_ = i < t, kl = i <= t;
        float dS = 1.f, dL = 1.f, dT = 1.f;
        if (TYPE == 1) { const float gi = gc[i]; dS = __expf(ks_ ? gc[t > 0 ? t - 1 : 0] - gi : 0.f); dL = __expf(kl ? gc[t] - gi : 0.f);
                         const int t2 = row16, i2 = 4 * q + r; dT = __expf(i2 < t2 ? gc[t2 - 1] - gc[i2] : 0.f); }
        gab[r] = ks_ ? gab[r] * dS : 0.f; gak[r] = ks_ ? gak[r] * dS : 0.f; grb[r] = kl ? grb[r] * dL : 0.f; grk[r] = kl ? grk[r] * dL : 0.f;
        gabT[r] = (4 * q + r < row16) ? gabT[r] * dT : 0.f;
    }
    f32x4 A = gab, AT = gabT, MT;
#pragma unroll
    for (int r = 0; r < 4; ++r) MT[r] = AT[r] + ((4 * q + r == row16) ? 1.f : 0.f);
#pragma unroll
    for (int s = 0; s < 3; ++s) {
        const bf16x8 pa = pk8z(A), pat = pk8z(AT);
        const f32x4 A2 = CK_MFMA(pat, pa, z4);
        MT = CK_MFMA(pk8z(A2), pk8z(MT), MT);
        if (s < 2) { AT = CK_MFMA(pa, pat, z4); A = A2; }
    }
    if (MIDBAR) lbar();
    const bf16x8 mplain = pk8z(MT);
    bf16x8 mfA = mplain;
    if (TYPE == 1) mfA = pk8z(MT * *(const f32x4*)(gc + 32 + 4 * q));
#pragma unroll
    for (int r = 0; r < 4; ++r) { AMak[(4 * q + r) * 16 + row16] = gak[r]; AMrb[(4 * q + r) * 16 + row16] = grb[r]; AMrk[(4 * q + r) * 16 + row16] = grk[r]; }
    const f32x4 aak4 = *(const f32x4*)(AMak + row16 * 16 + 4 * q), arb4 = *(const f32x4*)(AMrb + row16 * 16 + 4 * q), ark4 = *(const f32x4*)(AMrk + row16 * 16 + 4 * q);
    const bf16x8 arbB = pk8z(arb4);
#pragma unroll
    for (int nt = 0; nt < 4; ++nt) {
        const bf16x8 gfB = mk8(*(const u32x2*)(GAT + krow(16 * nt + row16) * 16 + 4 * q), Z2);
        const f32x4 W1n = CK_MFMA(mfA, gfB, z4);
        const f32x4 W1T = CK_MFMA(gfB, mfA, z4);
        *(u32x2*)(W1row + row16 * 72 + 16 * nt + 4 * q) = pk4(W1T);
        f32x4 cin = unpk4(*(const u32x2*)(GR + row16 * 72 + 16 * nt + 4 * q));
        if (TYPE == 1) cin = cin * gc[16 + row16];
        const f32x4 R2T = CK_MFMA(pk8z(W1n), arbB, cin);
        *(u32x2*)(R2row + row16 * 72 + 16 * nt + 4 * q) = pk4(R2T);
    }
    const bf16x8 aakA = pk8z(aak4), arbk = mk8(pk4(arb4), pk4(ark4));
#pragma unroll
    for (int vt = 0; vt < 2; ++vt) {
        const u32x2 vtf = *(const u32x2*)(VT + krow(16 * vt + row16) * 16 + 4 * q);
        const f32x4 AV = CK_MFMA(aakA, mk8(vtf, Z2), z4);
        const f32x4 W2 = CK_MFMA(mplain, pk8z(AV), z4);
        const f32x4 Y3 = CK_MFMA(arbk, mk8(pk4(W2), vtf), z4);
        f32x4* C2 = (f32x4*)(wks + 4608 + vt * 2048);
        C2[lane] = W2; C2[64 + lane] = Y3;
    }
}
template <int TYPE>
__device__ __forceinline__ void seq_wave(const char* pc, const char* wks, float* sYc, int vt, int lane, f32x4 (&Sreg)[4]) {
    const int row16 = lane & 15, q = lane >> 4;
    const bf16_t* W1row = (const bf16_t*)wks; const bf16_t* R2row = (const bf16_t*)(wks + 2304); const f32x4* C2 = (const f32x4*)(wks + 4608 + vt * 2048);
    const bf16_t* GBT = (const bf16_t*)(pc + 11264); const bf16_t* GKT = (const bf16_t*)(pc + (TYPE == 0 ? 13312 : 11264)); const bf16_t* VST = (const bf16_t*)(pc + 16384);
    const float* gc = (const float*)(pc + 17408); const float* pC = (const float*)(pc + 17664);
    f32x4 U = C2[lane], Y = C2[64 + lane];
#pragma unroll
    for (int ks = 0; ks < 2; ++ks) {
        const bf16x8 sf = mk8(pk4(Sreg[2 * ks]), pk4(Sreg[2 * ks + 1]));
        const bf16x8 a1 = mk8(*(const u32x2*)(W1row + row16 * 72 + 32 * ks + 4 * q), *(const u32x2*)(W1row + row16 * 72 + 32 * ks + 16 + 4 * q));
        const bf16x8 a2 = mk8(*(const u32x2*)(R2row + row16 * 72 + 32 * ks + 4 * q), *(const u32x2*)(R2row + row16 * 72 + 32 * ks + 16 + 4 * q));
        U = CK_MFMA(a1, sf, U);
        Y = CK_MFMA(a2, sf, Y);
    }
#pragma unroll
    for (int r = 0; r < 4; ++r) sYc[(4 * q + r) * 32 + 16 * vt + row16] = Y[r];
    if (TYPE == 1) U = U * *(const f32x4*)(gc + 48 + 4 * q);
    const bf16x8 ub = mk8(pk4(U), *(const u32x2*)(VST + krow(16 * vt + row16) * 16 + 4 * q));
#pragma unroll
    for (int kt = 0; kt < 4; ++kt) {
        const bf16x8 ak = mk8(*(const u32x2*)(GBT + krow(16 * kt + row16) * 16 + 4 * q), *(const u32x2*)(GKT + krow(16 * kt + row16) * 16 + 4 * q));
        const f32x4 pc4 = *(const f32x4*)(pC + 16 * kt + 4 * q);
        if (TYPE == 0) Sreg[kt] = CK_MFMA(ak, ub, Sreg[kt]) * pc4;
        else Sreg[kt] = CK_MFMA(ak, ub, Sreg[kt] * pc4);
    }
}
template <int TYPE, class F>
__device__ __forceinline__ void seq_role(char* cb, int vt, int lane, F&& extra) {
    f32x4 Sreg[4];
#pragma unroll
    for (int i = 0; i < 4; ++i) Sreg[i] = (f32x4){0.f, 0.f, 0.f, 0.f};
    extra(0); lbar(); extra(1); lbar();
    for (int k = 0; k <= NCH; ++k) {
        if (k > 0) {
            const int kb = k - 1;
            seq_wave<TYPE>(cb + (kb & 1) * PCB_BYTES, cb + WKS0 + ((kb & 1) * 2 + 0) * WKS_BYTES, (float*)(cb + SY0 + (kb & 1) * 4096), vt, lane, Sreg);
            seq_wave<TYPE>(cb + (kb & 1) * PCB_BYTES + PC_STRIDE, cb + WKS0 + ((kb & 1) * 2 + 1) * WKS_BYTES, (float*)(cb + SY0 + (kb & 1) * 4096) + 16 * 32, vt, lane, Sreg);
        }
        lbar();
        extra(k + 2);
        lbar();
    }
}
template <int TYPE>
__device__ __forceinline__ void prep_role(char* cb, int c, int lane) {
    lbar(); lbar();
    for (int k = 0; k <= NCH; ++k) {
        if (k < NCH) prep_wave<TYPE, true>(cb + (k & 1) * PCB_BYTES + c * PC_STRIDE, cb + WKP0 + c * WKP_BYTES, cb + WKS0 + ((k & 1) * 2 + c) * WKS_BYTES, lane);
        else lbar();
        lbar();
    }
}
__device__ __forceinline__ float red8(float x) { x += dppf<0xB1>(x); x += dppf<0x4E>(x); x += dppf<0x141>(x); return x; }
__device__ __forceinline__ void st8T(bf16_t* base, int row0, int t, u32x4 v) {
    const int r = row0 >> 3;
    base[(row0 + 0 + ((0 + r) & 3)) * 16 + t] = (bf16_t)v.x; base[(row0 + 0 + ((1 + r) & 3)) * 16 + t] = (bf16_t)(v.x >> 16); base[(row0 + 0 + ((2 + r) & 3)) * 16 + t] = (bf16_t)v.y; base[(row0 + 0 + ((3 + r) & 3)) * 16 + t] = (bf16_t)(v.y >> 16);
    base[(row0 + 4 + ((0 + r) & 3)) * 16 + t] = (bf16_t)v.z; base[(row0 + 4 + ((1 + r) & 3)) * 16 + t] = (bf16_t)(v.z >> 16); base[(row0 + 4 + ((2 + r) & 3)) * 16 + t] = (bf16_t)v.w; base[(row0 + 4 + ((3 + r) & 3)) * 16 + t] = (bf16_t)(v.w >> 16);
}
__device__ __forceinline__ u32x4 pk8(const f32x4& a, const f32x4& b) { u32x4 r; r.x = pk2(a[0], a[1]); r.y = pk2(a[2], a[3]); r.z = pk2(b[0], b[1]); r.w = pk2(b[2], b[3]); return r; }
__device__ __forceinline__ void unpk8(u32x4 v, f32x4& a, f32x4& b) { a = (f32x4){bflo(v.x), bfhi(v.x), bflo(v.y), bfhi(v.y)}; b = (f32x4){bflo(v.z), bfhi(v.z), bflo(v.w), bfhi(v.w)}; }
}

__device__ __forceinline__ void rwkv_job(const PP& p, int l, int job, float* sm) {
    char* cb = (char*)sm;
    float* sW = (float*)(cb + ck::SW0); float* sAA = (float*)(cb + ck::SAA0); float* cst = (float*)(cb + ck::CST0);
    const int half = job & 1, dir = (job >> 1) & 1, bh = job >> 2, b = bh / 6, h = bh - b * 6;
    const int tid = tid_of(p.wv), w = tid >> 6, lane = tid & 63;
    const bf16_t* Z = (const bf16_t*)(p.ws + OFF_Z); const bf16_t* RWP = (const bf16_t*)(p.ws + OFF_H);
    bf16_t* Y = (bf16_t*)(p.ws + OFF_YO) + (size_t)dir * MROWS * 384;
    float* BC = (float*)(p.ws + OFF_BC) + (size_t)dir * MROWS * 6;
    if (tid < 64) { cst[tid] = p.in[I_KK][l * 384 + h * 64 + tid]; cst[64 + tid] = p.in[I_KA][l * 384 + h * 64 + tid]; cst[128 + tid] = p.in[I_RK][l * 384 + h * 64 + tid];
        cst[192 + tid] = p.in[I_MU][l * 1408 + 768 + h * 64 + tid];
        cst[256 + tid] = p.in[I_W0][((size_t)l * 2 + dir) * 384 + h * 64 + tid]; cst[320 + tid] = p.in[I_A0][((size_t)l * 2 + dir) * 384 + h * 64 + tid]; }
    lbar();
    if (w < 2) ck::prep_role<0>(cb, w, lane);
    else if (w == 4 || w == 5) {
        const int mt = w - 4, fr = lane & 15, fq = lane >> 4;
        bf16x8 wfw[4][2], wfa[4][2];
#pragma unroll
        for (int nt = 0; nt < 4; ++nt) {
            const bf16_t* wu = (const bf16_t*)(p.ws + OFF_WUP) + ((size_t)dir * 384 + h * 64 + nt * 16 + fr) * 64 + fq * 8;
            const bf16_t* au = (const bf16_t*)(p.ws + OFF_AUP) + ((size_t)dir * 384 + h * 64 + nt * 16 + fr) * 64 + fq * 8;
            wfw[nt][0] = *(const bf16x8*)wu; wfw[nt][1] = *(const bf16x8*)(wu + 32); wfa[nt][0] = *(const bf16x8*)au; wfa[nt][1] = *(const bf16x8*)(au + 32);
        }
        bf16x8 xw[2], xa[2];
        auto loadm = [&](int blk) {
            if (blk < NCH) {
                const int jm = seqpos(dir, blk * 32 + mt * 16 + fr);
                const bf16_t* mp = RWP + (size_t)(b * TT + jm) * RWP_LD + 768 + fq * 8;
                xw[0] = *(const bf16x8*)mp; xw[1] = *(const bf16x8*)(mp + 32); xa[0] = *(const bf16x8*)(mp + 64); xa[1] = *(const bf16x8*)(mp + 96);
            }
        };
        loadm(0);
        auto lora = [&](int blk) {
            if (blk >= NCH) return;
            float* sWb = sW + (blk & 1) * ck::SWBUF; float* sAb = sAA + (blk & 1) * ck::SWBUF;
#pragma unroll
            for (int nt = 0; nt < 4; ++nt) {
                f32x4 aw = (f32x4){0.f, 0.f, 0.f, 0.f}, aa = aw;
#pragma unroll
                for (int ks = 0; ks < 2; ++ks) { aw = CK_MFMA(xw[ks], wfw[nt][ks], aw); aa = CK_MFMA(xa[ks], wfa[nt][ks], aa); }
                const float w0s = cst[256 + nt * 16 + fr], a0s = cst[320 + nt * 16 + fr];
                f32x4 G = (f32x4){0.f, 0.f, 0.f, 0.f};
#pragma unroll
                for (int i = 0; i < 4; ++i) {
                    const float lw = -0.6065306597126334f * sigmoidf_(aw[i] + w0s);
                    G = __builtin_amdgcn_mfma_f32_16x16x4f32((4 * fq + i <= fr) ? 1.f : 0.f, lw, G, 0, 0, 0);
                }
#pragma unroll
                for (int i = 0; i < 4; ++i) {
                    sWb[(mt * 16 + 4 * fq + i) * ck::SWLD + nt * 16 + fr] = G[i];
                    sAb[(mt * 16 + 4 * fq + i) * ck::SWLD + nt * 16 + fr] = sigmoidf_(aa[i] + a0s);
                }
            }
            loadm(blk + 1);
        };
        ck::seq_role<0>(cb, w - 4, lane, lora);
    }

    else {
        const int ew = (w & 1) + ((w >> 2) << 1);
        const int stid = ew * 64 + lane, es = stid >> 3, c8 = stid & 7, ec = h * 64 + 8 * c8, c = es >> 4, t = es & 15;
        struct PF { u32x4 r, k, vp, vc, vn; int row; };
        PF setA, setB;
        const float* sW_ = sW; const float* sAA_ = sAA;
        auto prefetch = [&](PF& s, int blk) {
            if (blk < NCH) {
                const int j = seqpos(dir, blk * 32 + es);
                const bool hp = (j != 0) && (j != CTX), hn = (j != CTX - 1) && (j != TT - 1);
                s.row = b * TT + j;
                const bf16_t* rp = RWP + (size_t)s.row * RWP_LD;
                s.r = *(const u32x4*)(rp + ec); s.k = *(const u32x4*)(rp + 384 + ec);
                const bf16_t* zp = Z + (size_t)s.row * ZLD + 768 + ec;
                s.vc = *(const u32x4*)zp; s.vp = hp ? *(const u32x4*)(zp - ZLD) : (u32x4){0u, 0u, 0u, 0u}; s.vn = hn ? *(const u32x4*)(zp + ZLD) : (u32x4){0u, 0u, 0u, 0u};
            }
        };
        auto flush = [&](int blk) {
            const float* sYb = (const float*)(cb + ck::SY0 + (blk & 1) * 4096);
            const int s = stid >> 3, v4 = (stid & 7) * 4, j = seqpos(dir, blk * 32 + s);
            *(u32x2*)(Y + (size_t)(b * TT + j) * 384 + h * 64 + half * 32 + v4) = pk4(*(const f32x4*)(sYb + s * 32 + v4));
        };
        auto stage = [&](int blk, PF& ps) {
            f32x4 r0, r1, k0, k1, v0, v1;
            ck::unpk8(ps.r, r0, r1); ck::unpk8(ps.k, k0, k1);
            {
                f32x4 a0, a1, c0, c1, n0, n1; ck::unpk8(ps.vp, a0, a1); ck::unpk8(ps.vc, c0, c1); ck::unpk8(ps.vn, n0, n1);
                const f32x4 m0 = *(const f32x4*)(cst + 192 + 8 * c8), m1 = *(const f32x4*)(cst + 196 + 8 * c8);
                v0 = c0 + ((a0 + n0) * 0.5f - c0) * m0; v1 = c1 + ((a1 + n1) * 0.5f - c1) * m1;
            }
            const int myrow = ps.row;
            u32x4 ga, gr, gb, gk, vb; f32x4 x0, x1; float bon;
            auto comp = [&]() {
                const float* sW = sW_ + (blk & 1) * ck::SWBUF; const float* sAA = sAA_ + (blk & 1) * ck::SWBUF;
                const f32x4 a40 = *(const f32x4*)(sAA + es * ck::SWLD + 8 * c8), a41 = *(const f32x4*)(sAA + es * ck::SWLD + 8 * c8 + 4);
                const f32x4 kd0 = k0 * ((a40 - 1.f) * *(const f32x4*)(cst + 64 + 8 * c8) + 1.f), kd1 = k1 * ((a41 - 1.f) * *(const f32x4*)(cst + 68 + 8 * c8) + 1.f);
                const f32x4 kk0 = k0 * *(const f32x4*)(cst + 8 * c8), kk1 = k1 * *(const f32x4*)(cst + 4 + 8 * c8);
                const float ssq = ck::red8(kk0[0] * kk0[0] + kk0[1] * kk0[1] + kk0[2] * kk0[2] + kk0[3] * kk0[3] + kk1[0] * kk1[0] + kk1[1] * kk1[1] + kk1[2] * kk1[2] + kk1[3] * kk1[3]);
                const float rn = __builtin_amdgcn_rsqf(ssq + 1e-6f);
                const f32x4 kn0 = kk0 * rn, kn1 = kk1 * rn;
                const f32x4 tb0 = r0 * kd0 * *(const f32x4*)(cst + 128 + 8 * c8), tb1 = r1 * kd1 * *(const f32x4*)(cst + 132 + 8 * c8);
                bon = ck::red8(tb0[0] + tb0[1] + tb0[2] + tb0[3] + tb1[0] + tb1[1] + tb1[2] + tb1[3]);
                const f32x4 G0 = *(const f32x4*)(sW + es * ck::SWLD + 8 * c8), G1 = *(const f32x4*)(sW + es * ck::SWLD + 8 * c8 + 4);
                const f32x4 T0 = *(const f32x4*)(sW + (16 * c + 15) * ck::SWLD + 8 * c8), T1 = *(const f32x4*)(sW + (16 * c + 15) * ck::SWLD + 8 * c8 + 4);
                f32x4 L0 = (f32x4){0.f, 0.f, 0.f, 0.f}, L1 = L0;
                if (t > 0) { L0 = *(const f32x4*)(sW + (es - 1) * ck::SWLD + 8 * c8); L1 = *(const f32x4*)(sW + (es - 1) * ck::SWLD + 8 * c8 + 4); }
                f32x4 P0, P1, Q0, Q1, I0, I1;
#pragma unroll
                for (int e = 0; e < 4; ++e) { P0[e] = __expf(G0[e]); P1[e] = __expf(G1[e]); Q0[e] = __expf(L0[e]); Q1[e] = __expf(L1[e]); I0[e] = __expf(-G0[e]); I1[e] = __expf(-G1[e]); x0[e] = __expf(T0[e]); x1[e] = __expf(T1[e]); }
                ga = ck::pk8(-kn0 * Q0, -kn1 * Q1); gb = ck::pk8(kn0 * a40 * I0, kn1 * a41 * I1); gk = ck::pk8(kd0 * I0, kd1 * I1); gr = ck::pk8(r0 * P0, r1 * P1);
                vb = ck::pk8(v0, v1);
            };
            if (blk > 0) comp();
            lbar();
            if (blk == 0) comp();
            prefetch(ps, blk + 2);
            if (blk > 1) flush(blk - 2);
            char* pc = cb + (blk & 1) * ck::PCB_BYTES + c * ck::PC_STRIDE;
            if (c8 == 0 && half == 0) BC[(size_t)myrow * 6 + h] = bon;
            *(u32x4*)(pc + (t * 72 + 8 * c8) * 2) = ga;
            *(u32x4*)(pc + 2304 + (t * 72 + 8 * c8) * 2) = gr;
            *(u32x4*)(pc + 4608 + (t * 72 + 8 * c8) * 2) = gb;
            *(u32x4*)(pc + 6912 + (t * 72 + 8 * c8) * 2) = gk;
            ck::st8T((bf16_t*)(pc + 9216), 8 * c8, t, ga); ck::st8T((bf16_t*)(pc + 11264), 8 * c8, t, gb); ck::st8T((bf16_t*)(pc + 13312), 8 * c8, t, gk);
            if (t == 15) { *(f32x4*)(pc + 17664 + 32 * c8) = x0; *(f32x4*)(pc + 17664 + 32 * c8 + 16) = x1; }
            if ((c8 >> 2) == half) { ck::st8T((bf16_t*)(pc + 15360), 8 * c8 - 32 * half, t, vb); ck::st8T((bf16_t*)(pc + 16384), 8 * c8 - 32 * half, t, vb); }
            lbar();
        };
        prefetch(setA, 0); prefetch(setB, 1);
        stage(0, setA);
        for (int k = 0; k < NCH; k += 2) {
            if (k + 1 < NCH) stage(k + 1, setB); else { lbar(); lbar(); }
            if (k + 2 < NCH) stage(k + 2, setA); else { lbar(); lbar(); }
        }
        lbar(); lbar();
        flush(NCH - 2); flush(NCH - 1);
    }
}

__device__ __forceinline__ void gdn_job(const PP& p, int l, int job, float* sm) {
    char* cb = (char*)sm;
    float* sSC = (float*)(cb + ck::SW0);
    float* cst = (float*)(cb + ck::CST0);
    const int half = job & 1, dir = (job >> 1) & 1, bh = job >> 2, b = bh / 6, h = bh - b * 6;
    const int tid = tid_of(p.wv), w = tid >> 6, lane = tid & 63;
    const bf16_t* Z = (const bf16_t*)(p.ws + OFF_Z);
    bf16_t* Y = (bf16_t*)(p.ws + OFF_YO) + (size_t)(2 + dir) * MROWS * 384;
    for (int i = tid; i < 576; i += 512) { const int a = i >> 6, cc = i & 63; cst[i] = p.in[I_CONV][(size_t)l * 3 * 1152 + (a / 3) * 1152 + (a % 3) * 384 + h * 64 + cc]; }
    lbar();
    if (w < 2) ck::prep_role<1>(cb, w, lane);
    else if (w == 2 || w == 3) ck::seq_role<1>(cb, w - 2, lane, [](int) {});
    else {
        const int ew = w - 4;
        const int stid = ew * 64 + lane, es = stid >> 3, c8 = stid & 7, ec = h * 64 + 8 * c8, c = es >> 4, t = es & 15;
        const float aexp = __expf(p.in[I_ALOG][((size_t)l * 2 + dir) * 6 + h]), dtb = p.in[I_DTB][((size_t)l * 2 + dir) * 6 + h];
        struct PF { u32x4 x[3][3]; bf16_t be, ai; };
        PF setA, setB;
        auto prefetch = [&](PF& s, int blk) {
            if (blk < NCH) {
                const int j = seqpos(dir, blk * 32 + es);
                const bool hp = (j != 0) && (j != CTX), hn = (j != CTX - 1) && (j != TT - 1);
                const bf16_t* zp = Z + (size_t)(b * TT + j) * ZLD + 1408 + ec;
#pragma unroll
                for (int a = 0; a < 3; ++a) {
                    s.x[a][1] = *(const u32x4*)(zp + a * 384);
                    s.x[a][0] = hp ? *(const u32x4*)(zp + a * 384 - ZLD) : (u32x4){0u, 0u, 0u, 0u};
                    s.x[a][2] = hn ? *(const u32x4*)(zp + a * 384 + ZLD) : (u32x4){0u, 0u, 0u, 0u};
                }
                s.be = zp[1152 - ec + dir * 6 + h]; s.ai = zp[1164 - ec + dir * 6 + h];
            }
        };
        auto flush = [&](int blk) {
            const float* sYb = (const float*)(cb + ck::SY0 + (blk & 1) * 4096);
            const int s = stid >> 3, v4 = (stid & 7) * 4, j = seqpos(dir, blk * 32 + s);
            *(u32x2*)(Y + (size_t)(b * TT + j) * 384 + h * 64 + half * 32 + v4) = pk4(*(const f32x4*)(sYb + s * 32 + v4));
        };
        auto stage = [&](int blk, PF& ps) {
            f32x4 o[3][2];
#pragma unroll
            for (int a = 0; a < 3; ++a) {
                f32x4 p0, p1, c0, c1, n0, n1; ck::unpk8(ps.x[a][0], p0, p1); ck::unpk8(ps.x[a][1], c0, c1); ck::unpk8(ps.x[a][2], n0, n1);
                o[a][0] = p0 * *(const f32x4*)(cst + (0 * 3 + a) * 64 + 8 * c8) + c0 * *(const f32x4*)(cst + (1 * 3 + a) * 64 + 8 * c8) + n0 * *(const f32x4*)(cst + (2 * 3 + a) * 64 + 8 * c8);
                o[a][1] = p1 * *(const f32x4*)(cst + (0 * 3 + a) * 64 + 8 * c8 + 4) + c1 * *(const f32x4*)(cst + (1 * 3 + a) * 64 + 8 * c8 + 4) + n1 * *(const f32x4*)(cst + (2 * 3 + a) * 64 + 8 * c8 + 4);
#pragma unroll
                for (int e = 0; e < 4; ++e) { o[a][0][e] = siluf_(o[a][0][e]); o[a][1][e] = siluf_(o[a][1][e]); }
            }
            float sq = 0.f, sk = 0.f;
#pragma unroll
            for (int e = 0; e < 4; ++e) { sq += o[0][0][e] * o[0][0][e] + o[0][1][e] * o[0][1][e]; sk += o[1][0][e] * o[1][0][e] + o[1][1][e] * o[1][1][e]; }
            sq = ck::red8(sq); sk = ck::red8(sk);
            const float qn = __builtin_amdgcn_rsqf(sq + 1e-6f) * 0.125f, kn = __builtin_amdgcn_rsqf(sk + 1e-6f);
            const f32x4 q0 = o[0][0] * qn, q1 = o[0][1] * qn, k0 = o[1][0] * kn, k1 = o[1][1] * kn;
            const float beta = sigmoidf_(bf2f(ps.be));
            const float xg = bf2f(ps.ai) + dtb; const float gl = -aexp * (xg > 20.f ? xg : __logf(1.f + __expf(xg)));
            if (c8 == 0) { sSC[es * 4] = beta; sSC[es * 4 + 1] = gl; }
            lbar();
            prefetch(ps, blk + 2);
            if (blk > 1) flush(blk - 2);
            char* pc = cb + (blk & 1) * ck::PCB_BYTES + c * ck::PC_STRIDE;
            float g = 0.f, gm1 = 0.f, gt = 0.f;
#pragma unroll
            for (int i = 0; i < 16; ++i) { const float lg = sSC[(16 * c + i) * 4 + 1]; gt += lg; if (i <= t) g += lg; if (i < t) gm1 += lg; }
            const float ac = -__expf(gl) * beta;
            const u32x4 ga = ck::pk8(k0 * ac, k1 * ac), kb = ck::pk8(k0, k1);
            *(u32x4*)(pc + (t * 72 + 8 * c8) * 2) = ga;
            *(u32x4*)(pc + 2304 + (t * 72 + 8 * c8) * 2) = ck::pk8(q0, q1);
            *(u32x4*)(pc + 4608 + (t * 72 + 8 * c8) * 2) = kb;
            ck::st8T((bf16_t*)(pc + 9216), 8 * c8, t, ga); ck::st8T((bf16_t*)(pc + 11264), 8 * c8, t, kb);
            const float us = __expf(gt - g);
            if (t == 15) { const float pv = __expf(gt); const f32x4 pv4 = (f32x4){pv, pv, pv, pv}; *(f32x4*)(pc + 17664 + 32 * c8) = pv4; *(f32x4*)(pc + 17664 + 32 * c8 + 16) = pv4; }
            if (c8 == 0) { float* sc4 = (float*)(pc + 17408); sc4[t] = g; sc4[16 + t] = __expf(g); sc4[32 + t] = __expf(gm1); sc4[48 + t] = us; }
            if ((c8 >> 2) == half) {
                const f32x4 v0 = o[2][0] * beta, v1 = o[2][1] * beta;
                ck::st8T((bf16_t*)(pc + 15360), 8 * c8 - 32 * half, t, ck::pk8(v0, v1)); ck::st8T((bf16_t*)(pc + 16384), 8 * c8 - 32 * half, t, ck::pk8(v0 * us, v1 * us));
            }
            lbar();
        };
        prefetch(setA, 0); prefetch(setB, 1);
        stage(0, setA);
        for (int k = 0; k < NCH; k += 2) {
            if (k + 1 < NCH) stage(k + 1, setB); else { lbar(); lbar(); }
            if (k + 2 < NCH) stage(k + 2, setA); else { lbar(); lbar(); }
        }
        lbar(); lbar();
        flush(NCH - 2); flush(NCH - 1);
    }
}

__device__ __forceinline__ void s5_job(const PP& p, int it, LAS uchar* lds) {
    const int g = it >> 1, dir = it & 1, tid = tid_of(p.wv), w = tid >> 6, q = tid & 63;
    bf16_t* A2 = (bf16_t*)(p.ws + OFF_A2) + (size_t)it * GROWS * 640;
    if (w < 4) {
        const float* HL = (const float*)(p.ws + OFF_HL) + (size_t)g * GROWS * 256 + dir * 128 + 2 * q;
        const float* DP = (const float*)(p.ws + OFF_DP) + (it * 64 + q) * 2;
        const float dr = DP[0], di = DP[1]; float hr = 0.f, hi = 0.f;
        for (int i0 = 0; i0 < NCH; i0 += 8) {
            f32x2 hl[8]; int Rr[8];
#pragma unroll
            for (int e = 0; e < 8; ++e) { const int i = i0 + e; const int c = dir == 0 ? i : (i < 8 ? 7 - i : NCH - 1 - (i - 8)); Rr[e] = w * NCH + c; hl[e] = *(const f32x2*)(HL + (size_t)Rr[e] * 256); }
#pragma unroll
            for (int e = 0; e < 8; ++e) {
                *(unsigned*)(A2 + (size_t)Rr[e] * 640 + 512 + 2 * q) = pk2(hr, hi);
                const float nr = dr * hr - di * hi + hl[e].x, ni = dr * hi + di * hr + hl[e].y; hr = nr; hi = ni;
            }
        }
    }
    __builtin_amdgcn_fence(__ATOMIC_RELEASE, "agent");
    asm volatile("s_waitcnt vmcnt(0)" ::: "memory");
    __syncthreads();
    __builtin_amdgcn_fence(__ATOMIC_ACQUIRE, "agent");
    asm volatile("s_waitcnt vmcnt(0)" ::: "memory");
    __syncthreads();
    pg8::Gemm gm; gm.A = (const bf16_t*)(p.ws + OFF_A2); gm.Bt = (const bf16_t*)(p.ws + OFF_TF); gm.K = 640; gm.lda = 640; gm.ldb = 640;
    pg8::Sched S; S.mode = 1; S.nM = 5; S.nN = 2; S.nwg = (it + 1) * 10; S.G = 1; S.c = it * 10;
    S.gA = (size_t)GROWS * 640 * 2; S.gB = (size_t)512 * 640 * 2; S.tA = (size_t)256 * 640 * 2; S.tB = (size_t)256 * 640 * 2;
    EpiY5 E; E.Y5 = (bf16_t*)(p.ws + OFF_Y5);
    pg8::gemm_phase(lds, gm, S, E, p.wv);
}


constexpr int GRW_SPLIT = 27000;
__device__ __forceinline__ bf16_t* grw_row(char* ws, int row) {
    return row < GRW_SPLIT ? (bf16_t*)(ws + OFF_TF) + (size_t)row * 384 : (bf16_t*)(ws + OFF_HL) + (size_t)(row - GRW_SPLIT) * 384;
}
__device__ __forceinline__ void phase_gaterw(const PP& p, int l, int gw, int nw) {
    int lane = lane_id(); asm volatile("" : "+v"(lane));
    const int fr = lane & 15, fq = lane >> 4;
    const bf16_t* Z = (const bf16_t*)(p.ws + OFF_Z); const bf16_t* GUP = (const bf16_t*)(p.ws + OFF_GUP);
    const float* mu = p.in[I_MU] + l * 1408;
    for (int item = gw; item < MROWS / 16; item += nw) {
        const int row = item * 16 + fr, b = row / TT, j = row - b * TT;
        const bool hp = (j != 0) && (j != CTX), hn = (j != CTX - 1) && (j != TT - 1);
        bf16x8 gfrag[4];
#pragma unroll
        for (int ks = 0; ks < 4; ++ks) {
            const int c0 = 1280 + ks * 32 + fq * 8;
            const Nb3 a = ld3(Z, row, hp, hn, c0), bq = ld3(Z, row, hp, hn, c0 + 4);
            f32x4 x0 = shiftmix(a, mu + c0), x1 = shiftmix(bq, mu + c0 + 4);
#pragma unroll
            for (int i = 0; i < 4; ++i) { x0[i] = sigmoidf_(x0[i]); x1[i] = sigmoidf_(x1[i]); }
            const u32x2 lo = pk4(x0), hi2 = pk4(x1); u32x4 t; t.x = lo.x; t.y = lo.y; t.z = hi2.x; t.w = hi2.y; gfrag[ks] = __builtin_bit_cast(bf16x8, t);
        }
        bf16_t* gr = grw_row(p.ws, row);
#pragma unroll 4
        for (int n24 = 0; n24 < 24; ++n24) {
            f32x4 ga = (f32x4){0.f, 0.f, 0.f, 0.f};
            const bf16_t* wp = GUP + (size_t)(n24 * 16 + fr) * 128 + fq * 8;
#pragma unroll
            for (int ks = 0; ks < 4; ++ks) ga = __builtin_amdgcn_mfma_f32_16x16x32_bf16(*(const bf16x8*)(wp + ks * 32), gfrag[ks], ga, 0, 0, 0);
            *(u32x2*)(gr + n24 * 16 + fq * 4) = pk4(ga);
        }
    }
}
__device__ __forceinline__ void phase_s5post(const PP& p, int l, int gw, int nw) {
    int lane = lane_id(); asm volatile("" : "+v"(lane));
    const int fr = lane & 15, fq = lane >> 4;
    const bf16_t* A2 = (const bf16_t*)(p.ws + OFF_A2); const bf16_t* Y5 = (const bf16_t*)(p.ws + OFF_Y5); bf16_t* Y5w = (bf16_t*)(p.ws + OFF_Y5);
    const bf16_t* GLU = (const bf16_t*)(p.ws + OFF_GLU);
    for (int item = gw; item < MROWS / 16; item += nw) {
        const int row = item * 16 + fr, b = row / TT, j = row - b * TT;
        {
            const int n = s5pos(j), R = b * NCH + (n >> 5), t = n & 31;
            const size_t GS5 = (size_t)GROWS * 512;
            bf16x8 yf[8];
#pragma unroll
            for (int ks = 0; ks < 8; ++ks) {
                const int ch = ks * 32 + fq * 8, g = ch >> 4, hh = ch & 15;
                const u32x4 y0 = *(const u32x4*)(Y5 + (size_t)(g * 2) * GS5 + (size_t)R * 512 + t * 16 + hh), y1 = *(const u32x4*)(Y5 + (size_t)(g * 2 + 1) * GS5 + (size_t)R * 512 + t * 16 + hh);
                const u32x4 uu = *(const u32x4*)(A2 + ((size_t)(g * 2) * GROWS + R) * 640 + t * 16 + hh);
                const float* dv = p.in[I_S5D] + l * 256 + ch;
                float v[8];
#pragma unroll
                for (int e = 0; e < 4; ++e) {
                    v[2 * e] = gelu_tanh(bflo(y0[e]) + bflo(y1[e]) + dv[2 * e] * bflo(uu[e]));
                    v[2 * e + 1] = gelu_tanh(bfhi(y0[e]) + bfhi(y1[e]) + dv[2 * e + 1] * bfhi(uu[e]));
                }
                u32x4 tq; tq.x = pk2(v[0], v[1]); tq.y = pk2(v[2], v[3]); tq.z = pk2(v[4], v[5]); tq.w = pk2(v[6], v[7]); yf[ks] = __builtin_bit_cast(bf16x8, tq);
                asm volatile("" ::: "memory");
            }
#pragma unroll 1
            for (int nt = 0; nt < 16; ++nt) {
                f32x4 a = (f32x4){0.f, 0.f, 0.f, 0.f};
                const bf16_t* wp = GLU + (size_t)(nt * 16 + fr) * 256 + fq * 8;
#pragma unroll
                for (int ks = 0; ks < 8; ++ks) a = __builtin_amdgcn_mfma_f32_16x16x32_bf16(*(const bf16x8*)(wp + ks * 32), yf[ks], a, 0, 0, 0);
                const int ch = nt * 16 + fq * 4, hh = ch & 15;
                const u32x2 y0 = *(const u32x2*)(Y5 + (size_t)(nt * 2) * GS5 + (size_t)R * 512 + t * 16 + hh), y1 = *(const u32x2*)(Y5 + (size_t)(nt * 2 + 1) * GS5 + (size_t)R * 512 + t * 16 + hh);
                const u32x2 uu = *(const u32x2*)(A2 + ((size_t)(nt * 2) * GROWS + R) * 640 + t * 16 + hh);
                const f32x4 dv = *(const f32x4*)(p.in[I_S5D] + l * 256 + ch), gb = *(const f32x4*)(p.in[I_GLUB] + l * 256 + ch);
                const f32x4 ys = unpk4(y0) + unpk4(y1) + dv * unpk4(uu);
                f32x4 o;
#pragma unroll
                for (int i = 0; i < 4; ++i) { const float yy = gelu_tanh(ys[i]); o[i] = yy * sigmoidf_(a[i] + gb[i]); }
                *(u32x2*)(Y5w + (size_t)(nt * 2) * GS5 + (size_t)R * 512 + t * 16 + hh) = pk4(o);
                asm volatile("" ::: "memory");
            }
        }
    }
}

__device__ __forceinline__ void phase_post(const PP& p, int l) {
    const int lane = tid_of(p.wv) & 63, gw = bidx() * 8 + (tid_of(p.wv) >> 6), nw = gridDim.x * 8, tk = lane >> 4, c4 = lane & 15;
    const bf16_t* Z = (const bf16_t*)(p.ws + OFF_Z);
    const bf16_t* YO = (const bf16_t*)(p.ws + OFF_YO);
    const float* BC = (const float*)(p.ws + OFF_BC);
    const bf16_t* Y5 = (const bf16_t*)(p.ws + OFF_Y5);
    bf16_t* MIX = (bf16_t*)(p.ws + OFF_H);
    const float* mu = p.in[I_MU] + l * 1408;
    const size_t YS = (size_t)MROWS * 384;
    for (int it3 = gw; it3 < 2 * (MROWS / 16); it3 += nw) {
      const int item = it3 >> 1, part = 1 + (((it3 / nw) + it3) & 1);
      if (part == 1) {
#pragma unroll 1
        for (int tg = 0; tg < 4; ++tg) {
            const int row = item * 16 + tg * 4 + tk, b = row / TT, j = row - b * TT;
            const bool hp = (j != 0) && (j != CTX), hn = (j != CTX - 1) && (j != TT - 1);
            const bf16_t* gr = grw_row(p.ws, row);
#pragma unroll 2
            for (int h = 0; h < 6; ++h) {
                const int c = h * 64 + 4 * c4;
                f32x4 y = unpk4(*(const u32x2*)(YO + (size_t)row * 384 + c)) + unpk4(*(const u32x2*)(YO + YS + (size_t)row * 384 + c));
                const float mean = red16(y[0] + y[1] + y[2] + y[3]) * (1.f / 64.f);
                y = y - mean;
                const float rstd = __builtin_amdgcn_rsqf(red16(y[0] * y[0] + y[1] * y[1] + y[2] * y[2] + y[3] * y[3]) * (1.f / 64.f) + 64e-5f);
                const float bon = BC[(size_t)row * 6 + h] + BC[(size_t)MROWS * 6 + (size_t)row * 6 + h];
                const f32x4 lg = *(const f32x4*)(p.in[I_LNG] + l * 384 + c), lb = *(const f32x4*)(p.in[I_LNB] + l * 384 + c);
                const f32x4 vs = shiftmix(ld3(Z, row, hp, hn, 768 + c), mu + 768 + c);
                const f32x4 ga = unpk4(*(const u32x2*)(gr + c));
                *(u32x2*)(MIX + (size_t)row * DM + c) = pk4((y * rstd * lg + lb + vs * bon) * ga);
            }
        }
      } else {
#pragma unroll 1
        for (int tg = 0; tg < 4; ++tg) {
            const int row = item * 16 + tg * 4 + tk, b = row / TT, j = row - b * TT;
            const f32x4 gn = *(const f32x4*)(p.in[I_GNG] + l * 64 + 4 * c4);
#pragma unroll 3
            for (int h = 0; h < 6; ++h) {
                const int c = h * 64 + 4 * c4;
                const f32x4 o = unpk4(*(const u32x2*)(YO + 2 * YS + (size_t)row * 384 + c)) + unpk4(*(const u32x2*)(YO + 3 * YS + (size_t)row * 384 + c));
                const float rs = __builtin_amdgcn_rsqf(red16(o[0] * o[0] + o[1] * o[1] + o[2] * o[2] + o[3] * o[3]) * (1.f / 64.f) + 1e-6f);
                f32x4 gt = unpk4(*(const u32x2*)(Z + (size_t)row * ZLD + 2584 + c));
#pragma unroll
                for (int i = 0; i < 4; ++i) gt[i] = siluf_(gt[i]);
                *(u32x2*)(MIX + (size_t)row * DM + 384 + c) = pk4(o * rs * gn * gt);
            }
            const int n = s5pos(j), R = b * NCH + (n >> 5), t = n & 31;
            const size_t GS5 = (size_t)GROWS * 512;
#pragma unroll
            for (int e = 0; e < 4; ++e) {
                const int ch = e * 64 + 4 * c4, nt = ch >> 4, hh = ch & 15;
                *(u32x2*)(MIX + (size_t)row * DM + 768 + ch) = *(const u32x2*)(Y5 + (size_t)(nt * 2) * GS5 + (size_t)R * 512 + t * 16 + hh);
            }
        }
      }
    }
}

__global__ void __launch_bounds__(512) fwd_mega(P kp) {
    extern __shared__ __attribute__((aligned(16))) uchar shm[];
    cg::grid_group grid = cg::this_grid();
    float* sm = (float*)shm;
    LAS uchar* lds = (LAS uchar*)shm;
    const int nblk = gridDim.x;
    if (threadIdx.x == 0) {
        unsigned long long* tab = (unsigned long long*)(shm + TAB_OFF);
#pragma unroll
        for (int i = 0; i < N_IN; ++i) tab[i] = (unsigned long long)kp.in[i];
        tab[N_IN] = (unsigned long long)kp.out; tab[N_IN + 1] = (unsigned long long)kp.ws;
    }
    if (threadIdx.x == 0) { volatile LAS unsigned* st0 = (volatile LAS unsigned*)(lds + TAB_OFF + 384); st0[0] = 0u; st0[1] = 0u; st0[2] = 0u; st0[3] = 0u; }
    __syncthreads();
    const PP p = mkp(__builtin_amdgcn_readfirstlane((int)(threadIdx.x >> 6)));
    const XcdBarrier xb = xcd_barrier_post((unsigned*)(p.ws + OFF_BAR), (volatile LAS unsigned*)(lds + TAB_OFF + 384), p.wv);

    phase_mod(p, sm);
    __syncthreads();
    phase_s5coef(p, 0, sm);
    phase_convw(p, 0, sm, 0, nblk - n_coef_blocks(), 0);
    {
        float* cr = (float*)(p.ws + OFF_CTXR);
        for (size_t i = (size_t)bidx() * 512 + tid_of(p.wv); i < (size_t)NB * CTX * DM / 4; i += (size_t)nblk * 512) ((f32x4*)cr)[i] = ((const f32x4*)p.in[I_CTX])[i];
    }
    grid.sync();

    for (int l = 0; l < DEPTH; ++l) {
        const float* xsrc = l == 0 ? p.in[I_X] : p.out;
        float* ctxr = (float*)(p.ws + OFF_CTXR);
        const float* modl = (const float*)(p.ws + OFF_MOD) + (size_t)l * 5 * 6144;
        phase_norm(p, l, 0, xsrc, ctxr, 0);
        xcd_barrier(xb);
        {
            pg8::Gemm gm; gm.A = (const bf16_t*)(p.ws + OFF_H); gm.Bt = (const bf16_t*)(p.ws + OFF_WIN); gm.K = 1024; gm.lda = 1024; gm.ldb = 1024;
            EpiZ E; E.Z = (bf16_t*)(p.ws + OFF_Z); E.A2 = (bf16_t*)(p.ws + OFF_A2);
            pg8::gemm_phase(lds, gm, sched_static(MROWS, 3328, 1024, 1024), E, p.wv);
        }
        xcd_barrier(xb);
        {
            pg8::Gemm gm; gm.A = (const bf16_t*)(p.ws + OFF_A2); gm.Bt = (const bf16_t*)(p.ws + OFF_E2); gm.K = 512; gm.lda = 640; gm.ldb = 512;
            pg8::Sched S; S.mode = 1; S.nM = 5; S.nN = 1; S.nwg = 80; S.G = nblk; S.c = bidx();
            S.gA = (size_t)2 * GROWS * 640 * 2; S.gB = (size_t)256 * 512 * 2; S.tA = (size_t)256 * 640 * 2; S.tB = 0;
            EpiHL E; E.HL = (float*)(p.ws + OFF_HL);
            pg8::gemm_phase(lds, gm, S, E, p.wv);
        }
        phase_rwprep(p, l);
        xcd_barrier(xb);
        for (int slot = bidx(); slot < 224; slot += nblk) {
            const int job = slot < 192 ? (((slot & 7) + 8 * (slot >> 4)) << 1) + ((slot >> 3) & 1) : slot;
            if (job < 96) rwkv_job(p, l, job, sm);
            else if (job < 192) gdn_job(p, l, job - 96, sm);
            else {
                s5_job(p, job - 192, lds);
                asm volatile("s_waitcnt vmcnt(0)" ::: "memory");
                __syncthreads();
                if (tid_of(p.wv) == 0) { __builtin_amdgcn_fence(__ATOMIC_RELEASE, "agent"); asm volatile("s_waitcnt vmcnt(0)" ::: "memory");
                    __hip_atomic_fetch_add((unsigned*)(p.ws + OFF_BAR) + 3600 + l, 1u, __ATOMIC_RELAXED, __HIP_MEMORY_SCOPE_AGENT); }
            }
            __syncthreads();
        }
        const bool s5_helpers = nblk >= 224;
        const int hb0 = s5_helpers ? 192 : 0;
        if (bidx() >= hb0) {
            const int tid = tid_of(p.wv);
            if (tid == 0) {
                while (__hip_atomic_load((unsigned*)(p.ws + OFF_BAR) + 3600 + l, __ATOMIC_RELAXED, __HIP_MEMORY_SCOPE_AGENT) < 32u) __builtin_amdgcn_s_sleep(8);
                __builtin_amdgcn_fence(__ATOMIC_ACQUIRE, "agent");
                asm volatile("s_waitcnt vmcnt(0)" ::: "memory");
            }
            __syncthreads();
            phase_s5post(p, l, (bidx() - hb0) * 8 + (tid >> 6), (nblk - hb0) * 8);
            phase_gaterw(p, l, (bidx() - hb0) * 8 + (tid >> 6), (nblk - hb0) * 8);
            __syncthreads();
            phase_convw(p, l, sm, hb0, nblk - hb0, 1);
        }
        xcd_barrier(xb);
        phase_post(p, l);
        xcd_barrier(xb);
        {
            pg8::Gemm gm; gm.A = (const bf16_t*)(p.ws + OFF_H); gm.Bt = (const bf16_t*)(p.ws + OFF_WOUT); gm.K = 1024; gm.lda = 1024; gm.ldb = 1024;
            EpiResid E; E.xin = xsrc; E.xout = p.out; E.cin = l == 0 ? p.in[I_CTX] : ctxr; E.cout = ctxr; E.mod = modl; E.gidx = 2;
            pg8::gemm_phase(lds, gm, sched_static(MROWS, 1024, 1024, 1024), E, p.wv);
        }
        xcd_barrier(xb);
        phase_norm(p, l, 1, p.out, ctxr, 0);
        xcd_barrier(xb);
        {
            pg8::Gemm gm; gm.A = (const bf16_t*)(p.ws + OFF_H); gm.Bt = (const bf16_t*)(p.ws + OFF_WGU); gm.K = 1024; gm.lda = 1024; gm.ldb = 1024;
            EpiSwiGLU E; E.HID = (bf16_t*)(p.ws + OFF_Z);
            pg8::gemm_phase(lds, gm, sched_static(MROWS, 5632, 1024, 1024), E, p.wv);
        }
        xcd_barrier(xb);
        {
            pg8::Gemm gm; gm.A = (const bf16_t*)(p.ws + OFF_Z); gm.Bt = (const bf16_t*)(p.ws + OFF_WDN); gm.K = FFN; gm.lda = FFN; gm.ldb = FFN;
            EpiResid E; E.xin = p.out; E.xout = p.out; E.cin = ctxr; E.cout = ctxr; E.mod = modl; E.gidx = 5;
            pg8::gemm_phase(lds, gm, sched_static(MROWS, 1024, FFN, FFN), E, p.wv);
        }
        if (l + 1 < DEPTH) {
            const int nx = (528 % nblk);
            __syncthreads();
            phase_s5coef(p, l + 1, sm);
            const int ncb = n_coef_blocks();
            const bool wide = nblk - nx - ncb >= 64;
            phase_convw(p, l + 1, sm, wide ? nx : 0, wide ? nblk - nx - ncb : nblk, 0);
        }
        xcd_barrier(xb);
    }
    phase_final(p);
}

extern "C" void kernel_launch(void* const* d_in, const int* in_sizes, int n_in, void* d_out, int out_size, void* d_ws, size_t ws_size, hipStream_t stream) {
    static int grid_blocks = 0;
    if (!grid_blocks) {
        int dev = 0, cus = 0, per_cu = 0;
        hipGetDevice(&dev);
        hipDeviceGetAttribute(&cus, hipDeviceAttributeMultiprocessorCount, dev);
        if (hipFuncSetAttribute((const void*)fwd_mega, hipFuncAttributeMaxDynamicSharedMemorySize, LDS_TOTAL) != hipSuccess) fprintf(stderr, "hipFuncSetAttribute failed\n");
        hipOccupancyMaxActiveBlocksPerMultiprocessor(&per_cu, (const void*)fwd_mega, 512, LDS_TOTAL);
        if (per_cu < 1) per_cu = 1;
        if (per_cu > 1) per_cu = 1;
        grid_blocks = cus * per_cu;
    }
    if (ws_size < WS_NEED) fprintf(stderr, "workspace too small: %zu < %zu\n", ws_size, (size_t)WS_NEED);
    P p{};
    for (int i = 0; i < N_IN; ++i) p.in[i] = (const float*)d_in[i];
    p.out = (float*)d_out; p.ws = (char*)d_ws;
    (void)hipMemsetAsync((char*)d_ws + OFF_BAR, 0, 16384, stream);
    void* args[] = {&p};
    hipError_t e = hipLaunchCooperativeKernel((void*)fwd_mega, dim3(grid_blocks), dim3(512), args, LDS_TOTAL, stream);
    if (e != hipSuccess) fprintf(stderr, "cooperative launch failed: %s (grid %d)\n", hipGetErrorString(e), grid_blocks);
}
```

```cpp
#include <hip/hip_runtime.h>
#include <hip/hip_cooperative_groups.h>
#include <cstdio>
namespace cg = cooperative_groups;

#define LAS __attribute__((address_space(3)))
typedef unsigned short bf16_t;
typedef unsigned char uchar;
typedef short bf16x8 __attribute__((ext_vector_type(8)));
typedef float f32x4 __attribute__((ext_vector_type(4)));
typedef float f32x2 __attribute__((ext_vector_type(2)));
typedef unsigned u32x4 __attribute__((ext_vector_type(4)));
typedef unsigned u32x2 __attribute__((ext_vector_type(2)));

constexpr int DM = 1024, NB = 4, SEQ = 8192, CTX = 256, TT = 8448, MROWS = 33792, DEPTH = 4;
constexpr int FFN = 2816, ZLD = 2968, NCH = 264  , GROWS = 1056  ;
constexpr int LDSB = 131072;
constexpr int LDS_TOTAL = 163840, TAB_OFF = 162816;

enum { I_X = 0, I_C, I_CTX, I_CCTX, I_N1G, I_N2G, I_FG, I_ADAW, I_ADAB, I_WIN, I_WOUT, I_MU, I_W0, I_WUP, I_A0, I_AUP, I_GUP, I_KK, I_KA, I_RK,
       I_LNG, I_LNB, I_CONV, I_ALOG, I_DTB, I_GNG, I_LRE, I_LIM, I_LDT, I_BRE, I_BIM, I_CRE, I_CIM, I_S5D, I_GLUW, I_GLUB, I_FG8, I_FU, I_FD, N_IN };

constexpr size_t OFF_WIN = 0;
constexpr size_t OFF_WOUT = OFF_WIN + 6815744;
constexpr size_t OFF_WGU = OFF_WOUT + 2097152;
constexpr size_t OFF_WDN = OFF_WGU + 11534336;
constexpr size_t OFF_WUP = OFF_WDN + 5767168;
constexpr size_t OFF_AUP = OFF_WUP + 98304;
constexpr size_t OFF_GUP = OFF_AUP + 98304;
constexpr size_t OFF_GLU = OFF_GUP + 98304;
constexpr size_t OFF_TF = OFF_GLU + 131072;
constexpr size_t OFF_E2 = OFF_TF + 20971520;
constexpr size_t OFF_DP = OFF_E2 + 4194304;
constexpr size_t OFF_MOD = OFF_DP + 16384;
constexpr size_t OFF_CTXR = OFF_MOD + 491520;
constexpr size_t OFF_BC = OFF_CTXR + 4194304;
constexpr size_t OFF_H = OFF_BC + 1622016;
constexpr size_t OFF_Z = OFF_H + 69206016;
constexpr size_t OFF_YO = OFF_Z + 200589312;
constexpr size_t OFF_A2 = OFF_YO + 103809024;
constexpr size_t OFF_Y5 = OFF_A2 + 43581440;
constexpr size_t OFF_HL = OFF_Y5 + 34603008;
constexpr size_t OFF_BAR = OFF_HL + 17301504;
constexpr size_t WS_NEED = OFF_BAR + 16384;

struct P { const float* in[N_IN]; float* out; char* ws; };
__device__ __forceinline__ char* ldp(int i) {
    extern __shared__ __attribute__((aligned(16))) unsigned char shm_[];
    const unsigned long long v = ((const unsigned long long*)(shm_ + TAB_OFF))[i];
    const unsigned lo = __builtin_amdgcn_readfirstlane((unsigned)v), hi = __builtin_amdgcn_readfirstlane((unsigned)(v >> 32));
    return (char*)(__attribute__((address_space(1))) char*)(((unsigned long long)hi << 32) | lo);
}
struct PIn { __device__ __forceinline__ const float* operator[](int i) const { return (const float*)ldp(i); } };
struct PP { PIn in; float* out; char* ws; int wv; };
__device__ __forceinline__ PP mkp(int wv) { PP q; q.out = (float*)ldp(N_IN); q.ws = ldp(N_IN + 1); q.wv = wv; return q; }

__device__ __forceinline__ int lane_id() { return (int)__builtin_amdgcn_mbcnt_hi(~0u, __builtin_amdgcn_mbcnt_lo(~0u, 0u)); }
__device__ __forceinline__ int tid_of(int wv) { int t = wv * 64 + lane_id(); asm volatile("" : "+v"(t)); return t; }
__device__ __forceinline__ int bidx() { int t = blockIdx.x; asm volatile("" : "+s"(t)); return t; }
__device__ __forceinline__ bf16_t f2bf(float f) { unsigned u = __float_as_uint(f); u += 0x7FFFu + ((u >> 16) & 1u); return (bf16_t)(u >> 16); }
typedef __bf16 bf16v2_t __attribute__((ext_vector_type(2)));
__device__ __forceinline__ unsigned pk2(float lo, float hi) { f32x2 f; f.x = lo; f.y = hi; return __builtin_bit_cast(unsigned, __builtin_convertvector(f, bf16v2_t)); }
__device__ __forceinline__ float bflo(unsigned u) { return __uint_as_float(u << 16); }
__device__ __forceinline__ float bfhi(unsigned u) { return __uint_as_float(u & 0xFFFF0000u); }
__device__ __forceinline__ float bf2f(bf16_t b) { return __uint_as_float(((unsigned)b) << 16); }
__device__ __forceinline__ f32x4 unpk4(u32x2 v) { return (f32x4){bflo(v.x), bfhi(v.x), bflo(v.y), bfhi(v.y)}; }
__device__ __forceinline__ u32x2 pk4(f32x4 v) { u32x2 r; r.x = pk2(v[0], v[1]); r.y = pk2(v[2], v[3]); return r; }
__device__ __forceinline__ float rcpf_(float x) { return __builtin_amdgcn_rcpf(x); }
__device__ __forceinline__ float sigmoidf_(float x) { return rcpf_(1.f + __expf(-x)); }
__device__ __forceinline__ float siluf_(float x) { return x * rcpf_(1.f + __expf(-x)); }
__device__ __forceinline__ float softplusf_(float x) { return x > 20.f ? x : log1pf(__expf(x)); }
__device__ __forceinline__ float gelu_tanh(float x) { const float u = 1.5957691216057308f * (x + 0.044715f * x * x * x); return x * rcpf_(1.f + __expf(-u)); }
__device__ __forceinline__ float tanhf_(float x) { return 1.f - 2.f * rcpf_(1.f + __expf(2.f * x)); }
template <int CTRL> __device__ __forceinline__ float dppf(float x) { return __builtin_bit_cast(float, __builtin_amdgcn_mov_dpp(__builtin_bit_cast(int, x), CTRL, 0xf, 0xf, true)); }
__device__ __forceinline__ float red16(float x) {
    x += dppf<0xB1>(x); x += dppf<0x4E>(x); x += dppf<0x141>(x); x += dppf<0x128>(x); return x;
}
__device__ __forceinline__ void red16x2(float& x, float& y) {
    x += dppf<0xB1>(x); y += dppf<0xB1>(y); x += dppf<0x4E>(x); y += dppf<0x4E>(y);
    x += dppf<0x141>(x); y += dppf<0x141>(y); x += dppf<0x128>(x); y += dppf<0x128>(y);
}
__device__ __forceinline__ float dot4(const f32x4& a, const f32x4& b) { return (a[0] * b[0] + a[2] * b[2]) + (a[1] * b[1] + a[3] * b[3]); }
__device__ __forceinline__ float red64(float x) {
#pragma unroll
    for (int o = 32; o > 0; o >>= 1) x += __shfl_xor(x, o);
    return x;
}
__device__ __forceinline__ void lbar() { asm volatile("s_waitcnt lgkmcnt(0)" ::: "memory"); __builtin_amdgcn_s_barrier(); asm volatile("" ::: "memory"); }
__device__ __forceinline__ int seqpos(int dir, int n) { return dir == 0 ? n : (n < CTX ? (CTX - 1 - n) : (TT - 1 - (n - CTX))); }
__device__ __forceinline__ int s5pos(int j) { if (j < CTX) return j; const int tok = j - CTX; return CTX + (tok & 63) * 128 + (tok >> 6); }

#define XB_TMO      128
#define XB_XCNT(j)  (256  + 64 * (j))
#define XB_XSUB(j)  (1280 + 64 * (j))
#define XB_XGEN(j)  (2304 + 64 * (j))
#define XB_TOP      3328
#define XB_TOPGEN   3392
#define XCD_BAR_WORDS 3456
#define XB_SPIN_CAP (1u << 18)

__device__ __forceinline__ unsigned xb_ld(unsigned* p)              { return __hip_atomic_load(p, __ATOMIC_RELAXED, __HIP_MEMORY_SCOPE_AGENT); }
__device__ __forceinline__ unsigned xb_add(unsigned* p, unsigned v) { return __hip_atomic_fetch_add(p, v, __ATOMIC_RELAXED, __HIP_MEMORY_SCOPE_AGENT); }
__device__ __forceinline__ unsigned xb_xcc_id() { return (unsigned)__builtin_amdgcn_s_getreg((3 << 11) | 20) & 0xFu; }
#define XB_SPIN(cond, bar) do { unsigned _sp = 0; while (cond) { __builtin_amdgcn_s_sleep(1); \
    if ((++_sp & 255u) == 0u) { if (xb_ld(&(bar)[XB_TMO])) break; if (_sp > XB_SPIN_CAP) { atomicAdd(&(bar)[XB_TMO], 1u); break; } } } } while (0)

struct XcdBarrier {
    int wv;
    unsigned* bar; unsigned x;
    volatile LAS unsigned* st;
};

__device__ __forceinline__ XcdBarrier xcd_barrier_post(unsigned* bar, volatile LAS unsigned* st, int wv) {
    XcdBarrier b; b.bar = bar; b.x = xb_xcc_id(); b.st = st; b.wv = wv;
    if (wv == 0 && lane_id() == 0) (void)xb_add(&bar[XB_XCNT(b.x)], 1u);
    return b;
}
__device__ __forceinline__ void xcd_barrier_complete(unsigned* bar, unsigned x, unsigned& nloc, unsigned& nx) {
    const unsigned G = gridDim.x * gridDim.y * gridDim.z;
    unsigned sum, cnt, mine, sp = 0u;
    for (;;) {
        sum = 0u; cnt = 0u; mine = 0u;
#pragma unroll
        for (unsigned j = 0; j < 16; ++j) { const unsigned c = xb_ld(&bar[XB_XCNT(j)]); sum += c; cnt += (c > 0u) ? 1u : 0u; mine = (j == x) ? c : mine; }
        if (sum == G) break;
        __builtin_amdgcn_s_sleep(1);
        if ((++sp & 255u) == 0u) { if (xb_ld(&bar[XB_TMO])) break; if (sp > XB_SPIN_CAP) { atomicAdd(&bar[XB_TMO], 1u); break; } }
    }
    nloc = mine > 0u ? mine : 1u; nx = cnt > 0u ? cnt : 1u;
}

__device__ __forceinline__ void xcd_barrier(const XcdBarrier& b) {
    asm volatile("s_waitcnt vmcnt(0)" ::: "memory");
    __syncthreads();
    if (b.wv == 0 && lane_id() == 0) {
        unsigned* bar = b.bar;
        __builtin_amdgcn_s_waitcnt(0);
        unsigned nloc = b.st[0], nx = b.st[1];
        if (nloc == 0u) { xcd_barrier_complete(bar, b.x, nloc, nx); b.st[0] = nloc; b.st[1] = nx; }
        const unsigned old = xb_add(&bar[XB_XSUB(b.x)], 1u);
        const unsigned gen = old / nloc;
        if (old + 1u == (gen + 1u) * nloc) {
            __builtin_amdgcn_fence(__ATOMIC_RELEASE, "agent");
            asm volatile("s_waitcnt vmcnt(0)" ::: "memory");
            const unsigned og = xb_add(&bar[XB_TOP], 1u);
            const unsigned tg = og / nx;
            if (og + 1u == (tg + 1u) * nx) xb_add(&bar[XB_TOPGEN], 1u);
            else XB_SPIN(xb_ld(&bar[XB_TOPGEN]) == tg, bar);
            __builtin_amdgcn_fence(__ATOMIC_ACQUIRE, "agent");
            xb_add(&bar[XB_XGEN(b.x)], 1u);
            asm volatile("s_waitcnt vmcnt(0)" ::: "memory");
        } else {
            XB_SPIN(xb_ld(&bar[XB_XGEN(b.x)]) == gen, bar);
            __builtin_amdgcn_fence(__ATOMIC_ACQUIRE, "agent");
            asm volatile("s_waitcnt vmcnt(0)" ::: "memory");
        }
    }
    __syncthreads();
}


namespace pg8 {
constexpr int BM = 256, BK = 64, HALF = 128, HTB = HALF * BK * 2, NXCD = 8, WGM = 8;
__device__ __forceinline__ int lds_byte(int r, int c) { const int st = (r >> 4) * 2 + (c >> 5), rr = r & 15, cc = c & 31, ob = rr * 64 + cc * 2; return st * 1024 + (ob ^ (((ob >> 9) & 1) << 5)); }
__device__ __forceinline__ void stage_rc(int b, int& R, int& C) { const int st = b / 1024, sb = b % 1024, swz = sb ^ (((sb >> 9) & 1) << 5); R = (st >> 1) * 16 + swz / 64; C = (st & 1) * 32 + (swz % 64) / 2; }
__device__ __forceinline__ int perm32(int rho) { const int n = rho >> 4, i = rho & 15; return 8 * (i >> 2) + 4 * n + (i & 3); }
struct Unit { int pm, pn, grp; size_t aoff, boff; };
struct Gemm { const bf16_t* A; const bf16_t* Bt; int K, lda, ldb; };
struct Sched {
    int mode, nM, nN, nwg, G, c; size_t gA, gB, tA, tB;
    __device__ bool next(int i, Unit& u) const {
        const long L = (long)i * G + c; if (L >= nwg) return false;
        if (mode == 0) {
            int wgid = (int)L; { const int q = nwg / NXCD, r = nwg % NXCD, xcd = wgid % NXCD, off = wgid / NXCD; wgid = (xcd < r ? xcd * (q + 1) : r * (q + 1) + (xcd - r) * q) + off; }
            const int nig = WGM * nN, gid = wgid / nig, fm = gid * WGM, gsz = (nM - fm) < WGM ? (nM - fm) : WGM;
            u.pm = fm + ((wgid % nig) % gsz); u.pn = (wgid % nig) / gsz; u.grp = 0;
        } else {
            const int upg = nM * nN; u.grp = (int)L / upg; const int rem = (int)L % upg; u.pm = rem % nM; u.pn = rem / nM;
        }
        u.aoff = (size_t)u.grp * gA + (size_t)u.pm * tA; u.boff = (size_t)u.grp * gB + (size_t)u.pn * tB; return true;
    }
};

template <class Epi>
__device__ __forceinline__ void gemm_phase(LAS uchar* lds, const Gemm g, const Sched& S, const Epi& E, int wv) {
    const int tid = tid_of(wv), wid = __builtin_amdgcn_readfirstlane(tid >> 6), lane = tid & 63, wr = wid >> 2, wc = wid & 3, fr = lane & 15, fq = lane >> 4;
    const int K = g.K, nt = K / BK;
    unsigned voffA[2], voffB[2];
#pragma unroll
    for (int i = 0; i < 2; ++i) { int R, C; stage_rc(tid * 16 + i * 8192, R, C); const int Rb = Epi::PERM ? ((R & ~31) + perm32(R & 31)) : R;
        voffA[i] = (unsigned)(R * g.lda + C) * 2u; voffB[i] = (unsigned)(Rb * g.ldb + C) * 2u; }
    const size_t kstep = (size_t)(BK * 2);
    const size_t hstepA = (size_t)HALF * g.lda * 2, hstepB = (size_t)HALF * g.ldb * 2;
    const unsigned ldsw = (unsigned)wid * 1024u;
    const int aoff = lds_byte(wr * 64 + fr, fq * 8), boff = lds_byte(wc * 32 + fr, fq * 8);
#define PG8_SA(b, h) (((b) * 2 + (h)) * HTB)
#define PG8_SB(b, h) ((4 + (b) * 2 + (h)) * HTB)
#define PG8_STAGE(bufoff, gbase, voff) do { _Pragma("unroll") for (int _i = 0; _i < 2; ++_i) \
        __builtin_amdgcn_global_load_lds((const unsigned*)((const char*)(gbase) + (voff)[_i]), (LAS unsigned*)(lds + (bufoff) + ldsw + _i * 8192), 16, 0, 0); } while (0)
#define PG8_LDA(dst, b, h) do { _Pragma("unroll") for (int m = 0; m < 4; ++m) _Pragma("unroll") for (int k = 0; k < 2; ++k) dst[m][k] = *(const LAS bf16x8*)(lds + PG8_SA(b, h) + aoff + m * 2048 + k * 1024); } while (0)
#define PG8_LDB(dst, b, h) do { _Pragma("unroll") for (int n = 0; n < 2; ++n) _Pragma("unroll") for (int k = 0; k < 2; ++k) dst[n][k] = *(const LAS bf16x8*)(lds + PG8_SB(b, h) + boff + n * 2048 + k * 1024); } while (0)
#define PG8_MMA(ai, bj, At, Bt) do { __builtin_amdgcn_s_setprio(1); _Pragma("unroll") for (int m = 0; m < 4; ++m) _Pragma("unroll") for (int n = 0; n < 2; ++n) _Pragma("unroll") for (int k = 0; k < 2; ++k) \
        acc[ai][bj][m][n] = __builtin_amdgcn_mfma_f32_16x16x32_bf16(Bt[n][k], At[m][k], acc[ai][bj][m][n], 0, 0, 0); __builtin_amdgcn_s_setprio(0); } while (0)
#define PG8_WAIT_V(n) asm volatile("s_waitcnt vmcnt(" #n ")" ::: "memory")
#define PG8_WAIT_L(n) asm volatile("s_waitcnt lgkmcnt(" #n ")" ::: "memory")
#define PG8_BAR __builtin_amdgcn_s_barrier()
#define PG8_SCHED __builtin_amdgcn_sched_barrier(0)
    Unit cur, nxt; int ui = 0;
    if (!S.next(0, cur)) return;
    f32x4 acc[2][2][4][2];
#pragma unroll
    for (int a = 0; a < 2; ++a)
#pragma unroll
        for (int b = 0; b < 2; ++b)
#pragma unroll
            for (int m = 0; m < 4; ++m)
#pragma unroll
                for (int n = 0; n < 2; ++n) acc[a][b][m][n] = (f32x4){0.f, 0.f, 0.f, 0.f};
    bf16x8 At[4][2], B0[2][2], B1[2][2];
    const char* cA = (const char*)g.A + cur.aoff; const char* cB = (const char*)g.Bt + cur.boff;
    PG8_STAGE(PG8_SB(0, 0), cB, voffB); PG8_STAGE(PG8_SA(0, 0), cA, voffA); PG8_STAGE(PG8_SB(0, 1), cB + hstepB, voffB); PG8_STAGE(PG8_SA(0, 1), cA + hstepA, voffA);
    if (wr == 1) PG8_BAR;
    PG8_WAIT_V(4); PG8_BAR;
    PG8_STAGE(PG8_SB(1, 0), cB + kstep, voffB); PG8_STAGE(PG8_SA(1, 0), cA + kstep, voffA); PG8_STAGE(PG8_SB(1, 1), cB + hstepB + kstep, voffB);
    PG8_WAIT_V(6); PG8_BAR;
    for (;;) {
        const bool has_next = S.next(ui + 1, nxt);
        const char* nA = has_next ? (const char*)g.A + nxt.aoff : cA; const char* nB = has_next ? (const char*)g.Bt + nxt.boff : cB;
        for (int t = 0; t < nt; t += 2) {
            const bool last = (t == nt - 2);
            const char* a1 = cA + (size_t)(t + 1) * kstep;
            const char* a2 = last ? nA : cA + (size_t)(t + 2) * kstep; const char* b2 = last ? nB : cB + (size_t)(t + 2) * kstep;
            const char* a3 = a2 + kstep; const char* b3 = b2 + kstep;
            PG8_LDB(B0, 0, 0); PG8_SCHED; PG8_LDA(At, 0, 0); PG8_STAGE(PG8_SA(1, 1), a1 + hstepA, voffA);
            PG8_WAIT_L(8); PG8_BAR; PG8_WAIT_L(0); PG8_MMA(0, 0, At, B0); PG8_BAR; PG8_SCHED;
            PG8_LDB(B1, 0, 1); PG8_STAGE(PG8_SB(0, 0), b2, voffB);
            PG8_BAR; PG8_WAIT_L(0); PG8_MMA(0, 1, At, B1); PG8_BAR;
            PG8_LDA(At, 0, 1); PG8_STAGE(PG8_SA(0, 0), a2, voffA);
            PG8_BAR; PG8_WAIT_L(0); PG8_MMA(1, 0, At, B0); PG8_BAR; PG8_SCHED;
            PG8_STAGE(PG8_SB(0, 1), b2 + hstepB, voffB);
            PG8_WAIT_V(6); PG8_BAR; PG8_MMA(1, 1, At, B1); PG8_BAR;
            PG8_LDB(B0, 1, 0); PG8_SCHED; PG8_LDA(At, 1, 0); PG8_STAGE(PG8_SA(0, 1), a2 + hstepA, voffA);
            PG8_WAIT_L(8); PG8_BAR; PG8_WAIT_L(0); PG8_MMA(0, 0, At, B0); PG8_BAR; PG8_SCHED;
            PG8_LDB(B1, 1, 1); PG8_STAGE(PG8_SB(1, 0), b3, voffB);
            PG8_BAR; PG8_WAIT_L(0); PG8_MMA(0, 1, At, B1); PG8_BAR;
            PG8_LDA(At, 1, 1); PG8_STAGE(PG8_SA(1, 0), a3, voffA);
            PG8_BAR; PG8_WAIT_L(0); PG8_MMA(1, 0, At, B0); PG8_BAR; PG8_SCHED;
            PG8_STAGE(PG8_SB(1, 1), b3 + hstepB, voffB);
            PG8_WAIT_V(6); PG8_BAR; PG8_MMA(1, 1, At, B1); PG8_BAR;
        }
        E(acc, cur, wr, wc, fr, fq);
        if (!has_next) break;
#pragma unroll
        for (int a = 0; a < 2; ++a)
#pragma unroll
            for (int b = 0; b < 2; ++b)
#pragma unroll
                for (int m = 0; m < 4; ++m)
#pragma unroll
                    for (int n = 0; n < 2; ++n) acc[a][b][m][n] = (f32x4){0.f, 0.f, 0.f, 0.f};
        cur = nxt; cA = nA; cB = nB; ++ui;
    }
    PG8_WAIT_V(0);
    if (wr == 0) PG8_BAR;
    PG8_BAR;
#undef PG8_SA
#undef PG8_SB
#undef PG8_STAGE
#undef PG8_LDA
#undef PG8_LDB
#undef PG8_MMA
#undef PG8_WAIT_V
#undef PG8_WAIT_L
#undef PG8_BAR
#undef PG8_SCHED
}
}
using pg8::Unit;

struct EpiZ {
    static constexpr bool PERM = true;
    bf16_t* Z; bf16_t* A2;
    __device__ __forceinline__ void operator()(const f32x4 (&acc)[2][2][4][2], const Unit& u, int wr, int wc, int fr, int fq) const {
#pragma unroll
        for (int ai = 0; ai < 2; ++ai)
#pragma unroll
            for (int m = 0; m < 4; ++m) {
                const int r = u.pm * 256 + ai * 128 + wr * 64 + m * 16 + fr;
#pragma unroll
                for (int bj = 0; bj < 2; ++bj) {
                    const int c = u.pn * 256 + bj * 128 + wc * 32 + 8 * fq;
                    u32x4 w; w.x = pk2(acc[ai][bj][m][0][0], acc[ai][bj][m][0][1]); w.y = pk2(acc[ai][bj][m][0][2], acc[ai][bj][m][0][3]);
                    w.z = pk2(acc[ai][bj][m][1][0], acc[ai][bj][m][1][1]); w.w = pk2(acc[ai][bj][m][1][2], acc[ai][bj][m][1][3]);
                    if (u.pn == 0) {
                        const int b = r / TT, j = r - b * TT, n = s5pos(j), R = b * NCH + (n >> 5), s = n & 31, g = c >> 4, h0 = c & 15;
                        bf16_t* d0 = A2 + ((size_t)((g * 2) * GROWS + R)) * 640 + s * 16 + h0;
                        *(u32x4*)d0 = w; *(u32x4*)(d0 + (size_t)GROWS * 640) = w;
                    } else {
                        const int zc = c - 256;
                        if (zc < ZLD) *(u32x4*)(Z + (size_t)r * ZLD + zc) = w;
                    }
                }
            }
    }
};
struct EpiResid {
    static constexpr bool PERM = false;
    const float* xin; float* xout; const float* cin; float* cout; const float* mod; int gidx;
    __device__ __forceinline__ void operator()(const f32x4 (&acc)[2][2][4][2], const Unit& u, int wr, int wc, int fr, int fq) const {
        const int b = u.pm / 33, tb = u.pm - b * 33;
        const bool isctx = (tb == 0);
        const float* gate = mod + (size_t)(isctx ? 4 : b) * 6144 + gidx * 1024;
        const size_t row0 = isctx ? (size_t)b * CTX : (size_t)b * SEQ + (size_t)(tb - 1) * 256;
        const float* src = isctx ? cin : xin; float* dst = isctx ? cout : xout;
        const int col0 = u.pn * 256 + wc * 32 + 4 * fq;
#pragma unroll
        for (int ai = 0; ai < 2; ++ai)
#pragma unroll
            for (int m = 0; m < 4; ++m) {
                const size_t ro = (row0 + ai * 128 + wr * 64 + m * 16 + fr) * DM;
#pragma unroll
                for (int bj = 0; bj < 2; ++bj)
#pragma unroll
                    for (int n = 0; n < 2; ++n) {
                        const int c = col0 + bj * 128 + n * 16;
                        const f32x4 gv = *(const f32x4*)(gate + c); const f32x4 xv = *(const f32x4*)(src + ro + c);
                        *(f32x4*)(dst + ro + c) = xv + gv * acc[ai][bj][m][n];
                    }
                asm volatile("" ::: "memory");
            }
    }
};
struct EpiSwiGLU {
    static constexpr bool PERM = false;
    bf16_t* HID;
    __device__ __forceinline__ void operator()(const f32x4 (&acc)[2][2][4][2], const Unit& u, int wr, int wc, int fr, int fq) const {
#pragma unroll
        for (int ai = 0; ai < 2; ++ai)
#pragma unroll
            for (int m = 0; m < 4; ++m) {
                const size_t r = (size_t)(u.pm * 256 + ai * 128 + wr * 64 + m * 16 + fr);
#pragma unroll
                for (int bj = 0; bj < 2; ++bj) {
                    const int hc = u.pn * 128 + bj * 64 + wc * 16 + 4 * fq;
                    f32x4 o;
#pragma unroll
                    for (int i = 0; i < 4; ++i) o[i] = siluf_(acc[ai][bj][m][0][i]) * acc[ai][bj][m][1][i];
                    *(u32x2*)(HID + r * FFN + hc) = pk4(o);
                }
                asm volatile("" ::: "memory");
            }
    }
};
struct EpiHL {
    static constexpr bool PERM = false;
    float* HL;
    __device__ __forceinline__ void operator()(const f32x4 (&acc)[2][2][4][2], const Unit& u, int wr, int wc, int fr, int fq) const {
#pragma unroll
        for (int ai = 0; ai < 2; ++ai)
#pragma unroll
            for (int m = 0; m < 4; ++m) {
                const int R = u.pm * 256 + ai * 128 + wr * 64 + m * 16 + fr;
                if (R < GROWS) {
                    float* rp = HL + ((size_t)u.grp * GROWS + R) * 256 + wc * 32 + 4 * fq;
#pragma unroll
                    for (int bj = 0; bj < 2; ++bj)
#pragma unroll
                        for (int n = 0; n < 2; ++n) *(f32x4*)(rp + bj * 128 + n * 16) = acc[ai][bj][m][n];
                }
                asm volatile("" ::: "memory");
            }
    }
};
struct EpiY5 {
    static constexpr bool PERM = true;
    bf16_t* Y5;
    __device__ __forceinline__ void operator()(const f32x4 (&acc)[2][2][4][2], const Unit& u, int wr, int wc, int fr, int fq) const {
#pragma unroll
        for (int ai = 0; ai < 2; ++ai)
#pragma unroll
            for (int m = 0; m < 4; ++m) {
                const int R = u.pm * 256 + ai * 128 + wr * 64 + m * 16 + fr;
                if (R < GROWS) {
                    bf16_t* rp = Y5 + ((size_t)u.grp * GROWS + R) * 512 + u.pn * 256 + wc * 32 + 8 * fq;
#pragma unroll
                    for (int bj = 0; bj < 2; ++bj) {
                        u32x4 w; w.x = pk2(acc[ai][bj][m][0][0], acc[ai][bj][m][0][1]); w.y = pk2(acc[ai][bj][m][0][2], acc[ai][bj][m][0][3]);
                        w.z = pk2(acc[ai][bj][m][1][0], acc[ai][bj][m][1][1]); w.w = pk2(acc[ai][bj][m][1][2], acc[ai][bj][m][1][3]);
                        *(u32x4*)(rp + bj * 128) = w;
                    }
                }
            }
    }
};

__device__ __forceinline__ pg8::Sched sched_static(int M, int N, int lda, int ldb) {
    pg8::Sched S; S.mode = 0; S.nM = M / 256; S.nN = N / 256; S.nwg = S.nM * S.nN; S.G = gridDim.x; S.c = bidx();
    S.gA = 0; S.gB = 0; S.tA = (size_t)256 * lda * 2; S.tB = (size_t)256 * ldb * 2; return S;
}

__device__ __forceinline__ void phase_mod(const PP& p, float* sm) {
    float* sv = sm;
    float* part = sm + 5 * 1024;
    const int tid = tid_of(p.wv), w = tid >> 6, lane = tid & 63;
    for (int i = tid; i < 5 * 1024; i += 512) { const int v = i >> 10, k = i & 1023; const float x = v < 4 ? p.in[I_C][v * 1024 + k] : p.in[I_CCTX][k]; sv[i] = siluf_(x); }
    __syncthreads();
    float* mod = (float*)(p.ws + OFF_MOD);
    for (int it = bidx(); it < DEPTH * 48; it += gridDim.x) {
        const int l = it / 48, cb = it - l * 48, col = cb * 128 + 2 * lane;
        const float* W = p.in[I_ADAW] + (size_t)l * 1024 * 6144 + col;
        f32x2 a[5];
#pragma unroll
        for (int i = 0; i < 5; ++i) a[i] = (f32x2){0.f, 0.f};
#pragma unroll 8
        for (int k = w * 128; k < w * 128 + 128; ++k) {
            const f32x2 wv = *(const f32x2*)(W + (size_t)k * 6144);
#pragma unroll
            for (int i = 0; i < 5; ++i) a[i] += sv[i * 1024 + k] * wv;
        }
#pragma unroll
        for (int i = 0; i < 5; ++i) { part[(w * 5 + i) * 128 + 2 * lane] = a[i].x; part[(w * 5 + i) * 128 + 2 * lane + 1] = a[i].y; }
        __syncthreads();
        for (int o = tid; o < 640; o += 512) { const int i = o >> 7, cc = o & 127; float s = 0.f;
#pragma unroll
            for (int ww = 0; ww < 8; ++ww) s += part[(ww * 5 + i) * 128 + cc];
            mod[((size_t)l * 5 + i) * 6144 + cb * 128 + cc] = s + p.in[I_ADAB][l * 6144 + cb * 128 + cc]; }
        __syncthreads();
    }
}

__device__ __forceinline__ int n_coef_blocks() { return gridDim.x >= 128 ? 64 : 0; }
__device__ __forceinline__ void convT_tile(const float* src, const float* src2, int ldn, bf16_t* dst, int K, int kind, int n0, int k0, float* sm, int wv) {
    const int tid = tid_of(wv);
    {
        const int nn = tid & 63, kq = tid >> 6;
        const int np = n0 + nn; const float* s = src; int col;
        if (kind == 0) col = np < 256 ? 2968 + np : (np < 3224 ? np - 256 : -1);
        else if (kind == 1) col = np;
        else { const int G = np >> 5, w = np & 31; col = 16 * G + (w & 15); if (w >= 16) s = src2; }
#pragma unroll
        for (int i = 0; i < 8; ++i) { const int kk = kq + 8 * i; sm[kk * 65 + nn] = col >= 0 ? s[(size_t)(k0 + kk) * ldn + col] : 0.f; }
    }
    __syncthreads();
    {
        const int n = tid >> 3, ks = (tid & 7) * 8;
        u32x4 w; w.x = pk2(sm[(ks + 0) * 65 + n], sm[(ks + 1) * 65 + n]); w.y = pk2(sm[(ks + 2) * 65 + n], sm[(ks + 3) * 65 + n]);
        w.z = pk2(sm[(ks + 4) * 65 + n], sm[(ks + 5) * 65 + n]); w.w = pk2(sm[(ks + 6) * 65 + n], sm[(ks + 7) * 65 + n]);
        *(u32x4*)(dst + (size_t)(n0 + n) * K + k0 + ks) = w;
    }
    __syncthreads();
}
__device__ __forceinline__ void phase_convw(const PP& p, int l, float* sm, int w0, int nwb, int ffn) {
    constexpr int T0 = 832, T1 = T0 + 256, T2 = T1 + 1408, T3 = T2 + 704, T4 = T3 + 12, T5 = T4 + 12, T6 = T5 + 12, T7 = T6 + 16;
    const int wb = bidx() - w0;
    if (wb < 0 || wb >= nwb) return;
    const int nt = ffn ? (T3 - T1) : (T7 - (T3 - T1));
    for (int tt = wb; tt < nt; tt += nwb) {
        const int t = ffn ? tt + T1 : (tt < T1 ? tt : tt + (T3 - T1));
        if (t < T0) { convT_tile(p.in[I_WIN] + (size_t)l * 1024 * 3224, nullptr, 3224, (bf16_t*)(p.ws + OFF_WIN), 1024, 0, (t >> 4) * 64, (t & 15) * 64, sm, p.wv); }
        else if (t < T1) { const int q = t - T0; convT_tile(p.in[I_WOUT] + (size_t)l * 1024 * 1024, nullptr, 1024, (bf16_t*)(p.ws + OFF_WOUT), 1024, 1, (q >> 4) * 64, (q & 15) * 64, sm, p.wv); }
        else if (t < T2) { const int q = t - T1; convT_tile(p.in[I_FG8] + (size_t)l * 1024 * FFN, p.in[I_FU] + (size_t)l * 1024 * FFN, FFN, (bf16_t*)(p.ws + OFF_WGU), 1024, 2, (q >> 4) * 64, (q & 15) * 64, sm, p.wv); }
        else if (t < T3) { const int q = t - T2; convT_tile(p.in[I_FD] + (size_t)l * FFN * 1024, nullptr, 1024, (bf16_t*)(p.ws + OFF_WDN), FFN, 1, (q / 44) * 64, (q % 44) * 64, sm, p.wv); }
        else if (t < T4) { const int q = t - T3, d = q / 6; convT_tile(p.in[I_WUP] + ((size_t)l * 2 + d) * 64 * 384, nullptr, 384, (bf16_t*)(p.ws + OFF_WUP) + d * 384 * 64, 64, 1, (q % 6) * 64, 0, sm, p.wv); }
        else if (t < T5) { const int q = t - T4, d = q / 6; convT_tile(p.in[I_AUP] + ((size_t)l * 2 + d) * 64 * 384, nullptr, 384, (bf16_t*)(p.ws + OFF_AUP) + d * 384 * 64, 64, 1, (q % 6) * 64, 0, sm, p.wv); }
        else if (t < T6) { const int q = t - T5; convT_tile(p.in[I_GUP] + (size_t)l * 128 * 384, nullptr, 384, (bf16_t*)(p.ws + OFF_GUP), 128, 1, (q >> 1) * 64, (q & 1) * 64, sm, p.wv); }
        else { const int q = t - T6; convT_tile(p.in[I_GLUW] + (size_t)l * 256 * 256, nullptr, 256, (bf16_t*)(p.ws + OFF_GLU), 256, 1, (q >> 2) * 64, (q & 3) * 64, sm, p.wv); }
    }
}

__device__ __forceinline__ void phase_s5coef(const PP& p, int l, float* sm) {
    float* pw = sm;
    float* bb = pw + 33 * 128;
    float* cc = bb + 2048;
    float* Kt = cc + 2048;
    const int tid = tid_of(p.wv);
    bf16_t* TF = (bf16_t*)(p.ws + OFF_TF); bf16_t* E2 = (bf16_t*)(p.ws + OFF_E2); float* DP = (float*)(p.ws + OFF_DP);
    for (int item = (int)gridDim.x - 1 - (int)bidx(); item < 64; item += gridDim.x) {
        const int it = item >> 1, part = item & 1, g = it >> 1, dir = it & 1;
        const size_t base = ((size_t)l * 2 + dir) * 16 + g;
        if (tid < 64) {
            const int q = tid;
            const float lre = p.in[I_LRE][base * 64 + q], lim = p.in[I_LIM][base * 64 + q], dt = __expf(p.in[I_LDT][base]);
            const float mag = __expf(lre * dt); float sn, cs; sincosf(lim * dt, &sn, &cs);
            const float are = mag * cs, aim = mag * sn, den = lre * lre + lim * lim;
            const float fre = ((are - 1.f) * lre + aim * lim) / den, fim = (aim * lre - (are - 1.f) * lim) / den;
            float pr = 1.f, pi = 0.f;
            for (int m = 0; m <= 32; ++m) { pw[(m * 64 + q) * 2] = pr; pw[(m * 64 + q) * 2 + 1] = pi; const float nr = pr * are - pi * aim, ni = pr * aim + pi * are; pr = nr; pi = ni; }
            for (int h = 0; h < 16; ++h) { const float br = p.in[I_BRE][(base * 64 + q) * 16 + h], bi = p.in[I_BIM][(base * 64 + q) * 16 + h];
                bb[(q * 16 + h) * 2] = fre * br - fim * bi; bb[(q * 16 + h) * 2 + 1] = fre * bi + fim * br; }
            if (part == 0) { DP[(it * 64 + q) * 2] = pw[(32 * 64 + q) * 2]; DP[(it * 64 + q) * 2 + 1] = pw[(32 * 64 + q) * 2 + 1]; }
        }
        for (int i = tid; i < 1024; i += 512) { const int h = i >> 6, q = i & 63; cc[i * 2] = p.in[I_CRE][(base * 16 + h) * 64 + q]; cc[i * 2 + 1] = p.in[I_CIM][(base * 16 + h) * 64 + q]; }
        __syncthreads();
        {
            const int lag = tid >> 4, hp = tid & 15;
            float s[16];
#pragma unroll
            for (int h = 0; h < 16; ++h) s[h] = 0.f;
            for (int q = 0; q < 64; ++q) {
                const f32x2 c2 = *(const f32x2*)(cc + (hp * 64 + q) * 2), w2 = *(const f32x2*)(pw + (lag * 64 + q) * 2);
                const float xr = c2.x * w2.x - c2.y * w2.y, xi = c2.x * w2.y + c2.y * w2.x;
#pragma unroll
                for (int h4 = 0; h4 < 8; ++h4) { const f32x4 b4 = *(const f32x4*)(bb + (q * 16 + 2 * h4) * 2); s[2 * h4] += xr * b4[0] - xi * b4[1]; s[2 * h4 + 1] += xr * b4[2] - xi * b4[3]; }
            }
#pragma unroll
            for (int h4 = 0; h4 < 4; ++h4) *(f32x4*)(Kt + lag * 256 + hp * 16 + 4 * h4) = (f32x4){s[4 * h4], s[4 * h4 + 1], s[4 * h4 + 2], s[4 * h4 + 3]};
        }
        __syncthreads();
        bf16_t* tf = TF + (size_t)it * 512 * 640;
        for (int o = part * 256 * 320 + tid; o < (part + 1) * 256 * 320; o += 512) {
            const int row = o / 320, c2 = (o - row * 320) * 2, t = row >> 4, hp = row & 15;
            float v[2];
            if (c2 < 512) {
#pragma unroll
                for (int e = 0; e < 2; ++e) { const int col = c2 + e, s = col >> 4, h = col & 15; const int lag = dir == 0 ? t - s : s - t; v[e] = lag >= 0 ? Kt[lag * 256 + hp * 16 + h] : 0.f; }
            } else {
                const int q = (c2 - 512) >> 1, m = dir == 0 ? t + 1 : 32 - t;
                const float cr = cc[(hp * 64 + q) * 2], ci = cc[(hp * 64 + q) * 2 + 1], wr_ = pw[(m * 64 + q) * 2], wi = pw[(m * 64 + q) * 2 + 1];
                v[0] = cr * wr_ - ci * wi; v[1] = -(cr * wi + ci * wr_);
            }
            *(unsigned*)(tf + (size_t)row * 640 + c2) = pk2(v[0], v[1]);
        }
        bf16_t* e2 = E2 + ((size_t)g * 256 + dir * 128) * 512;
        for (int o = part * 64 * 256 + tid; o < (part + 1) * 64 * 256; o += 512) {
            const int row = o >> 8, c2 = (o & 255) * 2, q = row >> 1, ri = row & 1; float v[2];
#pragma unroll
            for (int e = 0; e < 2; ++e) { const int col = c2 + e, s = col >> 4, h = col & 15, ex = dir == 0 ? 31 - s : s;
                const float wr_ = pw[(ex * 64 + q) * 2], wi = pw[(ex * 64 + q) * 2 + 1], br = bb[(q * 16 + h) * 2], bi = bb[(q * 16 + h) * 2 + 1];
                v[e] = ri == 0 ? (wr_ * br - wi * bi) : (wr_ * bi + wi * br); }
            *(unsigned*)(e2 + (size_t)row * 512 + c2) = pk2(v[0], v[1]);
        }
        __syncthreads();
    }
}

__device__ __forceinline__ void phase_norm(const PP& p, int l, int which, const float* xsrc, const float* csrc, int share) {
    const int nwb = (int)gridDim.x - (share ? n_coef_blocks() : 0);
    if (bidx() >= nwb) return;
    const int lane = tid_of(p.wv) & 63, gw = bidx() * 8 + (tid_of(p.wv) >> 6), nw = nwb * 8;
    const float* gain = p.in[which == 0 ? I_N1G : I_N2G] + l * 1024;
    const float* mod = (const float*)(p.ws + OFF_MOD) + (size_t)l * 5 * 6144;
    bf16_t* H = (bf16_t*)(p.ws + OFF_H);
    for (int r = gw; r < MROWS; r += nw) {
        const int b = r / TT, j = r - b * TT;
        const float* src = j < CTX ? csrc + ((size_t)b * CTX + j) * DM : xsrc + ((size_t)b * SEQ + (j - CTX)) * DM;
        const float* mv = mod + (size_t)(j < CTX ? 4 : b) * 6144 + (which == 0 ? 0 : 3072);
        f32x4 v[4]; float ss = 0.f;
#pragma unroll
        for (int i = 0; i < 4; ++i) { v[i] = *(const f32x4*)(src + i * 256 + lane * 4); ss += v[i][0] * v[i][0] + v[i][1] * v[i][1] + v[i][2] * v[i][2] + v[i][3] * v[i][3]; }
        ss = red64(ss);
        const float rs = __builtin_amdgcn_rsqf(ss * (1.f / 1024.f) + 1e-6f);
#pragma unroll
        for (int i = 0; i < 4; ++i) {
            const int c = i * 256 + lane * 4;
            const f32x4 gv = *(const f32x4*)(gain + c), sh = *(const f32x4*)(mv + c), sc = *(const f32x4*)(mv + 1024 + c);
            const f32x4 y = v[i] * rs * gv * (sc + 1.f) + sh;
            *(u32x2*)(H + (size_t)r * DM + c) = pk4(y);
        }
    }
}
__device__ __forceinline__ void phase_final(const PP& p) {
    const int lane = tid_of(p.wv) & 63, gw = bidx() * 8 + (tid_of(p.wv) >> 6), nw = gridDim.x * 8;
    const float* gain = p.in[I_FG];
    for (int r = gw; r < NB * SEQ; r += nw) {
        float* src = p.out + (size_t)r * DM;
        f32x4 v[4]; float ss = 0.f;
#pragma unroll
        for (int i = 0; i < 4; ++i) { v[i] = *(const f32x4*)(src + i * 256 + lane * 4); ss += v[i][0] * v[i][0] + v[i][1] * v[i][1] + v[i][2] * v[i][2] + v[i][3] * v[i][3]; }
        ss = red64(ss);
        const float rs = __builtin_amdgcn_rsqf(ss * (1.f / 1024.f) + 1e-6f);
#pragma unroll
        for (int i = 0; i < 4; ++i) { const int c = i * 256 + lane * 4; const f32x4 gv = *(const f32x4*)(gain + c); *(f32x4*)(src + c) = v[i] * rs * gv; }
    }
}

struct Nb3 { u32x2 pv, cu, nx; };
__device__ __forceinline__ Nb3 ld3(const bf16_t* Z, int row, bool hp, bool hn, int col) {
    Nb3 o; const bf16_t* q = Z + (size_t)row * ZLD + col;
    o.cu = *(const u32x2*)q;
    o.pv = hp ? *(const u32x2*)(q - ZLD) : (u32x2){0u, 0u};
    o.nx = hn ? *(const u32x2*)(q + ZLD) : (u32x2){0u, 0u};
    return o;
}
__device__ __forceinline__ f32x4 shiftmix(const Nb3& v, const float* mu) {
    const f32x4 c = unpk4(v.cu), a = unpk4(v.pv), n = unpk4(v.nx), m = *(const f32x4*)mu;
    return c + ((a + n) * 0.5f - c) * m;
}


constexpr int RWP_LD = 896;
__device__ __forceinline__ void phase_rwprep(const PP& p, int l) {
    const bf16_t* Z = (const bf16_t*)(p.ws + OFF_Z);
    bf16_t* RWP = (bf16_t*)(p.ws + OFF_H);
    const float* mu = p.in[I_MU] + l * 1408;
    const int nth = gridDim.x * 512;
    for (int idx = bidx() * 512 + tid_of(p.wv); idx < MROWS * 112; idx += nth) {
        const int row = idx / 112, qd = idx - row * 112, col0 = 8 * qd, zc = col0 < 768 ? col0 : col0 + 384;
        const int b = row / TT, j = row - b * TT;
        const bool hp = (j != 0) && (j != CTX), hn = (j != CTX - 1) && (j != TT - 1);
        const bf16_t* q = Z + (size_t)row * ZLD + zc;
        const u32x4 cu = *(const u32x4*)q;
        const u32x4 pv = hp ? *(const u32x4*)(q - ZLD) : (u32x4){0u, 0u, 0u, 0u};
        const u32x4 nx = hn ? *(const u32x4*)(q + ZLD) : (u32x4){0u, 0u, 0u, 0u};
        const f32x4 m0 = *(const f32x4*)(mu + zc), m1 = *(const f32x4*)(mu + zc + 4);
        const f32x4 c0 = (f32x4){bflo(cu.x), bfhi(cu.x), bflo(cu.y), bfhi(cu.y)}, c1 = (f32x4){bflo(cu.z), bfhi(cu.z), bflo(cu.w), bfhi(cu.w)};
        const f32x4 a0 = (f32x4){bflo(pv.x), bfhi(pv.x), bflo(pv.y), bfhi(pv.y)}, a1 = (f32x4){bflo(pv.z), bfhi(pv.z), bflo(pv.w), bfhi(pv.w)};
        const f32x4 n0 = (f32x4){bflo(nx.x), bfhi(nx.x), bflo(nx.y), bfhi(nx.y)}, n1 = (f32x4){bflo(nx.z), bfhi(nx.z), bflo(nx.w), bfhi(nx.w)};
        f32x4 v0 = c0 + ((a0 + n0) * 0.5f - c0) * m0, v1 = c1 + ((a1 + n1) * 0.5f - c1) * m1;
        if (col0 >= 768 && col0 < 832) {
#pragma unroll
            for (int i = 0; i < 4; ++i) { v0[i] = tanhf_(v0[i]); v1[i] = tanhf_(v1[i]); }
        }
        u32x4 o; o.x = pk2(v0[0], v0[1]); o.y = pk2(v0[2], v0[3]); o.z = pk2(v1[0], v1[1]); o.w = pk2(v1[2], v1[3]);
        *(u32x4*)(RWP + (size_t)row * RWP_LD + col0) = o;
    }
}

namespace ck {
constexpr int PC_STRIDE = 18432, PCB_BYTES = 36864, WKS0 = 73728, WKS_BYTES = 9216, WKP0 = 110592, WKP_BYTES = 3072, SW0 = 116736, SAA0 = 134144, SY0 = 151552, CST0 = 159744, SWLD = 68, SWBUF = 32 * 68;
__device__ __forceinline__ bf16x8 mk8(u32x2 lo, u32x2 hi) { u32x4 t; t.x = lo.x; t.y = lo.y; t.z = hi.x; t.w = hi.y; return __builtin_bit_cast(bf16x8, t); }
__device__ __forceinline__ bf16x8 pk8z(f32x4 v) { return mk8(pk4(v), (u32x2){0u, 0u}); }
#define CK_MFMA(a, b, c) __builtin_amdgcn_mfma_f32_16x16x32_bf16(a, b, c, 0, 0, 0)
__device__ __forceinline__ int krow(int k) { return (k & ~3) | ((k + (k >> 3)) & 3); }
template <int TYPE, bool MIDBAR>
__device__ __forceinline__ void prep_wave(const char* pc, char* wkp, char* wks, int lane) {
    const int row16 = lane & 15, q = lane >> 4;
    const u32x2 Z2 = (u32x2){0u, 0u};
    const f32x4 z4 = (f32x4){0.f, 0.f, 0.f, 0.f};
    float* AMak = (float*)wkp; float* AMrb = (float*)(wkp + 1024); float* AMrk = (float*)(wkp + 2048);
    bf16_t* W1row = (bf16_t*)wks; bf16_t* R2row = (bf16_t*)(wks + 2304);
    const bf16_t* GA = (const bf16_t*)pc; const bf16_t* GR = (const bf16_t*)(pc + 2304); const bf16_t* GB = (const bf16_t*)(pc + 4608);
    const bf16_t* GK = (const bf16_t*)(pc + (TYPE == 0 ? 6912 : 4608));
    const bf16_t* GAT = (const bf16_t*)(pc + 9216); const bf16_t* VT = (const bf16_t*)(pc + 15360);
    const float* gc = (const float*)(pc + 17408);
    f32x4 gab = z4, gabT = z4, gak = z4, grb = z4, grk = z4;
#pragma unroll
    for (int ks = 0; ks < 2; ++ks) {
        const int o = row16 * 72 + 8 * q + 32 * ks;
        const bf16x8 ra = *(const bf16x8*)(GA + o), rr = *(const bf16x8*)(GR + o), cbf = *(const bf16x8*)(GB + o), ckf = *(const bf16x8*)(GK + o);
        gab = CK_MFMA(ra, cbf, gab); gabT = CK_MFMA(cbf, ra, gabT); gak = CK_MFMA(ra, ckf, gak); grb = CK_MFMA(rr, cbf, grb); grk = CK_MFMA(rr, ckf, grk);
    }
#pragma unroll
    for (int r = 0; r < 4; ++r) {
        const int t = 4 * q + r, i = row16; const bool ks_ = i < t, kl = i <= t;
        float dS = 1.f, dL = 1.f, dT = 1.f;
        if (TYPE == 1) { const float gi = gc[i]; dS = __expf(ks_ ? gc[t > 0 ? t - 1 : 0] - gi : 0.f); dL = __expf(kl ? gc[t] - gi : 0.f);
                         const int t2 = row16, i2 = 4 * q + r; dT = __expf(i2 < t2 ? gc[t2 - 1] - gc[i2] : 0.f); }
        gab[r] = ks_ ? gab[r] * dS : 0.f; gak[r] = ks_ ? gak[r] * dS : 0.f; grb[r] = kl ? grb[r] * dL : 0.f; grk[r] = kl ? grk[r] * dL : 0.f;
        gabT[r] = (4 * q + r < row16) ? gabT[r] * dT : 0.f;
    }
    f32x4 A = gab, AT = gabT, MT;
#pragma unroll
    for (int r = 0; r < 4; ++r) MT[r] = AT[r] + ((4 * q + r == row16) ? 1.f : 0.f);
#pragma unroll
    for (int s = 0; s < 3; ++s) {
        const bf16x8 pa = pk8z(A), pat = pk8z(AT);
        const f32x4 A2 = CK_MFMA(pat, pa, z4);
        MT = CK_MFMA(pk8z(A2), pk8z(MT), MT);
        if (s < 2) { AT = CK_MFMA(pa, pat, z4); A = A2; }
    }
    if (MIDBAR) lbar();
    const bf16x8 mplain = pk8z(MT);
    bf16x8 mfA = mplain;
    if (TYPE == 1) mfA = pk8z(MT * *(const f32x4*)(gc + 32 + 4 * q));
#pragma unroll
    for (int r = 0; r < 4; ++r) { AMak[(4 * q + r) * 16 + row16] = gak[r]; AMrb[(4 * q + r) * 16 + row16] = grb[r]; AMrk[(4 * q + r) * 16 + row16] = grk[r]; }
    const f32x4 aak4 = *(const f32x4*)(AMak + row16 * 16 + 4 * q), arb4 = *(const f32x4*)(AMrb + row16 * 16 + 4 * q), ark4 = *(const f32x4*)(AMrk + row16 * 16 + 4 * q);
    const bf16x8 arbB = pk8z(arb4);
#pragma unroll
    for (int nt = 0; nt < 4; ++nt) {
        const bf16x8 gfB = mk8(*(const u32x2*)(GAT + krow(16 * nt + row16) * 16 + 4 * q), Z2);
        const f32x4 W1n = CK_MFMA(mfA, gfB, z4);
        const f32x4 W1T = CK_MFMA(gfB, mfA, z4);
        *(u32x2*)(W1row + row16 * 72 + 16 * nt + 4 * q) = pk4(W1T);
        f32x4 cin = unpk4(*(const u32x2*)(GR + row16 * 72 + 16 * nt + 4 * q));
        if (TYPE == 1) cin = cin * gc[16 + row16];
        const f32x4 R2T = CK_MFMA(pk8z(W1n), arbB, cin);
        *(u32x2*)(R2row + row16 * 72 + 16 * nt + 4 * q) = pk4(R2T);
    }
    const bf16x8 aakA = pk8z(aak4), arbk = mk8(pk4(arb4), pk4(ark4));
#pragma unroll
    for (int vt = 0; vt < 2; ++vt) {
        const u32x2 vtf = *(const u32x2*)(VT + krow(16 * vt + row16) * 16 + 4 * q);
        const f32x4 AV = CK_MFMA(aakA, mk8(vtf, Z2), z4);
        const f32x4 W2 = CK_MFMA(mplain, pk8z(AV), z4);
        const f32x4 Y3 = CK_MFMA(arbk, mk8(pk4(W2), vtf), z4);
        f32x4* C2 = (f32x4*)(wks + 4608 + vt * 2048);
        C2[lane] = W2; C2[64 + lane] = Y3;
    }
}
template <int TYPE>
__device__ __forceinline__ void seq_wave(const char* pc, const char* wks, float* sYc, int vt, int lane, f32x4 (&Sreg)[4]) {
    const int row16 = lane & 15, q = lane >> 4;
    const bf16_t* W1row = (const bf16_t*)wks; const bf16_t* R2row = (const bf16_t*)(wks + 2304); const f32x4* C2 = (const f32x4*)(wks + 4608 + vt * 2048);
    const bf16_t* GBT = (const bf16_t*)(pc + 11264); const bf16_t* GKT = (const bf16_t*)(pc + (TYPE == 0 ? 13312 : 11264)); const bf16_t* VST = (const bf16_t*)(pc + 16384);
    const float* gc = (const float*)(pc + 17408); const float* pC = (const float*)(pc + 17664);
    f32x4 U = C2[lane], Y = C2[64 + lane];
#pragma unroll
    for (int ks = 0; ks < 2; ++ks) {
        const bf16x8 sf = mk8(pk4(Sreg[2 * ks]), pk4(Sreg[2 * ks + 1]));
        const bf16x8 a1 = mk8(*(const u32x2*)(W1row + row16 * 72 + 32 * ks + 4 * q), *(const u32x2*)(W1row + row16 * 72 + 32 * ks + 16 + 4 * q));
        const bf16x8 a2 = mk8(*(const u32x2*)(R2row + row16 * 72 + 32 * ks + 4 * q), *(const u32x2*)(R2row + row16 * 72 + 32 * ks + 16 + 4 * q));
        U = CK_MFMA(a1, sf, U);
        Y = CK_MFMA(a2, sf, Y);
    }
#pragma unroll
    for (int r = 0; r < 4; ++r) sYc[(4 * q + r) * 32 + 16 * vt + row16] = Y[r];
    if (TYPE == 1) U = U * *(const f32x4*)(gc + 48 + 4 * q);
    const bf16x8 ub = mk8(pk4(U), *(const u32x2*)(VST + krow(16 * vt + row16) * 16 + 4 * q));
#pragma unroll
    for (int kt = 0; kt < 4; ++kt) {
        const bf16x8 ak = mk8(*(const u32x2*)(GBT + krow(16 * kt + row16) * 16 + 4 * q), *(const u32x2*)(GKT + krow(16 * kt + row16) * 16 + 4 * q));
        const f32x4 pc4 = *(const f32x4*)(pC + 16 * kt + 4 * q);
        if (TYPE == 0) Sreg[kt] = CK_MFMA(ak, ub, Sreg[kt]) * pc4;
        else Sreg[kt] = CK_MFMA(ak, ub, Sreg[kt] * pc4);
    }
}
template <int TYPE, class F>
__device__ __forceinline__ void seq_role(char* cb, int vt, int lane, F&& extra) {
    f32x4 Sreg[4];
#pragma unroll
    for (int i = 0; i < 4; ++i) Sreg[i] = (f32x4){0.f, 0.f, 0.f, 0.f};
    extra(0); lbar(); extra(1); lbar();
    for (int k = 0; k <= NCH; ++k) {
        if (k > 0) {
            const int kb = k - 1;
            seq_wave<TYPE>(cb + (kb & 1) * PCB_BYTES, cb + WKS0 + ((kb & 1) * 2 + 0) * WKS_BYTES, (float*)(cb + SY0 + (kb & 1) * 4096), vt, lane, Sreg);
            seq_wave<TYPE>(cb + (kb & 1) * PCB_BYTES + PC_STRIDE, cb + WKS0 + ((kb & 1) * 2 + 1) * WKS_BYTES, (float*)(cb + SY0 + (kb & 1) * 4096) + 16 * 32, vt, lane, Sreg);
        }
        lbar();
        extra(k + 2);
        lbar();
    }
}
template <int TYPE>
__device__ __forceinline__ void prep_role(char* cb, int c, int lane) {
    lbar(); lbar();
    for (int k = 0; k <= NCH; ++k) {
        if (k < NCH) prep_wave<TYPE, true>(cb + (k & 1) * PCB_BYTES + c * PC_STRIDE, cb + WKP0 + c * WKP_BYTES, cb + WKS0 + ((k & 1) * 2 + c) * WKS_BYTES, lane);
        else lbar();
        lbar();
    }
}
__device__ __forceinline__ float red8(float x) { x += dppf<0xB1>(x); x += dppf<0x4E>(x); x += dppf<0x141>(x); return x; }
__device__ __forceinline__ void st8T(bf16_t* base, int row0, int t, u32x4 v) {
    const int r = row0 >> 3;
    base[(row0 + 0 + ((0 + r) & 3)) * 16 + t] = (bf16_t)v.x; base[(row0 + 0 + ((1 + r) & 3)) * 16 + t] = (bf16_t)(v.x >> 16); base[(row0 + 0 + ((2 + r) & 3)) * 16 + t] = (bf16_t)v.y; base[(row0 + 0 + ((3 + r) & 3)) * 16 + t] = (bf16_t)(v.y >> 16);
    base[(row0 + 4 + ((0 + r) & 3)) * 16 + t] = (bf16_t)v.z; base[(row0 + 4 + ((1 + r) & 3)) * 16 + t] = (bf16_t)(v.z >> 16); base[(row0 + 4 + ((2 + r) & 3)) * 16 + t] = (bf16_t)v.w; base[(row0 + 4 + ((3 + r) & 3)) * 16 + t] = (bf16_t)(v.w >> 16);
}
__device__ __forceinline__ u32x4 pk8(const f32x4& a, const f32x4& b) { u32x4 r; r.x = pk2(a[0], a[1]); r.y = pk2(a[2], a[3]); r.z = pk2(b[0], b[1]); r.w = pk2(b[2], b[3]); return r; }
__device__ __forceinline__ void unpk8(u32x4 v, f32x4& a, f32x4& b) { a = (f32x4){bflo(v.x), bfhi(v.x), bflo(v.y), bfhi(v.y)}; b = (f32x4){bflo(v.z), bfhi(v.z), bflo(v.w), bfhi(v.w)}; }
}

__device__ __forceinline__ void rwkv_job(const PP& p, int l, int job, float* sm) {
    char* cb = (char*)sm;
    float* sW = (float*)(cb + ck::SW0); float* sAA = (float*)(cb + ck::SAA0); float* cst = (float*)(cb + ck::CST0);
    const int half = job & 1, dir = (job >> 1) & 1, bh = job >> 2, b = bh / 6, h = bh - b * 6;
    const int tid = tid_of(p.wv), w = tid >> 6, lane = tid & 63;
    const bf16_t* Z = (const bf16_t*)(p.ws + OFF_Z); const bf16_t* RWP = (const bf16_t*)(p.ws + OFF_H);
    bf16_t* Y = (bf16_t*)(p.ws + OFF_YO) + (size_t)dir * MROWS * 384;
    float* BC = (float*)(p.ws + OFF_BC) + (size_t)dir * MROWS * 6;
    if (tid < 64) { cst[tid] = p.in[I_KK][l * 384 + h * 64 + tid]; cst[64 + tid] = p.in[I_KA][l * 384 + h * 64 + tid]; cst[128 + tid] = p.in[I_RK][l * 384 + h * 64 + tid];
        cst[192 + tid] = p.in[I_MU][l * 1408 + 768 + h * 64 + tid];
        cst[256 + tid] = p.in[I_W0][((size_t)l * 2 + dir) * 384 + h * 64 + tid]; cst[320 + tid] = p.in[I_A0][((size_t)l * 2 + dir) * 384 + h * 64 + tid]; }
    lbar();
    if (w < 2) ck::prep_role<0>(cb, w, lane);
    else if (w == 4 || w == 5) {
        const int mt = w - 4, fr = lane & 15, fq = lane >> 4;
        bf16x8 wfw[4][2], wfa[4][2];
#pragma unroll
        for (int nt = 0; nt < 4; ++nt) {
            const bf16_t* wu = (const bf16_t*)(p.ws + OFF_WUP) + ((size_t)dir * 384 + h * 64 + nt * 16 + fr) * 64 + fq * 8;
            const bf16_t* au = (const bf16_t*)(p.ws + OFF_AUP) + ((size_t)dir * 384 + h * 64 + nt * 16 + fr) * 64 + fq * 8;
            wfw[nt][0] = *(const bf16x8*)wu; wfw[nt][1] = *(const bf16x8*)(wu + 32); wfa[nt][0] = *(const bf16x8*)au; wfa[nt][1] = *(const bf16x8*)(au + 32);
        }
        bf16x8 xw[2], xa[2];
        auto loadm = [&](int blk) {
            if (blk < NCH) {
                const int jm = seqpos(dir, blk * 32 + mt * 16 + fr);
                const bf16_t* mp = RWP + (size_t)(b * TT + jm) * RWP_LD + 768 + fq * 8;
                xw[0] = *(const bf16x8*)mp; xw[1] = *(const bf16x8*)(mp + 32); xa[0] = *(const bf16x8*)(mp + 64); xa[1] = *(const bf16x8*)(mp + 96);
            }
        };
        loadm(0);
        auto lora = [&](int blk) {
            if (blk >= NCH) return;
            float* sWb = sW + (blk & 1) * ck::SWBUF; float* sAb = sAA + (blk & 1) * ck::SWBUF;
#pragma unroll
            for (int nt = 0; nt < 4; ++nt) {
                f32x4 aw = (f32x4){0.f, 0.f, 0.f, 0.f}, aa = aw;
#pragma unroll
                for (int ks = 0; ks < 2; ++ks) { aw = CK_MFMA(xw[ks], wfw[nt][ks], aw); aa = CK_MFMA(xa[ks], wfa[nt][ks], aa); }
                const float w0s = cst[256 + nt * 16 + fr], a0s = cst[320 + nt * 16 + fr];
                f32x4 G = (f32x4){0.f, 0.f, 0.f, 0.f};
#pragma unroll
                for (int i = 0; i < 4; ++i) {
                    const float lw = -0.6065306597126334f * sigmoidf_(aw[i] + w0s);
                    G = __builtin_amdgcn_mfma_f32_16x16x4f32((4 * fq + i <= fr) ? 1.f : 0.f, lw, G, 0, 0, 0);
                }
#pragma unroll
                for (int i = 0; i < 4; ++i) {
                    sWb[(mt * 16 + 4 * fq + i) * ck::SWLD + nt * 16 + fr] = G[i];
                    sAb[(mt * 16 + 4 * fq + i) * ck::SWLD + nt * 16 + fr] = sigmoidf_(aa[i] + a0s);
                }
            }
            loadm(blk + 1);
        };
        ck::seq_role<0>(cb, w - 4, lane, lora);
    }

    else {
        const int ew = (w & 1) + ((w >> 2) << 1);
        const int stid = ew * 64 + lane, es = stid >> 3, c8 = stid & 7, ec = h * 64 + 8 * c8, c = es >> 4, t = es & 15;
        struct PF { u32x4 r, k, vp, vc, vn; int row; };
        PF setA, setB;
        const float* sW_ = sW; const float* sAA_ = sAA;
        auto prefetch = [&](PF& s, int blk) {
            if (blk < NCH) {
                const int j = seqpos(dir, blk * 32 + es);
                const bool hp = (j != 0) && (j != CTX), hn = (j != CTX - 1) && (j != TT - 1);
                s.row = b * TT + j;
                const bf16_t* rp = RWP + (size_t)s.row * RWP_LD;
                s.r = *(const u32x4*)(rp + ec); s.k = *(const u32x4*)(rp + 384 + ec);
                const bf16_t* zp = Z + (size_t)s.row * ZLD + 768 + ec;
                s.vc = *(const u32x4*)zp; s.vp = hp ? *(const u32x4*)(zp - ZLD) : (u32x4){0u, 0u, 0u, 0u}; s.vn = hn ? *(const u32x4*)(zp + ZLD) : (u32x4){0u, 0u, 0u, 0u};
            }
        };
        auto flush = [&](int blk) {
            const float* sYb = (const float*)(cb + ck::SY0 + (blk & 1) * 4096);
            const int s = stid >> 3, v4 = (stid & 7) * 4, j = seqpos(dir, blk * 32 + s);
            *(u32x2*)(Y + (size_t)(b * TT + j) * 384 + h * 64 + half * 32 + v4) = pk4(*(const f32x4*)(sYb + s * 32 + v4));
        };
        auto stage = [&](int blk, PF& ps) {
            f32x4 r0, r1, k0, k1, v0, v1;
            ck::unpk8(ps.r, r0, r1); ck::unpk8(ps.k, k0, k1);
            {
                f32x4 a0, a1, c0, c1, n0, n1; ck::unpk8(ps.vp, a0, a1); ck::unpk8(ps.vc, c0, c1); ck::unpk8(ps.vn, n0, n1);
                const f32x4 m0 = *(const f32x4*)(cst + 192 + 8 * c8), m1 = *(const f32x4*)(cst + 196 + 8 * c8);
                v0 = c0 + ((a0 + n0) * 0.5f - c0) * m0; v1 = c1 + ((a1 + n1) * 0.5f - c1) * m1;
            }
            const int myrow = ps.row;
            u32x4 ga, gr, gb, gk, vb; f32x4 x0, x1; float bon;
            auto comp = [&]() {
                const float* sW = sW_ + (blk & 1) * ck::SWBUF; const float* sAA = sAA_ + (blk & 1) * ck::SWBUF;
                const f32x4 a40 = *(const f32x4*)(sAA + es * ck::SWLD + 8 * c8), a41 = *(const f32x4*)(sAA + es * ck::SWLD + 8 * c8 + 4);
                const f32x4 kd0 = k0 * ((a40 - 1.f) * *(const f32x4*)(cst + 64 + 8 * c8) + 1.f), kd1 = k1 * ((a41 - 1.f) * *(const f32x4*)(cst + 68 + 8 * c8) + 1.f);
                const f32x4 kk0 = k0 * *(const f32x4*)(cst + 8 * c8), kk1 = k1 * *(const f32x4*)(cst + 4 + 8 * c8);
                const float ssq = ck::red8(kk0[0] * kk0[0] + kk0[1] * kk0[1] + kk0[2] * kk0[2] + kk0[3] * kk0[3] + kk1[0] * kk1[0] + kk1[1] * kk1[1] + kk1[2] * kk1[2] + kk1[3] * kk1[3]);
                const float rn = __builtin_amdgcn_rsqf(ssq + 1e-6f);
                const f32x4 kn0 = kk0 * rn, kn1 = kk1 * rn;
                const f32x4 tb0 = r0 * kd0 * *(const f32x4*)(cst + 128 + 8 * c8), tb1 = r1 * kd1 * *(const f32x4*)(cst + 132 + 8 * c8);
                bon = ck::red8(tb0[0] + tb0[1] + tb0[2] + tb0[3] + tb1[0] + tb1[1] + tb1[2] + tb1[3]);
                const f32x4 G0 = *(const f32x4*)(sW + es * ck::SWLD + 8 * c8), G1 = *(const f32x4*)(sW + es * ck::SWLD + 8 * c8 + 4);
                const f32x4 T0 = *(const f32x4*)(sW + (16 * c + 15) * ck::SWLD + 8 * c8), T1 = *(const f32x4*)(sW + (16 * c + 15) * ck::SWLD + 8 * c8 + 4);
                f32x4 L0 = (f32x4){0.f, 0.f, 0.f, 0.f}, L1 = L0;
                if (t > 0) { L0 = *(const f32x4*)(sW + (es - 1) * ck::SWLD + 8 * c8); L1 = *(const f32x4*)(sW + (es - 1) * ck::SWLD + 8 * c8 + 4); }
                f32x4 P0, P1, Q0, Q1, I0, I1;
#pragma unroll
                for (int e = 0; e < 4; ++e) { P0[e] = __expf(G0[e]); P1[e] = __expf(G1[e]); Q0[e] = __expf(L0[e]); Q1[e] = __expf(L1[e]); I0[e] = __expf(-G0[e]); I1[e] = __expf(-G1[e]); x0[e] = __expf(T0[e]); x1[e] = __expf(T1[e]); }
                ga = ck::pk8(-kn0 * Q0, -kn1 * Q1); gb = ck::pk8(kn0 * a40 * I0, kn1 * a41 * I1); gk = ck::pk8(kd0 * I0, kd1 * I1); gr = ck::pk8(r0 * P0, r1 * P1);
                vb = ck::pk8(v0, v1);
            };
            if (blk > 0) comp();
            lbar();
            if (blk == 0) comp();
            prefetch(ps, blk + 2);
            if (blk > 1) flush(blk - 2);
            char* pc = cb + (blk & 1) * ck::PCB_BYTES + c * ck::PC_STRIDE;
            if (c8 == 0 && half == 0) BC[(size_t)myrow * 6 + h] = bon;
            *(u32x4*)(pc + (t * 72 + 8 * c8) * 2) = ga;
            *(u32x4*)(pc + 2304 + (t * 72 + 8 * c8) * 2) = gr;
            *(u32x4*)(pc + 4608 + (t * 72 + 8 * c8) * 2) = gb;
            *(u32x4*)(pc + 6912 + (t * 72 + 8 * c8) * 2) = gk;
            ck::st8T((bf16_t*)(pc + 9216), 8 * c8, t, ga); ck::st8T((bf16_t*)(pc + 11264), 8 * c8, t, gb); ck::st8T((bf16_t*)(pc + 13312), 8 * c8, t, gk);
            if (t == 15) { *(f32x4*)(pc + 17664 + 32 * c8) = x0; *(f32x4*)(pc + 17664 + 32 * c8 + 16) = x1; }
            if ((c8 >> 2) == half) { ck::st8T((bf16_t*)(pc + 15360), 8 * c8 - 32 * half, t, vb); ck::st8T((bf16_t*)(pc + 16384), 8 * c8 - 32 * half, t, vb); }
            lbar();
        };
        prefetch(setA, 0); prefetch(setB, 1);
        stage(0, setA);
        for (int k = 0; k < NCH; k += 2) {
            if (k + 1 < NCH) stage(k + 1, setB); else { lbar(); lbar(); }
            if (k + 2 < NCH) stage(k + 2, setA); else { lbar(); lbar(); }
        }
        lbar(); lbar();
        flush(NCH - 2); flush(NCH - 1);
    }
}

__device__ __forceinline__ void gdn_job(const PP& p, int l, int job, float* sm) {
    char* cb = (char*)sm;
    float* sSC = (float*)(cb + ck::SW0);
    float* cst = (float*)(cb + ck::CST0);
    const int half = job & 1, dir = (job >> 1) & 1, bh = job >> 2, b = bh / 6, h = bh - b * 6;
    const int tid = tid_of(p.wv), w = tid >> 6, lane = tid & 63;
    const bf16_t* Z = (const bf16_t*)(p.ws + OFF_Z);
    bf16_t* Y = (bf16_t*)(p.ws + OFF_YO) + (size_t)(2 + dir) * MROWS * 384;
    for (int i = tid; i < 576; i += 512) { const int a = i >> 6, cc = i & 63; cst[i] = p.in[I_CONV][(size_t)l * 3 * 1152 + (a / 3) * 1152 + (a % 3) * 384 + h * 64 + cc]; }
    lbar();
    if (w < 2) ck::prep_role<1>(cb, w, lane);
    else if (w == 2 || w == 3) ck::seq_role<1>(cb, w - 2, lane, [](int) {});
    else {
        const int ew = w - 4;
        const int stid = ew * 64 + lane, es = stid >> 3, c8 = stid & 7, ec = h * 64 + 8 * c8, c = es >> 4, t = es & 15;
        const float aexp = __expf(p.in[I_ALOG][((size_t)l * 2 + dir) * 6 + h]), dtb = p.in[I_DTB][((size_t)l * 2 + dir) * 6 + h];
        struct PF { u32x4 x[3][3]; bf16_t be, ai; };
        PF setA, setB;
        auto prefetch = [&](PF& s, int blk) {
            if (blk < NCH) {
                const int j = seqpos(dir, blk * 32 + es);
                const bool hp = (j != 0) && (j != CTX), hn = (j != CTX - 1) && (j != TT - 1);
                const bf16_t* zp = Z + (size_t)(b * TT + j) * ZLD + 1408 + ec;
#pragma unroll
                for (int a = 0; a < 3; ++a) {
                    s.x[a][1] = *(const u32x4*)(zp + a * 384);
                    s.x[a][0] = hp ? *(const u32x4*)(zp + a * 384 - ZLD) : (u32x4){0u, 0u, 0u, 0u};
                    s.x[a][2] = hn ? *(const u32x4*)(zp + a * 384 + ZLD) : (u32x4){0u, 0u, 0u, 0u};
                }
                s.be = zp[1152 - ec + dir * 6 + h]; s.ai = zp[1164 - ec + dir * 6 + h];
            }
        };
        auto flush = [&](int blk) {
            const float* sYb = (const float*)(cb + ck::SY0 + (blk & 1) * 4096);
            const int s = stid >> 3, v4 = (stid & 7) * 4, j = seqpos(dir, blk * 32 + s);
            *(u32x2*)(Y + (size_t)(b * TT + j) * 384 + h * 64 + half * 32 + v4) = pk4(*(const f32x4*)(sYb + s * 32 + v4));
        };
        auto stage = [&](int blk, PF& ps) {
            f32x4 o[3][2];
#pragma unroll
            for (int a = 0; a < 3; ++a) {
                f32x4 p0, p1, c0, c1, n0, n1; ck::unpk8(ps.x[a][0], p0, p1); ck::unpk8(ps.x[a][1], c0, c1); ck::unpk8(ps.x[a][2], n0, n1);
                o[a][0] = p0 * *(const f32x4*)(cst + (0 * 3 + a) * 64 + 8 * c8) + c0 * *(const f32x4*)(cst + (1 * 3 + a) * 64 + 8 * c8) + n0 * *(const f32x4*)(cst + (2 * 3 + a) * 64 + 8 * c8);
                o[a][1] = p1 * *(const f32x4*)(cst + (0 * 3 + a) * 64 + 8 * c8 + 4) + c1 * *(const f32x4*)(cst + (1 * 3 + a) * 64 + 8 * c8 + 4) + n1 * *(const f32x4*)(cst + (2 * 3 + a) * 64 + 8 * c8 + 4);
#pragma unroll
                for (int e = 0; e < 4; ++e) { o[a][0][e] = siluf_(o[a][0][e]); o[a][1][e] = siluf_(o[a][1][e]); }
            }
            float sq = 0.f, sk = 0.f;
#pragma unroll
            for (int e = 0; e < 4; ++e) { sq += o[0][0][e] * o[0][0][e] + o[0][1][e] * o[0][1][e]; sk += o[1][0][e] * o[1][0][e] + o[1][1][e] * o[1][1][e]; }
            sq = ck::red8(sq); sk = ck::red8(sk);
            const float qn = __builtin_amdgcn_rsqf(sq + 1e-6f) * 0.125f, kn = __builtin_amdgcn_rsqf(sk + 1e-6f);
            const f32x4 q0 = o[0][0] * qn, q1 = o[0][1] * qn, k0 = o[1][0] * kn, k1 = o[1][1] * kn;
            const float beta = sigmoidf_(bf2f(ps.be));
            const float xg = bf2f(ps.ai) + dtb; const float gl = -aexp * (xg > 20.f ? xg : __logf(1.f + __expf(xg)));
            if (c8 == 0) { sSC[es * 4] = beta; sSC[es * 4 + 1] = gl; }
            lbar();
            prefetch(ps, blk + 2);
            if (blk > 1) flush(blk - 2);
            char* pc = cb + (blk & 1) * ck::PCB_BYTES + c * ck::PC_STRIDE;
            float g = 0.f, gm1 = 0.f, gt = 0.f;
#pragma unroll
            for (int i = 0; i < 16; ++i) { const float lg = sSC[(16 * c + i) * 4 + 1]; gt += lg; if (i <= t) g += lg; if (i < t) gm1 += lg; }
            const float ac = -__expf(gl) * beta;
            const u32x4 ga = ck::pk8(k0 * ac, k1 * ac), kb = ck::pk8(k0, k1);
            *(u32x4*)(pc + (t * 72 + 8 * c8) * 2) = ga;
            *(u32x4*)(pc + 2304 + (t * 72 + 8 * c8) * 2) = ck::pk8(q0, q1);
            *(u32x4*)(pc + 4608 + (t * 72 + 8 * c8) * 2) = kb;
            ck::st8T((bf16_t*)(pc + 9216), 8 * c8, t, ga); ck::st8T((bf16_t*)(pc + 11264), 8 * c8, t, kb);
            const float us = __expf(gt - g);
            if (t == 15) { const float pv = __expf(gt); const f32x4 pv4 = (f32x4){pv, pv, pv, pv}; *(f32x4*)(pc + 17664 + 32 * c8) = pv4; *(f32x4*)(pc + 17664 + 32 * c8 + 16) = pv4; }
            if (c8 == 0) { float* sc4 = (float*)(pc + 17408); sc4[t] = g; sc4[16 + t] = __expf(g); sc4[32 + t] = __expf(gm1); sc4[48 + t] = us; }
            if ((c8 >> 2) == half) {
                const f32x4 v0 = o[2][0] * beta, v1 = o[2][1] * beta;
                ck::st8T((bf16_t*)(pc + 15360), 8 * c8 - 32 * half, t, ck::pk8(v0, v1)); ck::st8T((bf16_t*)(pc + 16384), 8 * c8 - 32 * half, t, ck::pk8(v0 * us, v1 * us));
            }
            lbar();
        };
        prefetch(setA, 0); prefetch(setB, 1);
        stage(0, setA);
        for (int k = 0; k < NCH; k += 2) {
            if (k + 1 < NCH) stage(k + 1, setB); else { lbar(); lbar(); }
            if (k + 2 < NCH) stage(k + 2, setA); else { lbar(); lbar(); }
        }
        lbar(); lbar();
        flush(NCH - 2); flush(NCH - 1);
    }
}

__device__ __forceinline__ void s5_job(const PP& p, int it, LAS uchar* lds) {
    const int g = it >> 1, dir = it & 1, tid = tid_of(p.wv), w = tid >> 6, q = tid & 63;
    bf16_t* A2 = (bf16_t*)(p.ws + OFF_A2) + (size_t)it * GROWS * 640;
    if (w < 4) {
        const float* HL = (const float*)(p.ws + OFF_HL) + (size_t)g * GROWS * 256 + dir * 128 + 2 * q;
        const float* DP = (const float*)(p.ws + OFF_DP) + (it * 64 + q) * 2;
        const float dr = DP[0], di = DP[1]; float hr = 0.f, hi = 0.f;
        for (int i0 = 0; i0 < NCH; i0 += 8) {
            f32x2 hl[8]; int Rr[8];
#pragma unroll
            for (int e = 0; e < 8; ++e) { const int i = i0 + e; const int c = dir == 0 ? i : (i < 8 ? 7 - i : NCH - 1 - (i - 8)); Rr[e] = w * NCH + c; hl[e] = *(const f32x2*)(HL + (size_t)Rr[e] * 256); }
#pragma unroll
            for (int e = 0; e < 8; ++e) {
                *(unsigned*)(A2 + (size_t)Rr[e] * 640 + 512 + 2 * q) = pk2(hr, hi);
                const float nr = dr * hr - di * hi + hl[e].x, ni = dr * hi + di * hr + hl[e].y; hr = nr; hi = ni;
            }
        }
    }
    __builtin_amdgcn_fence(__ATOMIC_RELEASE, "agent");
    asm volatile("s_waitcnt vmcnt(0)" ::: "memory");
    __syncthreads();
    __builtin_amdgcn_fence(__ATOMIC_ACQUIRE, "agent");
    asm volatile("s_waitcnt vmcnt(0)" ::: "memory");
    __syncthreads();
    pg8::Gemm gm; gm.A = (const bf16_t*)(p.ws + OFF_A2); gm.Bt = (const bf16_t*)(p.ws + OFF_TF); gm.K = 640; gm.lda = 640; gm.ldb = 640;
    pg8::Sched S; S.mode = 1; S.nM = 5; S.nN = 2; S.nwg = (it + 1) * 10; S.G = 1; S.c = it * 10;
    S.gA = (size_t)GROWS * 640 * 2; S.gB = (size_t)512 * 640 * 2; S.tA = (size_t)256 * 640 * 2; S.tB = (size_t)256 * 640 * 2;
    EpiY5 E; E.Y5 = (bf16_t*)(p.ws + OFF_Y5);
    pg8::gemm_phase(lds, gm, S, E, p.wv);
}


constexpr int GRW_SPLIT = 27000;
__device__ __forceinline__ bf16_t* grw_row(char* ws, int row) {
    return row < GRW_SPLIT ? (bf16_t*)(ws + OFF_TF) + (size_t)row * 384 : (bf16_t*)(ws + OFF_HL) + (size_t)(row - GRW_SPLIT) * 384;
}
__device__ __forceinline__ void phase_gaterw(const PP& p, int l, int gw, int nw) {
    int lane = lane_id(); asm volatile("" : "+v"(lane));
    const int fr = lane & 15, fq = lane >> 4;
    const bf16_t* Z = (const bf16_t*)(p.ws + OFF_Z); const bf16_t* GUP = (const bf16_t*)(p.ws + OFF_GUP);
    const float* mu = p.in[I_MU] + l * 1408;
    for (int item = gw; item < MROWS / 16; item += nw) {
        const int row = item * 16 + fr, b = row / TT, j = row - b * TT;
        const bool hp = (j != 0) && (j != CTX), hn = (j != CTX - 1) && (j != TT - 1);
        bf16x8 gfrag[4];
#pragma unroll
        for (int ks = 0; ks < 4; ++ks) {
            const int c0 = 1280 + ks * 32 + fq * 8;
            const Nb3 a = ld3(Z, row, hp, hn, c0), bq = ld3(Z, row, hp, hn, c0 + 4);
            f32x4 x0 = shiftmix(a, mu + c0), x1 = shiftmix(bq, mu + c0 + 4);
#pragma unroll
            for (int i = 0; i < 4; ++i) { x0[i] = sigmoidf_(x0[i]); x1[i] = sigmoidf_(x1[i]); }
            const u32x2 lo = pk4(x0), hi2 = pk4(x1); u32x4 t; t.x = lo.x; t.y = lo.y; t.z = hi2.x; t.w = hi2.y; gfrag[ks] = __builtin_bit_cast(bf16x8, t);
        }
        bf16_t* gr = grw_row(p.ws, row);
#pragma unroll 4
        for (int n24 = 0; n24 < 24; ++n24) {
            f32x4 ga = (f32x4){0.f, 0.f, 0.f, 0.f};
            const bf16_t* wp = GUP + (size_t)(n24 * 16 + fr) * 128 + fq * 8;
#pragma unroll
            for (int ks = 0; ks < 4; ++ks) ga = __builtin_amdgcn_mfma_f32_16x16x32_bf16(*(const bf16x8*)(wp + ks * 32), gfrag[ks], ga, 0, 0, 0);
            *(u32x2*)(gr + n24 * 16 + fq * 4) = pk4(ga);
        }
    }
}
__device__ __forceinline__ void phase_s5post(const PP& p, int l, int gw, int nw) {
    int lane = lane_id(); asm volatile("" : "+v"(lane));
    const int fr = lane & 15, fq = lane >> 4;
    const bf16_t* A2 = (const bf16_t*)(p.ws + OFF_A2); const bf16_t* Y5 = (const bf16_t*)(p.ws + OFF_Y5); bf16_t* Y5w = (bf16_t*)(p.ws + OFF_Y5);
    const bf16_t* GLU = (const bf16_t*)(p.ws + OFF_GLU);
    for (int item = gw; item < MROWS / 16; item += nw) {
        const int row = item * 16 + fr, b = row / TT, j = row - b * TT;
        {
            const int n = s5pos(j), R = b * NCH + (n >> 5), t = n & 31;
            const size_t GS5 = (size_t)GROWS * 512;
            bf16x8 yf[8];
#pragma unroll
            for (int ks = 0; ks < 8; ++ks) {
                const int ch = ks * 32 + fq * 8, g = ch >> 4, hh = ch & 15;
                const u32x4 y0 = *(const u32x4*)(Y5 + (size_t)(g * 2) * GS5 + (size_t)R * 512 + t * 16 + hh), y1 = *(const u32x4*)(Y5 + (size_t)(g * 2 + 1) * GS5 + (size_t)R * 512 + t * 16 + hh);
                const u32x4 uu = *(const u32x4*)(A2 + ((size_t)(g * 2) * GROWS + R) * 640 + t * 16 + hh);
                const float* dv = p.in[I_S5D] + l * 256 + ch;
                float v[8];
#pragma unroll
                for (int e = 0; e < 4; ++e) {
                    v[2 * e] = gelu_tanh(bflo(y0[e]) + bflo(y1[e]) + dv[2 * e] * bflo(uu[e]));
                    v[2 * e + 1] = gelu_tanh(bfhi(y0[e]) + bfhi(y1[e]) + dv[2 * e + 1] * bfhi(uu[e]));
                }
                u32x4 tq; tq.x = pk2(v[0], v[1]); tq.y = pk2(v[2], v[3]); tq.z = pk2(v[4], v[5]); tq.w = pk2(v[6], v[7]); yf[ks] = __builtin_bit_cast(bf16x8, tq);
                asm volatile("" ::: "memory");
            }
#pragma unroll 1
            for (int nt = 0; nt < 16; ++nt) {
                f32x4 a = (f32x4){0.f, 0.f, 0.f, 0.f};
                const bf16_t* wp = GLU + (size_t)(nt * 16 + fr) * 256 + fq * 8;
#pragma unroll
                for (int ks = 0; ks < 8; ++ks) a = __builtin_amdgcn_mfma_f32_16x16x32_bf16(*(const bf16x8*)(wp + ks * 32), yf[ks], a, 0, 0, 0);
                const int ch = nt * 16 + fq * 4, hh = ch & 15;
                const u32x2 y0 = *(const u32x2*)(Y5 + (size_t)(nt * 2) * GS5 + (size_t)R * 512 + t * 16 + hh), y1 = *(const u32x2*)(Y5 + (size_t)(nt * 2 + 1) * GS5 + (size_t)R * 512 + t * 16 + hh);
                const u32x2 uu = *(const u32x2*)(A2 + ((size_t)(nt * 2) * GROWS + R) * 640 + t * 16 + hh);
                const f32x4 dv = *(const f32x4*)(p.in[I_S5D] + l * 256 + ch), gb = *(const f32x4*)(p.in[I_GLUB] + l * 256 + ch);
                const f32x4 ys = unpk4(y0) + unpk4(y1) + dv * unpk4(uu);
                f32x4 o;
#pragma unroll
                for (int i = 0; i < 4; ++i) { const float yy = gelu_tanh(ys[i]); o[i] = yy * sigmoidf_(a[i] + gb[i]); }
                *(u32x2*)(Y5w + (size_t)(nt * 2) * GS5 + (size_t)R * 512 + t * 16 + hh) = pk4(o);
                asm volatile("" ::: "memory");
            }
        }
    }
}

__device__ __forceinline__ void phase_post(const PP& p, int l) {
    const int lane = tid_of(p.wv) & 63, gw = bidx() * 8 + (tid_of(p.wv) >> 6), nw = gridDim.x * 8, tk = lane >> 4, c4 = lane & 15;
    const bf16_t* Z = (const bf16_t*)(p.ws + OFF_Z);
    const bf16_t* YO = (const bf16_t*)(p.ws + OFF_YO);
    const float* BC = (const float*)(p.ws + OFF_BC);
    const bf16_t* Y5 = (const bf16_t*)(p.ws + OFF_Y5);
    bf16_t* MIX = (bf16_t*)(p.ws + OFF_H);
    const float* mu = p.in[I_MU] + l * 1408;
    const size_t YS = (size_t)MROWS * 384;
    for (int it3 = gw; it3 < 2 * (MROWS / 16); it3 += nw) {
      const int item = it3 >> 1, part = 1 + (((it3 / nw) + it3) & 1);
      if (part == 1) {
#pragma unroll 1
        for (int tg = 0; tg < 4; ++tg) {
            const int row = item * 16 + tg * 4 + tk, b = row / TT, j = row - b * TT;
            const bool hp = (j != 0) && (j != CTX), hn = (j != CTX - 1) && (j != TT - 1);
            const bf16_t* gr = grw_row(p.ws, row);
#pragma unroll 2
            for (int h = 0; h < 6; ++h) {
                const int c = h * 64 + 4 * c4;
                f32x4 y = unpk4(*(const u32x2*)(YO + (size_t)row * 384 + c)) + unpk4(*(const u32x2*)(YO + YS + (size_t)row * 384 + c));
                const float mean = red16(y[0] + y[1] + y[2] + y[3]) * (1.f / 64.f);
                y = y - mean;
                const float rstd = __builtin_amdgcn_rsqf(red16(y[0] * y[0] + y[1] * y[1] + y[2] * y[2] + y[3] * y[3]) * (1.f / 64.f) + 64e-5f);
                const float bon = BC[(size_t)row * 6 + h] + BC[(size_t)MROWS * 6 + (size_t)row * 6 + h];
                const f32x4 lg = *(const f32x4*)(p.in[I_LNG] + l * 384 + c), lb = *(const f32x4*)(p.in[I_LNB] + l * 384 + c);
                const f32x4 vs = shiftmix(ld3(Z, row, hp, hn, 768 + c), mu + 768 + c);
                const f32x4 ga = unpk4(*(const u32x2*)(gr + c));
                *(u32x2*)(MIX + (size_t)row * DM + c) = pk4((y * rstd * lg + lb + vs * bon) * ga);
            }
        }
      } else {
#pragma unroll 1
        for (int tg = 0; tg < 4; ++tg) {
            const int row = item * 16 + tg * 4 + tk, b = row / TT, j = row - b * TT;
            const f32x4 gn = *(const f32x4*)(p.in[I_GNG] + l * 64 + 4 * c4);
#pragma unroll 3
            for (int h = 0; h < 6; ++h) {
                const int c = h * 64 + 4 * c4;
                const f32x4 o = unpk4(*(const u32x2*)(YO + 2 * YS + (size_t)row * 384 + c)) + unpk4(*(const u32x2*)(YO + 3 * YS + (size_t)row * 384 + c));
                const float rs = __builtin_amdgcn_rsqf(red16(o[0] * o[0] + o[1] * o[1] + o[2] * o[2] + o[3] * o[3]) * (1.f / 64.f) + 1e-6f);
                f32x4 gt = unpk4(*(const u32x2*)(Z + (size_t)row * ZLD + 2584 + c));
#pragma unroll
                for (int i = 0; i < 4; ++i) gt[i] = siluf_(gt[i]);
                *(u32x2*)(MIX + (size_t)row * DM + 384 + c) = pk4(o * rs * gn * gt);
            }
            const int n = s5pos(j), R = b * NCH + (n >> 5), t = n & 31;
            const size_t GS5 = (size_t)GROWS * 512;
#pragma unroll
            for (int e = 0; e < 4; ++e) {
                const int ch = e * 64 + 4 * c4, nt = ch >> 4, hh = ch & 15;
                *(u32x2*)(MIX + (size_t)row * DM + 768 + ch) = *(const u32x2*)(Y5 + (size_t)(nt * 2) * GS5 + (size_t)R * 512 + t * 16 + hh);
            }
        }
      }
    }
}

__global__ void __launch_bounds__(512) fwd_mega(P kp) {
    extern __shared__ __attribute__((aligned(16))) uchar shm[];
    cg::grid_group grid = cg::this_grid();
    float* sm = (float*)shm;
    LAS uchar* lds = (LAS uchar*)shm;
    const int nblk = gridDim.x;
    if (threadIdx.x == 0) {
        unsigned long long* tab = (unsigned long long*)(shm + TAB_OFF);
#pragma unroll
        for (int i = 0; i < N_IN; ++i) tab[i] = (unsigned long long)kp.in[i];
        tab[N_IN] = (unsigned long long)kp.out; tab[N_IN + 1] = (unsigned long long)kp.ws;
    }
    if (threadIdx.x == 0) { volatile LAS unsigned* st0 = (volatile LAS unsigned*)(lds + TAB_OFF + 384); st0[0] = 0u; st0[1] = 0u; st0[2] = 0u; st0[3] = 0u; }
    __syncthreads();
    const PP p = mkp(__builtin_amdgcn_readfirstlane((int)(threadIdx.x >> 6)));
    const XcdBarrier xb = xcd_barrier_post((unsigned*)(p.ws + OFF_BAR), (volatile LAS unsigned*)(lds + TAB_OFF + 384), p.wv);

    phase_mod(p, sm);
    __syncthreads();
    phase_s5coef(p, 0, sm);
    phase_convw(p, 0, sm, 0, nblk - n_coef_blocks(), 0);
    {
        float* cr = (float*)(p.ws + OFF_CTXR);
        for (size_t i = (size_t)bidx() * 512 + tid_of(p.wv); i < (size_t)NB * CTX * DM / 4; i += (size_t)nblk * 512) ((f32x4*)cr)[i] = ((const f32x4*)p.in[I_CTX])[i];
    }
    grid.sync();

    for (int l = 0; l < DEPTH; ++l) {
        const float* xsrc = l == 0 ? p.in[I_X] : p.out;
        float* ctxr = (float*)(p.ws + OFF_CTXR);
        const float* modl = (const float*)(p.ws + OFF_MOD) + (size_t)l * 5 * 6144;
        phase_norm(p, l, 0, xsrc, ctxr, 0);
        xcd_barrier(xb);
        {
            pg8::Gemm gm; gm.A = (const bf16_t*)(p.ws + OFF_H); gm.Bt = (const bf16_t*)(p.ws + OFF_WIN); gm.K = 1024; gm.lda = 1024; gm.ldb = 1024;
            EpiZ E; E.Z = (bf16_t*)(p.ws + OFF_Z); E.A2 = (bf16_t*)(p.ws + OFF_A2);
            pg8::gemm_phase(lds, gm, sched_static(MROWS, 3328, 1024, 1024), E, p.wv);
        }
        xcd_barrier(xb);
        {
            pg8::Gemm gm; gm.A = (const bf16_t*)(p.ws + OFF_A2); gm.Bt = (const bf16_t*)(p.ws + OFF_E2); gm.K = 512; gm.lda = 640; gm.ldb = 512;
            pg8::Sched S; S.mode = 1; S.nM = 5; S.nN = 1; S.nwg = 80; S.G = nblk; S.c = bidx();
            S.gA = (size_t)2 * GROWS * 640 * 2; S.gB = (size_t)256 * 512 * 2; S.tA = (size_t)256 * 640 * 2; S.tB = 0;
            EpiHL E; E.HL = (float*)(p.ws + OFF_HL);
            pg8::gemm_phase(lds, gm, S, E, p.wv);
        }
        phase_rwprep(p, l);
        xcd_barrier(xb);
        for (int slot = bidx(); slot < 224; slot += nblk) {
            int job = slot;
            if (slot < 192) {
                const int ty = slot >= 96 ? 1 : 0, sl = slot - 96 * ty, x = sl & 7, idx = sl >> 3;
                job = 96 * ty + ((((x >> 1) * 6 + (idx >> 1)) * 2 + (x & 1)) << 1) + (idx & 1);
            }
            if (job < 96) rwkv_job(p, l, job, sm);
            else if (job < 192) gdn_job(p, l, job - 96, sm);
            else {
                s5_job(p, job - 192, lds);
                asm volatile("s_waitcnt vmcnt(0)" ::: "memory");
                __syncthreads();
                if (tid_of(p.wv) == 0) { __builtin_amdgcn_fence(__ATOMIC_RELEASE, "agent"); asm volatile("s_waitcnt vmcnt(0)" ::: "memory");
                    __hip_atomic_fetch_add((unsigned*)(p.ws + OFF_BAR) + 3600 + l, 1u, __ATOMIC_RELAXED, __HIP_MEMORY_SCOPE_AGENT); }
            }
            __syncthreads();
        }
        const bool s5_helpers = nblk >= 224;
        const int hb0 = s5_helpers ? 192 : 0;
        if (bidx() >= hb0) {
            const int tid = tid_of(p.wv);
            if (tid == 0) {
                while (__hip_atomic_load((unsigned*)(p.ws + OFF_BAR) + 3600 + l, __ATOMIC_RELAXED, __HIP_MEMORY_SCOPE_AGENT) < 32u) __builtin_amdgcn_s_sleep(8);
                __builtin_amdgcn_fence(__ATOMIC_ACQUIRE, "agent");
                asm volatile("s_waitcnt vmcnt(0)" ::: "memory");
            }
            __syncthreads();
            phase_s5post(p, l, (bidx() - hb0) * 8 + (tid >> 6), (nblk - hb0) * 8);
            phase_gaterw(p, l, (bidx() - hb0) * 8 + (tid >> 6), (nblk - hb0) * 8);
            __syncthreads();
            phase_convw(p, l, sm, hb0, nblk - hb0, 1);
        }
        xcd_barrier(xb);
        phase_post(p, l);
        xcd_barrier(xb);
        {
            pg8::Gemm gm; gm.A = (const bf16_t*)(p.ws + OFF_H); gm.Bt = (const bf16_t*)(p.ws + OFF_WOUT); gm.K = 1024; gm.lda = 1024; gm.ldb = 1024;
            EpiResid E; E.xin = xsrc; E.xout = p.out; E.cin = l == 0 ? p.in[I_CTX] : ctxr; E.cout = ctxr; E.mod = modl; E.gidx = 2;
            pg8::gemm_phase(lds, gm, sched_static(MROWS, 1024, 1024, 1024), E, p.wv);
        }
        xcd_barrier(xb);
        phase_norm(p, l, 1, p.out, ctxr, 0);
        xcd_barrier(xb);
        {
            pg8::Gemm gm; gm.A = (const bf16_t*)(p.ws + OFF_H); gm.Bt = (const bf16_t*)(p.ws + OFF_WGU); gm.K = 1024; gm.lda = 1024; gm.ldb = 1024;
            EpiSwiGLU E; E.HID = (bf16_t*)(p.ws + OFF_Z);
            pg8::gemm_phase(lds, gm, sched_static(MROWS, 5632, 1024, 1024), E, p.wv);
        }
        xcd_barrier(xb);
        {
            pg8::Gemm gm; gm.A = (const bf16_t*)(p.ws + OFF_Z); gm.Bt = (const bf16_t*)(p.ws + OFF_WDN); gm.K = FFN; gm.lda = FFN; gm.ldb = FFN;
            EpiResid E; E.xin = p.out; E.xout = p.out; E.cin = ctxr; E.cout = ctxr; E.mod = modl; E.gidx = 5;
            pg8::gemm_phase(lds, gm, sched_static(MROWS, 1024, FFN, FFN), E, p.wv);
        }
        if (l + 1 < DEPTH) {
            const int nx = (528 % nblk);
            __syncthreads();
            phase_s5coef(p, l + 1, sm);
            const int ncb = n_coef_blocks();
            const bool wide = nblk - nx - ncb >= 64;
            phase_convw(p, l + 1, sm, wide ? nx : 0, wide ? nblk - nx - ncb : nblk, 0);
        }
        xcd_barrier(xb);
    }
    phase_final(p);
}

extern "C" void kernel_launch(void* const* d_in, const int* in_sizes, int n_in, void* d_out, int out_size, void* d_ws, size_t ws_size, hipStream_t stream) {
    static int grid_blocks = 0;
    if (!grid_blocks) {
        int dev = 0, cus = 0, per_cu = 0;
        hipGetDevice(&dev);
        hipDeviceGetAttribute(&cus, hipDeviceAttributeMultiprocessorCount, dev);
        if (hipFuncSetAttribute((const void*)fwd_mega, hipFuncAttributeMaxDynamicSharedMemorySize, LDS_TOTAL) != hipSuccess) fprintf(stderr, "hipFuncSetAttribute failed\n");
        hipOccupancyMaxActiveBlocksPerMultiprocessor(&per_cu, (const void*)fwd_mega, 512, LDS_TOTAL);
        if (per_cu < 1) per_cu = 1;
        if (per_cu > 1) per_cu = 1;
        grid_blocks = cus * per_cu;
    }
    if (ws_size < WS_NEED) fprintf(stderr, "workspace too small: %zu < %zu\n", ws_size, (size_t)WS_NEED);
    P p{};
    for (int i = 0; i < N_IN; ++i) p.in[i] = (const float*)d_in[i];
    p.out = (float*)d_out; p.ws = (char*)d_ws;
    (void)hipMemsetAsync((char*)d_ws + OFF_BAR, 0, 16384, stream);
    void* args[] = {&p};
    hipError_t e = hipLaunchCooperativeKernel((void*)fwd_mega, dim3(grid_blocks), dim3(512), args, LDS_TOTAL, stream);
    if (e != hipSuccess) fprintf(stderr, "cooperative launch failed: %s (grid %d)\n", hipGetErrorString(e), grid_blocks);
}
```
